# Optimizing an MI355X kernel written in HIP

```python
import math
import jax, jax.numpy as jnp
from jax import lax
import numpy as np

D_MODEL = 1024
BATCH = 8
SEQ = 4096
DEPTH = 2

FOX_HEADS = 8
FOX_DIM = 64
FOX_W = FOX_HEADS * FOX_DIM
DSA_HEADS = 8
DSA_DIM = 64
DSA_W = DSA_HEADS * DSA_DIM
IDX_HEADS = 8
IDX_DIM = 64
TOPK_MAX = 256
D_FF = 2816
QB = 128
ALPHA = (2.0 * DEPTH) ** 0.25
BETA = (8.0 * DEPTH) ** -0.25
LN_EPS = 1e-5
NEG_INF = -1e30
IDX_SCALE = (IDX_HEADS ** -0.5) * (IDX_DIM ** -0.5)

IN_WIDTHS = (FOX_W, FOX_W, FOX_W, FOX_HEADS,
             DSA_W, DSA_W, DSA_W, IDX_HEADS * IDX_DIM, IDX_DIM, IDX_HEADS,
             D_MODEL, D_MODEL)
IN_SCALES = (1.0, 1.0, BETA, 1.0,
             1.0, 1.0, BETA, 1.0, 1.0, 1.0,
             1.0, 1.0)
N_IN = sum(IN_WIDTHS)

kernel_name = "fox_dsa_gated_hybrid_deepnorm"


def _layer_norm(x, g, b):
    xf = x.astype(jnp.float32)
    mu = jnp.mean(xf, axis=-1, keepdims=True)
    var = jnp.mean(jnp.square(xf - mu), axis=-1, keepdims=True)
    y = (xf - mu) * lax.rsqrt(var + LN_EPS)
    return (y * g.astype(jnp.float32) + b.astype(jnp.float32)).astype(x.dtype)


def _alibi_slopes(n_heads):
    h = jnp.arange(n_heads, dtype=jnp.float32)
    return jnp.exp2(-8.0 * (h + 1.0) / n_heads)


def _split_columns(proj):
    points = [int(p) for p in np.cumsum(IN_WIDTHS)[:-1]]
    return jnp.split(proj, points, axis=-1)


def _fox_attention(q, k, v, f_logit):
    B, L, H, dh = q.shape
    scale = dh ** -0.5
    c = jnp.cumsum(jax.nn.log_sigmoid(f_logit.astype(jnp.float32)), axis=1)
    c = jnp.transpose(c, (0, 2, 1))
    kpos = jnp.arange(L)

    def block(i):
        start = i * QB
        qb = lax.dynamic_slice_in_dim(q, start, QB, axis=1)
        cb = lax.dynamic_slice_in_dim(c, start, QB, axis=2)
        qpos = start + jnp.arange(QB)
        s = jnp.einsum('bqhd,bkhd->bhqk', qb, k).astype(jnp.float32) * scale
        s = s + (cb[..., None] - c[:, :, None, :])
        s = jnp.where(kpos[None, :] <= qpos[:, None], s, NEG_INF)
        p = jax.nn.softmax(s, axis=-1).astype(v.dtype)
        return jnp.einsum('bhqk,bkhd->bqhd', p, v)

    o = lax.map(block, jnp.arange(L // QB))
    return jnp.transpose(o, (1, 0, 2, 3, 4)).reshape(B, L, H * dh)


def _dsa_attention(q, k, v, iq, ik, iw):
    B, L, H, dh = q.shape
    scale = dh ** -0.5
    topk = min(TOPK_MAX, L // 4)
    slopes = _alibi_slopes(H)
    kpos = jnp.arange(L)
    gather = jax.vmap(lambda arr, idx: arr[idx])

    def block(i):
        start = i * QB
        qpos = start + jnp.arange(QB)
        iqb = lax.dynamic_slice_in_dim(iq, start, QB, axis=1)
        iwb = lax.dynamic_slice_in_dim(iw, start, QB, axis=1)
        rel = jax.nn.relu(jnp.einsum('bqhd,bkd->bqhk', iqb, ik).astype(jnp.float32))
        score = jnp.einsum('bqh,bqhk->bqk', iwb.astype(jnp.float32) * IDX_SCALE, rel)
        score = jnp.where(kpos[None, None, :] <= qpos[None, :, None], score, NEG_INF)
        _, idx = lax.top_k(score, topk)
        kg = gather(k, idx)
        vg = gather(v, idx)
        qb = lax.dynamic_slice_in_dim(q, start, QB, axis=1)
        dist = (qpos[None, :, None] - idx).astype(jnp.float32)
        s = jnp.einsum('bqhd,bqkhd->bhqk', qb, kg).astype(jnp.float32) * scale
        s = s - slopes[None, :, None, None] * dist[:, None]
        s = jnp.where((dist >= 0.0)[:, None], s, NEG_INF)
        p = jax.nn.softmax(s, axis=-1).astype(v.dtype)
        return jnp.einsum('bhqk,bqkhd->bqhd', p, vg)

    o = lax.map(block, jnp.arange(L // QB))
    return jnp.transpose(o, (1, 0, 2, 3, 4)).reshape(B, L, H * dh)


def setup_inputs(seed: int = 0) -> dict:
    key = jax.random.key(seed)
    keys = jax.random.split(key, 32)
    f32 = jnp.float32

    def nrm(k, shape, fan_in, scale=1.0):
        return jax.random.normal(k, shape, f32) * (scale * fan_in ** -0.5)

    x = jax.random.normal(keys[0], (BATCH, SEQ, D_MODEL), f32)
    in_keys = jax.random.split(keys[1], len(IN_WIDTHS))
    w_in = jnp.concatenate(
        [nrm(kk, (DEPTH, D_MODEL, w), D_MODEL, s)
         for kk, w, s in zip(in_keys, IN_WIDTHS, IN_SCALES)], axis=-1)
    b_forget = jax.random.uniform(keys[2], (DEPTH, FOX_HEADS), f32, 1.0, 6.0)
    w_branch_a = nrm(keys[3], (DEPTH, FOX_W, D_MODEL), FOX_W)
    w_branch_b = nrm(keys[4], (DEPTH, DSA_W, D_MODEL), DSA_W)
    w_out = nrm(keys[5], (DEPTH, D_MODEL, D_MODEL), D_MODEL, BETA)
    ln1_g = 1.0 + 0.02 * jax.random.normal(keys[6], (DEPTH, D_MODEL), f32)
    ln1_b = 0.02 * jax.random.normal(keys[7], (DEPTH, D_MODEL), f32)
    w_ffn_in = nrm(keys[8], (DEPTH, D_MODEL, 2 * D_FF), D_MODEL, BETA)
    w_ffn_out = nrm(keys[9], (DEPTH, D_FF, D_MODEL), D_FF, BETA)
    ln2_g = 1.0 + 0.02 * jax.random.normal(keys[10], (DEPTH, D_MODEL), f32)
    ln2_b = 0.02 * jax.random.normal(keys[11], (DEPTH, D_MODEL), f32)
    return {"x": x, "w_in": w_in, "b_forget": b_forget,
            "w_branch_a": w_branch_a, "w_branch_b": w_branch_b, "w_out": w_out,
            "ln1_g": ln1_g, "ln1_b": ln1_b,
            "w_ffn_in": w_ffn_in, "w_ffn_out": w_ffn_out,
            "ln2_g": ln2_g, "ln2_b": ln2_b}


def reference(x, w_in, b_forget, w_branch_a, w_branch_b, w_out,
              ln1_g, ln1_b, w_ffn_in, w_ffn_out, ln2_g, ln2_b):
    B, L, D = x.shape
    for l in range(DEPTH):
        proj = x @ w_in[l]
        (fq, fk, fv, f_logit, dq, dk, dv, iq, ik, iw, g_a, g_b) = _split_columns(proj)
        o_a = _fox_attention(fq.reshape(B, L, FOX_HEADS, FOX_DIM),
                             fk.reshape(B, L, FOX_HEADS, FOX_DIM),
                             fv.reshape(B, L, FOX_HEADS, FOX_DIM),
                             f_logit + b_forget[l])
        o_b = _dsa_attention(dq.reshape(B, L, DSA_HEADS, DSA_DIM),
                             dk.reshape(B, L, DSA_HEADS, DSA_DIM),
                             dv.reshape(B, L, DSA_HEADS, DSA_DIM),
                             iq.reshape(B, L, IDX_HEADS, IDX_DIM), ik, iw)
        merged = (jax.nn.sigmoid(g_a) * (o_a @ w_branch_a[l])
                  + jax.nn.sigmoid(g_b) * (o_b @ w_branch_b[l]))
        x = _layer_norm(ALPHA * x + merged @ w_out[l], ln1_g[l], ln1_b[l])
        gate, up = jnp.split(x @ w_ffn_in[l], 2, axis=-1)
        ffn = (jax.nn.silu(gate) * up) @ w_ffn_out[l]
        x = _layer_norm(ALPHA * x + ffn, ln2_g[l], ln2_b[l])
    return x
```

```cpp
#include <hip/hip_runtime.h>
#include <stdint.h>
#include <stdio.h>

#define LAS __attribute__((address_space(3)))
typedef unsigned short bf16_t;
typedef float f32x4 __attribute__((ext_vector_type(4)));
typedef unsigned u32x4 __attribute__((ext_vector_type(4)));
typedef unsigned u32x2 __attribute__((ext_vector_type(2)));

namespace cfg {
constexpr int NB = 8, L = 4096, D = 1024, M = NB * L, DEPTH = 2;
constexpr int NH = 8, HD = 64, HW = 512;
constexpr int DFF = 2816;
constexpr int NIN = 5712;
constexpr int C_GA = 3664;
constexpr float ALPHA = 1.4142135623730951f;
constexpr float LN_EPS = 1e-5f;
constexpr float LOG2E = 1.4426950408889634f;
constexpr float QSCALE = 0.125f * LOG2E;
constexpr float IDX_SCALE = 0.04419417382415922f;
constexpr int TOPK = 256;
constexpr int NT = 512;
constexpr size_t MiB = 1u << 20;
constexpr size_t WS_CTL = 0;
constexpr size_t WS_XB = 65 * MiB;
constexpr size_t WS_FQ = 129 * MiB, WS_FK = 161 * MiB, WS_FV = 193 * MiB, WS_DQ = 225 * MiB, WS_DK = 257 * MiB, WS_DV = 289 * MiB, WS_IQ = 321 * MiB;
constexpr size_t WS_IK = 353 * MiB;
constexpr size_t WS_FL = 357 * MiB, WS_IW = 358 * MiB, WS_CUM = 359 * MiB;
constexpr size_t WS_OA = 360 * MiB, WS_OB = 392 * MiB;
constexpr size_t WS_X1B = 360 * MiB;
constexpr size_t WS_MASK = 424 * MiB;
constexpr size_t WS_SGA = 129 * MiB, WS_SGB = 193 * MiB;
constexpr size_t WS_H = 129 * MiB;
constexpr size_t WS_END = 440 * MiB;
}
using namespace cfg;

__device__ __forceinline__ float bf2f(unsigned v) { return __uint_as_float(v << 16); }
__device__ __forceinline__ unsigned f2bf(float f) { unsigned u = __float_as_uint(f); return (u + 0x7fffu + ((u >> 16) & 1u)) >> 16; }

struct P {
    const float *x, *w_in, *b_forget, *w_a, *w_b, *w_out, *ln1_g, *ln1_b, *w_ffn_in, *w_ffn_out, *ln2_g, *ln2_b;
    float* out; unsigned char* ws;
};
#define WSP(T, off) ((T*)(p.ws + (off)))

struct GemmArgs { const bf16_t* A; int lda; const float* W; int ldw; int N; int K; int dual_off; };

template <class Epi, bool DUAL>
__device__ __forceinline__ void naive_gemm_phase(LAS unsigned char* lds, const GemmArgs g, const Epi& E, int wg, int nwg) {
    LAS float* As = (LAS float*)lds;
    LAS float* Bs = As + 16 * 132;
    LAS float* Bs2 = Bs + 16 * 128;
    const int tid = threadIdx.x, ty = tid >> 5, tx = tid & 31;
    const int ntn = (g.N + 127) / 128, ntm = M / 128, nitems = ntn * ntm;
    for (int it = wg; it < nitems; it += nwg) {
        const int tm = it / ntn, tn = it % ntn;
        const int m0 = tm * 128, n0 = tn * 128;
        float acc[8][4], acc2[8][4];
#pragma unroll
        for (int i = 0; i < 8; ++i)
#pragma unroll
            for (int j = 0; j < 4; ++j) { acc[i][j] = 0.f; acc2[i][j] = 0.f; }
        for (int k0 = 0; k0 < g.K; k0 += 16) {
            {
                const int r = tid >> 2, kq = (tid & 3) * 4;
                const u32x2 v = *(const u32x2*)(g.A + (size_t)(m0 + r) * g.lda + k0 + kq);
                As[(kq + 0) * 132 + r] = bf2f(v.x & 0xffffu); As[(kq + 1) * 132 + r] = bf2f(v.x >> 16);
                As[(kq + 2) * 132 + r] = bf2f(v.y & 0xffffu); As[(kq + 3) * 132 + r] = bf2f(v.y >> 16);
            }
            {
                const int k = tid >> 5, n4 = (tid & 31) * 4, n = n0 + n4;
                f32x4 w = (f32x4){0.f, 0.f, 0.f, 0.f}, w2 = w;
                if (n < g.N) { w = *(const f32x4*)(g.W + (size_t)(k0 + k) * g.ldw + n); if (DUAL) w2 = *(const f32x4*)(g.W + (size_t)(k0 + k) * g.ldw + n + g.dual_off); }
                *(LAS f32x4*)(Bs + k * 128 + n4) = w;
                if (DUAL) *(LAS f32x4*)(Bs2 + k * 128 + n4) = w2;
            }
            __syncthreads();
#pragma unroll
            for (int kk = 0; kk < 16; ++kk) {
                const f32x4 a0 = *(const LAS f32x4*)(As + kk * 132 + ty * 8), a1 = *(const LAS f32x4*)(As + kk * 132 + ty * 8 + 4);
                const f32x4 b = *(const LAS f32x4*)(Bs + kk * 128 + tx * 4);
                const float a[8] = {a0.x, a0.y, a0.z, a0.w, a1.x, a1.y, a1.z, a1.w};
                const float bb[4] = {b.x, b.y, b.z, b.w};
#pragma unroll
                for (int i = 0; i < 8; ++i)
#pragma unroll
                    for (int j = 0; j < 4; ++j) acc[i][j] = fmaf(a[i], bb[j], acc[i][j]);
                if (DUAL) {
                    const f32x4 b2 = *(const LAS f32x4*)(Bs2 + kk * 128 + tx * 4);
                    const float b2b[4] = {b2.x, b2.y, b2.z, b2.w};
#pragma unroll
                    for (int i = 0; i < 8; ++i)
#pragma unroll
                        for (int j = 0; j < 4; ++j) acc2[i][j] = fmaf(a[i], b2b[j], acc2[i][j]);
                }
            }
            __syncthreads();
        }
#pragma unroll
        for (int i = 0; i < 8; ++i)
#pragma unroll
            for (int j = 0; j < 4; ++j) { const int n = n0 + tx * 4 + j; if (n < g.N) E(m0 + ty * 8 + i, n, acc[i][j], acc2[i][j]); }
    }
}

struct EpiProj {
    bf16_t *FQ, *FK, *FV, *DQ, *DK, *DV, *IQ, *IK; float *FL, *IW; const float* bforget;
    __device__ __forceinline__ void operator()(int m, int n, float v, float) const {
        const size_t r = (size_t)m;
        if (n < 512) FQ[r * 512 + n] = (bf16_t)f2bf(v * QSCALE);
        else if (n < 1024) FK[r * 512 + (n - 512)] = (bf16_t)f2bf(v);
        else if (n < 1536) FV[r * 512 + (n - 1024)] = (bf16_t)f2bf(v);
        else if (n < 1544) FL[r * 8 + (n - 1536)] = v + bforget[n - 1536];
        else if (n < 2056) DQ[r * 512 + (n - 1544)] = (bf16_t)f2bf(v * QSCALE);
        else if (n < 2568) DK[r * 512 + (n - 2056)] = (bf16_t)f2bf(v);
        else if (n < 3080) DV[r * 512 + (n - 2568)] = (bf16_t)f2bf(v);
        else if (n < 3592) IQ[r * 512 + (n - 3080)] = (bf16_t)f2bf(v);
        else if (n < 3656) IK[r * 64 + (n - 3592)] = (bf16_t)f2bf(v);
        else IW[r * 8 + (n - 3656)] = v;
    }
};
struct EpiGates {
    bf16_t *SGA, *SGB;
    __device__ __forceinline__ void operator()(int m, int n, float v, float) const {
        const float s = 1.f / (1.f + __expf(-v));
        if (n < 1024) SGA[(size_t)m * 1024 + n] = (bf16_t)f2bf(s); else SGB[(size_t)m * 1024 + (n - 1024)] = (bf16_t)f2bf(s);
    }
};
struct EpiBranchA { bf16_t* SGA;
    __device__ __forceinline__ void operator()(int m, int n, float v, float) const { bf16_t* q = SGA + (size_t)m * 1024 + n; *q = (bf16_t)f2bf(bf2f(*q) * v); } };
struct EpiBranchB { const bf16_t* MA; bf16_t* SGB;
    __device__ __forceinline__ void operator()(int m, int n, float v, float) const { const size_t o = (size_t)m * 1024 + n; SGB[o] = (bf16_t)f2bf(bf2f(MA[o]) + bf2f(SGB[o]) * v); } };
struct EpiResF32 { const float* xf; const bf16_t* xb; float* Y;
    __device__ __forceinline__ void operator()(int m, int n, float v, float) const { const size_t o = (size_t)m * 1024 + n; const float xv = xf ? xf[o] : bf2f(xb[o]); Y[o] = ALPHA * xv + v; } };
struct EpiSwiglu { bf16_t* H;
    __device__ __forceinline__ void operator()(int m, int n, float g, float u) const { const float s = g / (1.f + __expf(-g)); H[(size_t)m * DFF + n] = (bf16_t)f2bf(s * u); } };

__device__ __forceinline__ void cvt_phase(const P& p, int wg, int nwg) {
    bf16_t* XB = WSP(bf16_t, WS_XB);
    const size_t n4 = (size_t)M * D / 4;
    for (size_t i = (size_t)wg * NT + threadIdx.x; i < n4; i += (size_t)nwg * NT) {
        const f32x4 v = ((const f32x4*)p.x)[i];
        u32x2 o; o.x = f2bf(v.x) | (f2bf(v.y) << 16); o.y = f2bf(v.z) | (f2bf(v.w) << 16);
        ((u32x2*)XB)[i] = o;
    }
}

__device__ __forceinline__ void cum_phase(const P& p, LAS unsigned char* lds, int wg, int nwg) {
    const float* FL = WSP(const float, WS_FL); float* CUM = WSP(float, WS_CUM);
    LAS float* wsum = (LAS float*)lds;
    const int tid = threadIdx.x, lane = tid & 63, wv = tid >> 6;
    for (int it = wg; it < NB * NH; it += nwg) {
        const int b = it / NH, h = it % NH;
        float v[8]; float s = 0.f;
#pragma unroll
        for (int j = 0; j < 8; ++j) { const int t = tid * 8 + j; const float z = FL[((size_t)b * L + t) * 8 + h];
            const float ls = fminf(z, 0.f) - log1pf(__expf(-fabsf(z))); s += ls; v[j] = s; }
        float incl = s;
#pragma unroll
        for (int o = 1; o < 64; o <<= 1) { const float u = __shfl_up(incl, o); if (lane >= o) incl += u; }
        if (lane == 63) wsum[wv] = incl;
        __syncthreads();
        float base = incl - s;
        for (int w = 0; w < wv; ++w) base += wsum[w];
#pragma unroll
        for (int j = 0; j < 8; ++j) CUM[((size_t)b * NH + h) * L + tid * 8 + j] = base + v[j];
        __syncthreads();
    }
}

__device__ __forceinline__ void ln_phase(const float* Y, const float* g, const float* bta, bf16_t* XO, float* FO, int wg, int nwg) {
    const int lane = threadIdx.x & 63, wv = threadIdx.x >> 6;
    for (int m = wg * 8 + wv; m < M; m += nwg * 8) {
        const f32x4* yr = (const f32x4*)(Y + (size_t)m * D) + lane;
        f32x4 v[4]; float s = 0.f;
#pragma unroll
        for (int j = 0; j < 4; ++j) { v[j] = yr[64 * j]; s += (v[j].x + v[j].y) + (v[j].z + v[j].w); }
#pragma unroll
        for (int o = 1; o < 64; o <<= 1) s += __shfl_xor(s, o);
        const float mean = s * (1.f / D); float s2 = 0.f;
#pragma unroll
        for (int j = 0; j < 4; ++j) { v[j] = v[j] - mean; s2 += (v[j].x * v[j].x + v[j].y * v[j].y) + (v[j].z * v[j].z + v[j].w * v[j].w); }
#pragma unroll
        for (int o = 1; o < 64; o <<= 1) s2 += __shfl_xor(s2, o);
        const float rstd = 1.f / sqrtf(s2 * (1.f / D) + LN_EPS);
#pragma unroll
        for (int j = 0; j < 4; ++j) {
            const f32x4 gg = ((const f32x4*)g)[lane + 64 * j], bb = ((const f32x4*)bta)[lane + 64 * j];
            const f32x4 o = v[j] * rstd * gg + bb;
            if (XO) { u32x2 w; w.x = f2bf(o.x) | (f2bf(o.y) << 16); w.y = f2bf(o.z) | (f2bf(o.w) << 16); ((u32x2*)(XO + (size_t)m * D))[lane + 64 * j] = w; }
            else ((f32x4*)(FO + (size_t)m * D))[lane + 64 * j] = o;
        }
    }
}

__device__ __forceinline__ unsigned sortable(float f) { const unsigned u = __float_as_uint(f); return (u & 0x80000000u) ? ~u : (u | 0x80000000u); }
__device__ __forceinline__ unsigned wg_sum(unsigned c, LAS unsigned* buf, int par) {
#pragma unroll
    for (int o = 1; o < 64; o <<= 1) c += __shfl_xor(c, o);
    if ((threadIdx.x & 63) == 0) buf[par * 8 + (threadIdx.x >> 6)] = c;
    __syncthreads();
    unsigned s = 0;
#pragma unroll
    for (int w = 0; w < 8; ++w) s += buf[par * 8 + w];
    return s;
}
__device__ __forceinline__ void idx_phase(const P& p, LAS unsigned char* lds, int wg, int nwg) {
    const bf16_t* IQ = WSP(const bf16_t, WS_IQ); const bf16_t* IK = WSP(const bf16_t, WS_IK); const float* IW = WSP(const float, WS_IW);
    unsigned* MASK = WSP(unsigned, WS_MASK);
    LAS float* iqs = (LAS float*)lds;
    LAS float* wv = iqs + 512;
    LAS unsigned* cbuf = (LAS unsigned*)(wv + 8);
    LAS unsigned* wtot = cbuf + 16;
    LAS unsigned char* bytes = (LAS unsigned char*)(wtot + 8);
    LAS unsigned* sc = (LAS unsigned*)(bytes + 512);
    const int tid = threadIdx.x, lane = tid & 63, wave = tid >> 6;
    for (int row = wg; row < M; row += nwg) {
        const int b = row / L, t = row % L, n = t + 1;
        iqs[tid] = bf2f(IQ[(size_t)row * 512 + tid]);
        if (tid < 8) wv[tid] = IW[(size_t)row * 8 + tid] * IDX_SCALE;
        __syncthreads();
        for (int s = tid; s < L; s += NT) {
            unsigned key = 0u;
            if (s < n) {
                float kf[64];
                const u32x4* kr = (const u32x4*)(IK + ((size_t)b * L + s) * 64);
#pragma unroll
                for (int c = 0; c < 8; ++c) { const u32x4 v = kr[c];
                    kf[c * 8 + 0] = bf2f(v.x & 0xffffu); kf[c * 8 + 1] = bf2f(v.x >> 16); kf[c * 8 + 2] = bf2f(v.y & 0xffffu); kf[c * 8 + 3] = bf2f(v.y >> 16);
                    kf[c * 8 + 4] = bf2f(v.z & 0xffffu); kf[c * 8 + 5] = bf2f(v.z >> 16); kf[c * 8 + 6] = bf2f(v.w & 0xffffu); kf[c * 8 + 7] = bf2f(v.w >> 16); }
                float score = 0.f;
#pragma unroll
                for (int h = 0; h < 8; ++h) {
                    float d0 = 0.f, d1 = 0.f;
#pragma unroll
                    for (int d = 0; d < 64; d += 4) { const f32x4 q = *(const LAS f32x4*)(iqs + h * 64 + d);
                        d0 = fmaf(q.x, kf[d], d0); d1 = fmaf(q.y, kf[d + 1], d1); d0 = fmaf(q.z, kf[d + 2], d0); d1 = fmaf(q.w, kf[d + 3], d1); }
                    score = fmaf(wv[h], fmaxf(d0 + d1, 0.f), score);
                }
                key = sortable(score + 0.f);
                if (key == 0u) key = 1u;
            }
            sc[s] = key;
        }
        __syncthreads();
        unsigned k8[8];
#pragma unroll
        for (int j = 0; j < 8; ++j) k8[j] = sc[tid * 8 + j];
        unsigned bits = 0u;
        if (n <= TOPK) {
#pragma unroll
            for (int j = 0; j < 8; ++j) if (tid * 8 + j < n) bits |= 1u << j;
        } else {
            unsigned T = 0u; int par = 0;
            for (int bit = 31; bit >= 0; --bit) {
                const unsigned cand = T | (1u << bit); unsigned c = 0;
#pragma unroll
                for (int j = 0; j < 8; ++j) c += (k8[j] >= cand) ? 1u : 0u;
                if (wg_sum(c, cbuf, par) >= (unsigned)TOPK) T = cand;
                par ^= 1;
            }
            unsigned cg = 0, ce = 0;
#pragma unroll
            for (int j = 0; j < 8; ++j) { cg += (k8[j] > T) ? 1u : 0u; ce += (k8[j] == T) ? 1u : 0u; }
            const unsigned G = wg_sum(cg, cbuf, par); par ^= 1;
            const unsigned E = (unsigned)TOPK - G;
            unsigned incl = ce;
#pragma unroll
            for (int o = 1; o < 64; o <<= 1) { const unsigned u = __shfl_up(incl, o); if (lane >= o) incl += u; }
            if (lane == 63) wtot[wave] = incl;
            __syncthreads();
            unsigned rank = incl - ce;
            for (int w = 0; w < wave; ++w) rank += wtot[w];
#pragma unroll
            for (int j = 0; j < 8; ++j) {
                if (k8[j] > T) bits |= 1u << j;
                else if (k8[j] == T) { if (rank < E) bits |= 1u << j; ++rank; }
            }
        }
        bytes[tid] = (unsigned char)bits;
        __syncthreads();
        if (tid < 128) MASK[(size_t)row * 128 + tid] = ((const LAS unsigned*)bytes)[tid];
        __syncthreads();
    }
}

template <bool DSA>
__device__ __forceinline__ void attn_item(const P& p, int item) {
    const int qc = item & 7, h = (item >> 3) & 7, b = item >> 6;
    const int t = qc * 512 + threadIdx.x;
    const size_t row = (size_t)b * L + t;
    const bf16_t* Q = DSA ? WSP(const bf16_t, WS_DQ) : WSP(const bf16_t, WS_FQ);
    const bf16_t* K = DSA ? WSP(const bf16_t, WS_DK) : WSP(const bf16_t, WS_FK);
    const bf16_t* V = DSA ? WSP(const bf16_t, WS_DV) : WSP(const bf16_t, WS_FV);
    bf16_t* O = DSA ? WSP(bf16_t, WS_OB) : WSP(bf16_t, WS_OA);
    const float* cum = WSP(const float, WS_CUM) + ((size_t)b * NH + h) * L;
    const unsigned* mrow = WSP(const unsigned, WS_MASK) + row * 128;
    float q[64], o[64];
    {
        const u32x4* qr = (const u32x4*)(Q + row * 512 + h * 64);
#pragma unroll
        for (int c = 0; c < 8; ++c) { const u32x4 v = qr[c];
            q[c * 8 + 0] = bf2f(v.x & 0xffffu); q[c * 8 + 1] = bf2f(v.x >> 16); q[c * 8 + 2] = bf2f(v.y & 0xffffu); q[c * 8 + 3] = bf2f(v.y >> 16);
            q[c * 8 + 4] = bf2f(v.z & 0xffffu); q[c * 8 + 5] = bf2f(v.z >> 16); q[c * 8 + 6] = bf2f(v.w & 0xffffu); q[c * 8 + 7] = bf2f(v.w >> 16); }
    }
#pragma unroll
    for (int d = 0; d < 64; ++d) o[d] = 0.f;
    float mx = -1e30f, l = 0.f;
    const float ct = DSA ? 0.f : cum[t] * LOG2E;
    const float slope2 = exp2f(-(float)(h + 1)) * LOG2E;
    const int tmax = __builtin_amdgcn_readfirstlane(t | 63);
    const bf16_t* Kh = K + (size_t)b * L * 512 + h * 64;
    const bf16_t* Vh = V + (size_t)b * L * 512 + h * 64;
    for (int s0 = 0; s0 <= tmax; s0 += 2) {
        float xv[2]; bool ok[2];
        const unsigned mb = DSA ? (mrow[s0 >> 5] >> (s0 & 31)) : 0x3u;
#pragma unroll
        for (int j = 0; j < 2; ++j) {
            const int s = s0 + j;
            const u32x4* kr = (const u32x4*)(Kh + (size_t)s * 512);
            float d0 = 0.f, d1 = 0.f;
#pragma unroll
            for (int c = 0; c < 8; ++c) { const u32x4 v = kr[c];
                d0 = fmaf(q[c * 8 + 0], bf2f(v.x & 0xffffu), d0); d1 = fmaf(q[c * 8 + 1], bf2f(v.x >> 16), d1);
                d0 = fmaf(q[c * 8 + 2], bf2f(v.y & 0xffffu), d0); d1 = fmaf(q[c * 8 + 3], bf2f(v.y >> 16), d1);
                d0 = fmaf(q[c * 8 + 4], bf2f(v.z & 0xffffu), d0); d1 = fmaf(q[c * 8 + 5], bf2f(v.z >> 16), d1);
                d0 = fmaf(q[c * 8 + 6], bf2f(v.w & 0xffffu), d0); d1 = fmaf(q[c * 8 + 7], bf2f(v.w >> 16), d1); }
            const float dot = d0 + d1;
            ok[j] = (s <= t) && ((mb >> j) & 1u);
            const float xx = DSA ? (dot - slope2 * (float)(t - s)) : (dot + (ct - cum[s] * LOG2E));
            xv[j] = ok[j] ? xx : -1e30f;
        }
        const float mnew = fmaxf(fmaxf(xv[0], xv[1]), mx);
        const float alpha = exp2f(mx - mnew);
        mx = mnew; l *= alpha;
#pragma unroll
        for (int d = 0; d < 64; ++d) o[d] *= alpha;
#pragma unroll
        for (int j = 0; j < 2; ++j) {
            const int s = s0 + j;
            const float pj = ok[j] ? exp2f(xv[j] - mnew) : 0.f;
            l += pj;
            const u32x4* vr = (const u32x4*)(Vh + (size_t)s * 512);
#pragma unroll
            for (int c = 0; c < 8; ++c) { const u32x4 v = vr[c];
                o[c * 8 + 0] = fmaf(pj, bf2f(v.x & 0xffffu), o[c * 8 + 0]); o[c * 8 + 1] = fmaf(pj, bf2f(v.x >> 16), o[c * 8 + 1]);
                o[c * 8 + 2] = fmaf(pj, bf2f(v.y & 0xffffu), o[c * 8 + 2]); o[c * 8 + 3] = fmaf(pj, bf2f(v.y >> 16), o[c * 8 + 3]);
                o[c * 8 + 4] = fmaf(pj, bf2f(v.z & 0xffffu), o[c * 8 + 4]); o[c * 8 + 5] = fmaf(pj, bf2f(v.z >> 16), o[c * 8 + 5]);
                o[c * 8 + 6] = fmaf(pj, bf2f(v.w & 0xffffu), o[c * 8 + 6]); o[c * 8 + 7] = fmaf(pj, bf2f(v.w >> 16), o[c * 8 + 7]); }
        }
    }
    const float rl = 1.f / l;
    u32x4* orow = (u32x4*)(O + row * 512 + h * 64);
#pragma unroll
    for (int c = 0; c < 8; ++c) { u32x4 w;
        w.x = f2bf(o[c * 8 + 0] * rl) | (f2bf(o[c * 8 + 1] * rl) << 16); w.y = f2bf(o[c * 8 + 2] * rl) | (f2bf(o[c * 8 + 3] * rl) << 16);
        w.z = f2bf(o[c * 8 + 4] * rl) | (f2bf(o[c * 8 + 5] * rl) << 16); w.w = f2bf(o[c * 8 + 6] * rl) | (f2bf(o[c * 8 + 7] * rl) << 16);
        orow[c] = w; }
}
__device__ __forceinline__ void attn_phase_naive(const P& p, int wg, int nwg) {
    for (int it = wg; it < 1024; it += nwg) {
        const int r = it >> 1; const int item = (r & ~7) | (7 - (r & 7));
        if (it & 1) attn_item<true>(p, item); else attn_item<false>(p, item);
    }
}

enum { PH_CVT = 0, PH_PROJ, PH_CUM, PH_IDX, PH_ATTN, PH_GATES, PH_BRA, PH_BRB, PH_OUT, PH_LN1, PH_FFN1, PH_FFN2, PH_LN2 };

template <int PH>
__device__ __forceinline__ void run_phase(const P& p, int l, LAS unsigned char* lds, int wg, int nwg) {
    bf16_t* XB = WSP(bf16_t, WS_XB);
    if constexpr (PH == PH_CVT) cvt_phase(p, wg, nwg);
    if constexpr (PH == PH_PROJ) {
        GemmArgs g{XB, D, p.w_in + (size_t)l * D * NIN, NIN, C_GA, D, 0};
        EpiProj E{WSP(bf16_t, WS_FQ), WSP(bf16_t, WS_FK), WSP(bf16_t, WS_FV), WSP(bf16_t, WS_DQ), WSP(bf16_t, WS_DK), WSP(bf16_t, WS_DV), WSP(bf16_t, WS_IQ), WSP(bf16_t, WS_IK),
                  WSP(float, WS_FL), WSP(float, WS_IW), p.b_forget + l * NH};
        naive_gemm_phase<EpiProj, false>(lds, g, E, wg, nwg);
    }
    if constexpr (PH == PH_CUM) cum_phase(p, lds, wg, nwg);
    if constexpr (PH == PH_IDX) idx_phase(p, lds, wg, nwg);
    if constexpr (PH == PH_ATTN) attn_phase_naive(p, wg, nwg);
    if constexpr (PH == PH_GATES) {
        GemmArgs g{XB, D, p.w_in + (size_t)l * D * NIN + C_GA, NIN, 2048, D, 0};
        EpiGates E{WSP(bf16_t, WS_SGA), WSP(bf16_t, WS_SGB)};
        naive_gemm_phase<EpiGates, false>(lds, g, E, wg, nwg);
    }
    if constexpr (PH == PH_BRA) {
        GemmArgs g{WSP(bf16_t, WS_OA), 512, p.w_a + (size_t)l * 512 * D, D, D, 512, 0};
        EpiBranchA E{WSP(bf16_t, WS_SGA)};
        naive_gemm_phase<EpiBranchA, false>(lds, g, E, wg, nwg);
    }
    if constexpr (PH == PH_BRB) {
        GemmArgs g{WSP(bf16_t, WS_OB), 512, p.w_b + (size_t)l * 512 * D, D, D, 512, 0};
        EpiBranchB E{WSP(bf16_t, WS_SGA), WSP(bf16_t, WS_SGB)};
        naive_gemm_phase<EpiBranchB, false>(lds, g, E, wg, nwg);
    }
    if constexpr (PH == PH_OUT) {
        GemmArgs g{WSP(bf16_t, WS_SGB), D, p.w_out + (size_t)l * D * D, D, D, D, 0};
        EpiResF32 E{l == 0 ? p.x : nullptr, XB, p.out};
        naive_gemm_phase<EpiResF32, false>(lds, g, E, wg, nwg);
    }
    if constexpr (PH == PH_LN1) ln_phase(p.out, p.ln1_g + l * D, p.ln1_b + l * D, WSP(bf16_t, WS_X1B), nullptr, wg, nwg);
    if constexpr (PH == PH_FFN1) {
        GemmArgs g{WSP(bf16_t, WS_X1B), D, p.w_ffn_in + (size_t)l * D * 2 * DFF, 2 * DFF, DFF, D, DFF};
        EpiSwiglu E{WSP(bf16_t, WS_H)};
        naive_gemm_phase<EpiSwiglu, true>(lds, g, E, wg, nwg);
    }
    if constexpr (PH == PH_FFN2) {
        GemmArgs g{WSP(bf16_t, WS_H), DFF, p.w_ffn_out + (size_t)l * DFF * D, D, D, DFF, 0};
        EpiResF32 E{nullptr, WSP(bf16_t, WS_X1B), p.out};
        naive_gemm_phase<EpiResF32, false>(lds, g, E, wg, nwg);
    }
    if constexpr (PH == PH_LN2) {
        if (l + 1 < DEPTH) ln_phase(p.out, p.ln2_g + l * D, p.ln2_b + l * D, XB, nullptr, wg, nwg);
        else ln_phase(p.out, p.ln2_g + l * D, p.ln2_b + l * D, nullptr, p.out, wg, nwg);
    }
}

template <int PH>
__global__ void __launch_bounds__(NT, 2) k_phase(P p, int l) {
    extern __shared__ __attribute__((aligned(16))) unsigned char lds_raw[];
    run_phase<PH>(p, l, (LAS unsigned char*)lds_raw, (int)blockIdx.x, (int)gridDim.x);
}

constexpr int LDS_BYTES = 32768;
template <int PH> static void launch_phase(const P& p, int l, int grid, hipStream_t stream) {
    hipLaunchKernelGGL(k_phase<PH>, dim3(grid), dim3(NT), LDS_BYTES, stream, p, l);
}

extern "C" void kernel_launch(void* const* d_in, const int* in_sizes, int n_in, void* d_out, int out_size, void* d_ws, size_t ws_size, hipStream_t stream) {
    if (n_in != 12 || ws_size < WS_END) { fprintf(stderr, "kernel_launch: unexpected inputs (n_in %d, ws %zu)\n", n_in, ws_size); return; }
    P p{};
    p.x = (const float*)d_in[0]; p.w_in = (const float*)d_in[1]; p.b_forget = (const float*)d_in[2]; p.w_a = (const float*)d_in[3]; p.w_b = (const float*)d_in[4];
    p.w_out = (const float*)d_in[5]; p.ln1_g = (const float*)d_in[6]; p.ln1_b = (const float*)d_in[7]; p.w_ffn_in = (const float*)d_in[8]; p.w_ffn_out = (const float*)d_in[9];
    p.ln2_g = (const float*)d_in[10]; p.ln2_b = (const float*)d_in[11]; p.out = (float*)d_out; p.ws = (unsigned char*)d_ws;
    const int G = 1024;
    launch_phase<PH_CVT>(p, 0, G, stream);
    for (int l = 0; l < DEPTH; ++l) {
        launch_phase<PH_PROJ>(p, l, G, stream);
        launch_phase<PH_CUM>(p, l, 64, stream);
        launch_phase<PH_IDX>(p, l, G, stream);
        launch_phase<PH_ATTN>(p, l, G, stream);
        launch_phase<PH_GATES>(p, l, G, stream);
        launch_phase<PH_BRA>(p, l, G, stream);
        launch_phase<PH_BRB>(p, l, G, stream);
        launch_phase<PH_OUT>(p, l, G, stream);
        launch_phase<PH_LN1>(p, l, G, stream);
        launch_phase<PH_FFN1>(p, l, G, stream);
        launch_phase<PH_FFN2>(p, l, G, stream);
        launch_phase<PH_LN2>(p, l, G, stream);
    }
}
```

```cpp
#include <hip/hip_runtime.h>
#include <stdint.h>
#include <stdio.h>

#define LAS __attribute__((address_space(3)))
typedef unsigned short bf16_t;
typedef float f32x4 __attribute__((ext_vector_type(4)));
typedef unsigned u32x4 __attribute__((ext_vector_type(4)));
typedef unsigned u32x2 __attribute__((ext_vector_type(2)));

namespace cfg {
constexpr int NB = 8, L = 4096, D = 1024, M = NB * L, DEPTH = 2;
constexpr int NH = 8, HD = 64, HW = 512;
constexpr int DFF = 2816;
constexpr int NIN = 5712;
constexpr int C_GA = 3664;
constexpr float ALPHA = 1.4142135623730951f;
constexpr float LN_EPS = 1e-5f;
constexpr float LOG2E = 1.4426950408889634f;
constexpr float QSCALE = 0.125f * LOG2E;
constexpr float IDX_SCALE = 0.04419417382415922f;
constexpr int TOPK = 256;
constexpr int NT = 512;
constexpr int LDS_MISC_OFF = 135168;
constexpr size_t MiB = 1u << 20;
constexpr size_t WS_CTL = 0;
constexpr size_t WS_WT = 1 * MiB, WT_LAYER = 32 * MiB;
constexpr size_t WT_IN = 0, WT_A = 12058624, WT_B = WT_A + 1048576, WT_OUT = WT_B + 1048576, WT_F1 = WT_OUT + 2097152, WT_F2 = WT_F1 + 11534336;
constexpr int NPROJ = 3840, NGATE = 2048;
constexpr size_t WS_XB = 65 * MiB;
constexpr size_t WS_FQ = 129 * MiB, WS_FK = 161 * MiB, WS_FV = 193 * MiB, WS_DQ = 225 * MiB, WS_DK = 257 * MiB, WS_DV = 289 * MiB, WS_IQ = 321 * MiB;
constexpr size_t WS_IK = 353 * MiB;
constexpr size_t WS_FL = 357 * MiB, WS_IW = 358 * MiB, WS_CUM = 359 * MiB;
constexpr size_t WS_OA = 360 * MiB, WS_OB = 392 * MiB;
constexpr size_t WS_X1B = 360 * MiB;
constexpr size_t WS_MASK = 424 * MiB;
constexpr size_t WS_SGA = 129 * MiB, WS_SGB = 193 * MiB;
constexpr size_t WS_Y1 = 129 * MiB;
constexpr size_t WS_H = 129 * MiB;
constexpr size_t WS_END = 440 * MiB;
constexpr int CW_QHEAD = 8192;
constexpr int CW_KMAX = 8448;
constexpr int CW_BLK = 8704;
constexpr int CW_QMAX = 9216;
}
using namespace cfg;

__device__ __forceinline__ float bf2f(unsigned v) { return __uint_as_float(v << 16); }
__device__ __forceinline__ unsigned f2bf(float f) { unsigned u = __float_as_uint(f); return (u + 0x7fffu + ((u >> 16) & 1u)) >> 16; }

constexpr int LDS_WTAB_OFF = 135168 + 64;
__device__ __forceinline__ unsigned hw_wave_slot() { return ((unsigned)__builtin_amdgcn_s_getreg((3 << 11) | (0 << 6) | 4) & 15u) | (((unsigned)__builtin_amdgcn_s_getreg((1 << 11) | (4 << 6) | 4) & 3u) << 4); }
__device__ __forceinline__ int ltid() {
    const int w = ((volatile LAS int*)(uintptr_t)LDS_WTAB_OFF)[hw_wave_slot()];
    int lane; asm volatile("v_mbcnt_lo_u32_b32 %0, -1, 0\n\tv_mbcnt_hi_u32_b32 %0, -1, %0" : "=v"(lane));
    int t = w * 64 + lane;
    asm volatile("" : "+v"(t)); return t;
}

struct P {
    const float *x, *w_in, *b_forget, *w_a, *w_b, *w_out, *ln1_g, *ln1_b, *w_ffn_in, *w_ffn_out, *ln2_g, *ln2_b;
    float* out; unsigned char* ws;
};
#define WSP(T, off) ((T*)(p.ws + (off)))

struct GemmArgs { const bf16_t* A; int lda; const float* W; int ldw; int N; int K; int dual_off; };

template <class Epi, bool DUAL>
__device__ __forceinline__ void naive_gemm_phase(LAS unsigned char* lds, const GemmArgs g, const Epi& E, int wg, int nwg) {
    LAS float* As = (LAS float*)lds;
    LAS float* Bs = As + 16 * 132;
    LAS float* Bs2 = Bs + 16 * 128;
    const int tid = ltid(), ty = tid >> 5, tx = tid & 31;
    const int ntn = (g.N + 127) / 128, ntm = M / 128, nitems = ntn * ntm;
    for (int it = wg; it < nitems; it += nwg) {
        const int tm = it / ntn, tn = it % ntn;
        const int m0 = tm * 128, n0 = tn * 128;
        float acc[8][4], acc2[8][4];
#pragma unroll
        for (int i = 0; i < 8; ++i)
#pragma unroll
            for (int j = 0; j < 4; ++j) { acc[i][j] = 0.f; acc2[i][j] = 0.f; }
        for (int k0 = 0; k0 < g.K; k0 += 16) {
            {
                const int r = tid >> 2, kq = (tid & 3) * 4;
                const u32x2 v = *(const u32x2*)(g.A + (size_t)(m0 + r) * g.lda + k0 + kq);
                As[(kq + 0) * 132 + r] = bf2f(v.x & 0xffffu); As[(kq + 1) * 132 + r] = bf2f(v.x >> 16);
                As[(kq + 2) * 132 + r] = bf2f(v.y & 0xffffu); As[(kq + 3) * 132 + r] = bf2f(v.y >> 16);
            }
            {
                const int k = tid >> 5, n4 = (tid & 31) * 4, n = n0 + n4;
                f32x4 w = (f32x4){0.f, 0.f, 0.f, 0.f}, w2 = w;
                if (n < g.N) { w = *(const f32x4*)(g.W + (size_t)(k0 + k) * g.ldw + n); if (DUAL) w2 = *(const f32x4*)(g.W + (size_t)(k0 + k) * g.ldw + n + g.dual_off); }
                *(LAS f32x4*)(Bs + k * 128 + n4) = w;
                if (DUAL) *(LAS f32x4*)(Bs2 + k * 128 + n4) = w2;
            }
            __syncthreads();
#pragma unroll 2
            for (int kk = 0; kk < 16; ++kk) {
                const f32x4 a0 = *(const LAS f32x4*)(As + kk * 132 + ty * 8), a1 = *(const LAS f32x4*)(As + kk * 132 + ty * 8 + 4);
                const f32x4 b = *(const LAS f32x4*)(Bs + kk * 128 + tx * 4);
                const float a[8] = {a0.x, a0.y, a0.z, a0.w, a1.x, a1.y, a1.z, a1.w};
                const float bb[4] = {b.x, b.y, b.z, b.w};
#pragma unroll
                for (int i = 0; i < 8; ++i)
#pragma unroll
                    for (int j = 0; j < 4; ++j) acc[i][j] = fmaf(a[i], bb[j], acc[i][j]);
                if (DUAL) {
                    const f32x4 b2 = *(const LAS f32x4*)(Bs2 + kk * 128 + tx * 4);
                    const float b2b[4] = {b2.x, b2.y, b2.z, b2.w};
#pragma unroll
                    for (int i = 0; i < 8; ++i)
#pragma unroll
                        for (int j = 0; j < 4; ++j) acc2[i][j] = fmaf(a[i], b2b[j], acc2[i][j]);
                }
            }
            __syncthreads();
        }
#pragma unroll
        for (int i = 0; i < 8; ++i)
#pragma unroll
            for (int j = 0; j < 4; ++j) { const int n = n0 + tx * 4 + j; if (n < g.N) E(m0 + ty * 8 + i, n, acc[i][j], acc2[i][j]); }
    }
}

struct EpiProj {
    bf16_t *FQ, *FK, *FV, *DQ, *DK, *DV, *IQ, *IK; float *FL, *IW; const float* bforget;
    __device__ __forceinline__ void operator()(int m, int n, float v, float) const {
        const size_t r = (size_t)m;
        if (n < 512) FQ[r * 512 + n] = (bf16_t)f2bf(v * QSCALE);
        else if (n < 1024) FK[r * 512 + (n - 512)] = (bf16_t)f2bf(v);
        else if (n < 1536) FV[r * 512 + (n - 1024)] = (bf16_t)f2bf(v);
        else if (n < 1544) FL[r * 8 + (n - 1536)] = v + bforget[n - 1536];
        else if (n < 2056) DQ[r * 512 + (n - 1544)] = (bf16_t)f2bf(v * QSCALE);
        else if (n < 2568) DK[r * 512 + (n - 2056)] = (bf16_t)f2bf(v);
        else if (n < 3080) DV[r * 512 + (n - 2568)] = (bf16_t)f2bf(v);
        else if (n < 3592) IQ[r * 512 + (n - 3080)] = (bf16_t)f2bf(v);
        else if (n < 3656) IK[r * 64 + (n - 3592)] = (bf16_t)f2bf(v);
        else IW[r * 8 + (n - 3656)] = v;
    }
};
struct EpiGates {
    bf16_t *SGA, *SGB;
    __device__ __forceinline__ void operator()(int m, int n, float v, float) const {
        const float s = 1.f / (1.f + __expf(-v));
        if (n < 1024) SGA[(size_t)m * 1024 + n] = (bf16_t)f2bf(s); else SGB[(size_t)m * 1024 + (n - 1024)] = (bf16_t)f2bf(s);
    }
};
struct EpiBranchA { bf16_t* SGA;
    __device__ __forceinline__ void operator()(int m, int n, float v, float) const { bf16_t* q = SGA + (size_t)m * 1024 + n; *q = (bf16_t)f2bf(bf2f(*q) * v); } };
struct EpiBranchB { const bf16_t* MA; bf16_t* SGB;
    __device__ __forceinline__ void operator()(int m, int n, float v, float) const { const size_t o = (size_t)m * 1024 + n; SGB[o] = (bf16_t)f2bf(bf2f(MA[o]) + bf2f(SGB[o]) * v); } };
struct EpiResF32 { const float* xf; const bf16_t* xb; float* Y;
    __device__ __forceinline__ void operator()(int m, int n, float v, float) const { const size_t o = (size_t)m * 1024 + n; const float xv = xf ? xf[o] : bf2f(xb[o]); Y[o] = ALPHA * xv + v; } };
struct EpiSwiglu { bf16_t* H;
    __device__ __forceinline__ void operator()(int m, int n, float g, float u) const { const float s = g / (1.f + __expf(-g)); H[(size_t)m * DFF + n] = (bf16_t)f2bf(s * u); } };

namespace pg8 {
#define PG8_LAS __attribute__((address_space(3)))
typedef unsigned short bf16_t;
typedef short bf16x8 __attribute__((ext_vector_type(8)));
typedef float f32x4 __attribute__((ext_vector_type(4)));
typedef unsigned u32x4 __attribute__((ext_vector_type(4)));
constexpr int BM = 256, BK = 64, HALF = 128, HTB = HALF * BK * 2  , STAGE_BYTES = 8 * HTB, NXCD = 8, WGM = 8;

__host__ __device__ __forceinline__ int lds_byte(int r, int c) { const int st = (r >> 4) * 2 + (c >> 5), rr = r & 15, cc = c & 31, ob = rr * 64 + cc * 2; return st * 1024 + (ob ^ (((ob >> 9) & 1) << 5)); }
__host__ __device__ __forceinline__ void stage_rc(int b, int& R, int& C) { const int st = b / 1024, sb = b % 1024, swz = sb ^ (((sb >> 9) & 1) << 5); R = (st >> 1) * 16 + swz / 64; C = (st & 1) * 32 + (swz % 64) / 2; }
__host__ __device__ __forceinline__ int perm32(int rho) { const int n = rho >> 4, i = rho & 15; return 8 * (i >> 2) + 4 * n + (i & 3); }

struct Unit { int pm, pn; };
struct Gemm { const bf16_t* A; const bf16_t* Bt; int M, N, K; };

struct StaticOrder {
    int nM, nN, nwg, G, c;
    __host__ __device__ void init(int M, int N, int G_, int c_) { nM = M / BM; nN = N / BM; nwg = nM * nN; G = G_; c = c_; }
    __host__ __device__ bool next(int i, Unit& u) const {
        const long L = (long)i * G + c; if (L >= nwg) return false;
        int wgid = (int)L; { const int q = nwg / NXCD, r = nwg % NXCD, xcd = wgid % NXCD, off = wgid / NXCD; wgid = (xcd < r ? xcd * (q + 1) : r * (q + 1) + (xcd - r) * q) + off; }
        const int nig = WGM * nN, gid = wgid / nig, fm = gid * WGM, gsz = (nM - fm) < WGM ? (nM - fm) : WGM;
        u.pm = fm + ((wgid % nig) % gsz); u.pn = (wgid % nig) / gsz; return true;
    }
    __device__ __forceinline__ void a_ready(const Unit&) const {}
    __device__ __forceinline__ void done(const Unit&) const {}
};


typedef float f32x2_t __attribute__((ext_vector_type(2))); typedef __bf16 bf16x2_t __attribute__((ext_vector_type(2)));
__device__ __forceinline__ unsigned cvt_pk_bf16(float lo, float hi) { f32x2_t v = {lo, hi}; bf16x2_t b = __builtin_convertvector(v, bf16x2_t); return __builtin_bit_cast(unsigned, b); }
__device__ __forceinline__ float bflo(unsigned w) { return __uint_as_float(w << 16); }
__device__ __forceinline__ float bfhi(unsigned w) { return __uint_as_float(w & 0xffff0000u); }
__device__ __forceinline__ u32x4 pack8(const f32x4 v0, const f32x4 v1) { u32x4 w; w.x = cvt_pk_bf16(v0[0], v0[1]); w.y = cvt_pk_bf16(v0[2], v0[3]); w.z = cvt_pk_bf16(v1[0], v1[1]); w.w = cvt_pk_bf16(v1[2], v1[3]); return w; }
__device__ __forceinline__ float sigmoid_f(float v) { return __builtin_amdgcn_rcpf(1.0f + __builtin_amdgcn_exp2f(-1.4426950408889634f * v)); }

struct EpiProjF {
    static constexpr bool PERM = true, AFTER_DRAIN = false;
    bf16_t* QKV; size_t tstride; bf16_t* IK; float* FL; float* IW; const float* bforget; float qs;
    __device__ __forceinline__ void operator()(const f32x4 (&acc)[2][2][4][2], const Unit& u, int wr, int wc, int fr, int fq) const {
        const int row0 = u.pm * BM + wr * 64 + fr;
        if (u.pn < 14) {
            const int t = u.pn >> 1; const float sc = (t == 0 || t == 3) ? qs : 1.f;
            bf16_t* base = QKV + (size_t)t * tstride + (u.pn & 1) * 256 + wc * 32 + 8 * fq;
#pragma unroll
            for (int ai = 0; ai < 2; ++ai)
#pragma unroll
                for (int m = 0; m < 4; ++m) { bf16_t* rowp = base + (size_t)(row0 + ai * HALF + m * 16) * 512;
#pragma unroll
                    for (int bj = 0; bj < 2; ++bj) *(u32x4*)(rowp + bj * HALF) = pack8(acc[ai][bj][m][0] * sc, acc[ai][bj][m][1] * sc); }
        } else {
#pragma unroll
            for (int ai = 0; ai < 2; ++ai)
#pragma unroll
                for (int m = 0; m < 4; ++m) { const size_t row = (size_t)(row0 + ai * HALF + m * 16);
                    const f32x4 v0 = acc[ai][0][m][0], v1 = acc[ai][0][m][1];
                    if (wc < 2) *(u32x4*)(IK + row * 64 + wc * 32 + 8 * fq) = pack8(v0, v1);
                    else if (wc == 2 && fq == 0) { *(f32x4*)(FL + row * 8) = v0 + *(const f32x4*)bforget; *(f32x4*)(FL + row * 8 + 4) = v1 + *(const f32x4*)(bforget + 4); }
                    else if (wc == 2 && fq == 1) { *(f32x4*)(IW + row * 8) = v0; *(f32x4*)(IW + row * 8 + 4) = v1; } }
        }
    }
};
struct EpiGatesF {
    static constexpr bool PERM = true, AFTER_DRAIN = false;
    bf16_t* SG; size_t tstride;
    __device__ __forceinline__ void operator()(const f32x4 (&acc)[2][2][4][2], const Unit& u, int wr, int wc, int fr, int fq) const {
        const int row0 = u.pm * BM + wr * 64 + fr;
        bf16_t* base = SG + (size_t)(u.pn >> 2) * tstride + (u.pn & 3) * 256 + wc * 32 + 8 * fq;
#pragma unroll
        for (int ai = 0; ai < 2; ++ai)
#pragma unroll
            for (int m = 0; m < 4; ++m) { bf16_t* rowp = base + (size_t)(row0 + ai * HALF + m * 16) * 1024;
#pragma unroll
                for (int bj = 0; bj < 2; ++bj) { f32x4 v0 = acc[ai][bj][m][0], v1 = acc[ai][bj][m][1];
#pragma unroll
                    for (int e = 0; e < 4; ++e) { v0[e] = sigmoid_f(v0[e]); v1[e] = sigmoid_f(v1[e]); }
                    *(u32x4*)(rowp + bj * HALF) = pack8(v0, v1); } }
    }
};
template <int MODE> struct EpiBranchF {
    static constexpr bool PERM = true, AFTER_DRAIN = false;
    bf16_t* G; const bf16_t* MA;
    __device__ __forceinline__ void operator()(const f32x4 (&acc)[2][2][4][2], const Unit& u, int wr, int wc, int fr, int fq) const {
        const int row0 = u.pm * BM + wr * 64 + fr; const int col0 = u.pn * BM + wc * 32 + 8 * fq;
#pragma unroll
        for (int ai = 0; ai < 2; ++ai)
#pragma unroll
            for (int m = 0; m < 4; ++m) { const size_t off = (size_t)(row0 + ai * HALF + m * 16) * 1024 + col0;
#pragma unroll
                for (int bj = 0; bj < 2; ++bj) { const f32x4 a0 = acc[ai][bj][m][0], a1 = acc[ai][bj][m][1];
                    const u32x4 g = *(const u32x4*)(G + off + bj * HALF);
                    f32x4 v0 = (f32x4){bflo(g.x) * a0[0], bfhi(g.x) * a0[1], bflo(g.y) * a0[2], bfhi(g.y) * a0[3]};
                    f32x4 v1 = (f32x4){bflo(g.z) * a1[0], bfhi(g.z) * a1[1], bflo(g.w) * a1[2], bfhi(g.w) * a1[3]};
                    if (MODE == 1) { const u32x4 q = *(const u32x4*)(MA + off + bj * HALF);
                        v0 = v0 + (f32x4){bflo(q.x), bfhi(q.x), bflo(q.y), bfhi(q.y)}; v1 = v1 + (f32x4){bflo(q.z), bfhi(q.z), bflo(q.w), bfhi(q.w)}; }
                    *(u32x4*)(G + off + bj * HALF) = pack8(v0, v1); } }
    }
};
struct EpiResF {
    static constexpr bool PERM = true, AFTER_DRAIN = false;
    const float* xf; const bf16_t* xb; bf16_t* Y; float alpha;
    __device__ __forceinline__ void operator()(const f32x4 (&acc)[2][2][4][2], const Unit& u, int wr, int wc, int fr, int fq) const {
        const int row0 = u.pm * BM + wr * 64 + fr; const int col0 = u.pn * BM + wc * 32 + 8 * fq;
#pragma unroll
        for (int ai = 0; ai < 2; ++ai)
#pragma unroll
            for (int m = 0; m < 4; ++m) { const size_t off = (size_t)(row0 + ai * HALF + m * 16) * 1024 + col0;
#pragma unroll
                for (int bj = 0; bj < 2; ++bj) { const size_t o = off + bj * HALF; f32x4 x0, x1;
                    if (xf) { x0 = *(const f32x4*)(xf + o); x1 = *(const f32x4*)(xf + o + 4); }
                    else { const u32x4 w = *(const u32x4*)(xb + o); x0 = (f32x4){bflo(w.x), bfhi(w.x), bflo(w.y), bfhi(w.y)}; x1 = (f32x4){bflo(w.z), bfhi(w.z), bflo(w.w), bfhi(w.w)}; }
                    *(u32x4*)(Y + o) = pack8(x0 * alpha + acc[ai][bj][m][0], x1 * alpha + acc[ai][bj][m][1]); } }
    }
};
struct EpiSwigluF {
    static constexpr bool PERM = true, AFTER_DRAIN = false;
    bf16_t* H; int ldh;
    __device__ __forceinline__ void operator()(const f32x4 (&acc)[2][2][4][2], const Unit& u, int wr, int wc, int fr, int fq) const {
        const int row0 = u.pm * BM + wr * 64 + fr; const int col0 = u.pn * HALF + wc * 32 + 8 * fq;
#pragma unroll
        for (int ai = 0; ai < 2; ++ai)
#pragma unroll
            for (int m = 0; m < 4; ++m) { f32x4 v0, v1;
#pragma unroll
                for (int e = 0; e < 4; ++e) { const float g0 = acc[ai][0][m][0][e], g1 = acc[ai][0][m][1][e];
                    v0[e] = g0 * sigmoid_f(g0) * acc[ai][1][m][0][e]; v1[e] = g1 * sigmoid_f(g1) * acc[ai][1][m][1][e]; }
                *(u32x4*)(H + (size_t)(row0 + ai * HALF + m * 16) * ldh + col0) = pack8(v0, v1); }
    }
};

template <class Epi, class Sched, bool ALIGN_EPI = false, bool SP2 = false>
__device__ __forceinline__ void gemm_phase(PG8_LAS unsigned char* lds, const Gemm g, const Sched& S, const Epi& E) {
    const int tid = ltid(), wid = __builtin_amdgcn_readfirstlane(tid >> 6), lane = tid & 63, wr = wid >> 2, wc = wid & 3, fr = lane & 15, fq = lane >> 4;
    const int K = g.K, nt = K / BK;
    unsigned voffA[2], voffB[2];
#pragma unroll
    for (int i = 0; i < 2; ++i) { int R, C; stage_rc(tid * 16 + i * 8192, R, C); const int Rb = Epi::PERM ? ((R & ~31) + perm32(R & 31)) : R;
        voffA[i] = (unsigned)(R * K + C) * 2u; voffB[i] = (unsigned)(Rb * K + C) * 2u; }
    const size_t kstep = (size_t)(BK * 2);
    const size_t hstep = (size_t)HALF * K * 2;
    const size_t tstep = 2 * hstep;
    const unsigned ldsw = (unsigned)wid * 1024u;
    const int aoff = lds_byte(wr * 64 + fr, fq * 8), boff = lds_byte(wc * 32 + fr, fq * 8);
#define PG8_SA(b, h) (((b) * 2 + (h)) * HTB)
#define PG8_SB(b, h) ((4 + (b) * 2 + (h)) * HTB)
#define PG8_STAGE(bufoff, gbase, voff) do { _Pragma("unroll") for (int _i = 0; _i < 2; ++_i) \
        __builtin_amdgcn_global_load_lds((const unsigned*)((const char*)(gbase) + (voff)[_i]), (PG8_LAS unsigned*)(lds + (bufoff) + ldsw + _i * 8192), 16, 0, 0); } while (0)
#define PG8_LDA(dst, b, h) do { _Pragma("unroll") for (int m = 0; m < 4; ++m) _Pragma("unroll") for (int k = 0; k < 2; ++k) dst[m][k] = *(const PG8_LAS bf16x8*)(lds + PG8_SA(b, h) + aoff + m * 2048 + k * 1024); } while (0)
#define PG8_LDB(dst, b, h) do { _Pragma("unroll") for (int n = 0; n < 2; ++n) _Pragma("unroll") for (int k = 0; k < 2; ++k) dst[n][k] = *(const PG8_LAS bf16x8*)(lds + PG8_SB(b, h) + boff + n * 2048 + k * 1024); } while (0)
#define PG8_MMA(ai, bj, At, Bt) do { __builtin_amdgcn_s_setprio(1); _Pragma("unroll") for (int m = 0; m < 4; ++m) _Pragma("unroll") for (int n = 0; n < 2; ++n) _Pragma("unroll") for (int k = 0; k < 2; ++k) \
        acc[ai][bj][m][n] = __builtin_amdgcn_mfma_f32_16x16x32_bf16(Bt[n][k], At[m][k], acc[ai][bj][m][n], 0, 0, 0); __builtin_amdgcn_s_setprio(0); } while (0)
#define PG8_WAIT_V(n) asm volatile("s_waitcnt vmcnt(" #n ")" ::: "memory")
#define PG8_WAIT_L(n) asm volatile("s_waitcnt lgkmcnt(" #n ")" ::: "memory")
#define PG8_BAR __builtin_amdgcn_s_barrier()
#define PG8_SCHED __builtin_amdgcn_sched_barrier(0)
    Unit cur, nxt; int ui = 0;
    if (!S.next(0, cur)) return;
    f32x4 acc[2][2][4][2];
#pragma unroll
    for (int a = 0; a < 2; ++a)
#pragma unroll
        for (int b = 0; b < 2; ++b)
#pragma unroll
            for (int m = 0; m < 4; ++m)
#pragma unroll
                for (int n = 0; n < 2; ++n) acc[a][b][m][n] = (f32x4){0.f, 0.f, 0.f, 0.f};
    bf16x8 At[4][2], B0[2][2], B1[2][2];
    const char* cA = (const char*)g.A + (size_t)cur.pm * tstep; const char* cB = (const char*)g.Bt + (size_t)cur.pn * tstep;
    S.a_ready(cur);
    if constexpr (SP2) {
        PG8_STAGE(PG8_SB(0, 0), cB, voffB); PG8_STAGE(PG8_SB(0, 1), cB + hstep, voffB); PG8_STAGE(PG8_SA(0, 0), cA, voffA); PG8_STAGE(PG8_SA(0, 1), cA + hstep, voffA);
        if (wr == 1) PG8_BAR;
        PG8_WAIT_V(2); PG8_BAR;
        PG8_STAGE(PG8_SB(1, 0), cB + kstep, voffB); PG8_STAGE(PG8_SA(1, 0), cA + kstep, voffA); PG8_STAGE(PG8_SB(1, 1), cB + hstep + kstep, voffB);
        PG8_WAIT_V(6); PG8_BAR;
    } else {
        PG8_STAGE(PG8_SB(0, 0), cB, voffB); PG8_STAGE(PG8_SA(0, 0), cA, voffA); PG8_STAGE(PG8_SB(0, 1), cB + hstep, voffB); PG8_STAGE(PG8_SA(0, 1), cA + hstep, voffA);
        if (wr == 1) PG8_BAR;
        PG8_WAIT_V(4); PG8_BAR;
        PG8_STAGE(PG8_SB(1, 0), cB + kstep, voffB); PG8_STAGE(PG8_SA(1, 0), cA + kstep, voffA); PG8_STAGE(PG8_SB(1, 1), cB + hstep + kstep, voffB);
        PG8_WAIT_V(6); PG8_BAR;
    }
    for (;;) {
        const bool has_next = S.next(ui + 1, nxt);
        const char* nA = has_next ? (const char*)g.A + (size_t)nxt.pm * tstep : cA; const char* nB = has_next ? (const char*)g.Bt + (size_t)nxt.pn * tstep : cB;
        for (int t = 0; t < nt; t += 2) {
            const bool last = (t == nt - 2);
            const char* a1 = cA + (size_t)(t + 1) * kstep;
            const char* a2 = last ? nA : cA + (size_t)(t + 2) * kstep; const char* b2 = last ? nB : cB + (size_t)(t + 2) * kstep;
            const char* a3 = a2 + kstep; const char* b3 = b2 + kstep;
            if (last && has_next) S.a_ready(nxt);
            if constexpr (SP2) {
            PG8_LDB(B0, 0, 0); PG8_LDB(B1, 0, 1); PG8_SCHED; PG8_LDA(At, 0, 0); PG8_STAGE(PG8_SA(1, 1), a1 + hstep, voffA);
            PG8_WAIT_V(8); PG8_WAIT_L(0); PG8_BAR; PG8_MMA(0, 0, At, B0); PG8_MMA(0, 1, At, B1); PG8_BAR; PG8_SCHED;
            PG8_LDA(At, 0, 1); PG8_STAGE(PG8_SB(0, 0), b2, voffB); PG8_STAGE(PG8_SB(0, 1), b2 + hstep, voffB); PG8_STAGE(PG8_SA(0, 0), a2, voffA);
            PG8_WAIT_V(8); PG8_WAIT_L(0); PG8_BAR; PG8_MMA(1, 0, At, B0); PG8_MMA(1, 1, At, B1); PG8_BAR; PG8_SCHED;
            PG8_LDB(B0, 1, 0); PG8_LDB(B1, 1, 1); PG8_SCHED; PG8_LDA(At, 1, 0); PG8_STAGE(PG8_SA(0, 1), a2 + hstep, voffA);
            PG8_WAIT_V(8); PG8_WAIT_L(0); PG8_BAR; PG8_MMA(0, 0, At, B0); PG8_MMA(0, 1, At, B1); PG8_BAR; PG8_SCHED;
            PG8_LDA(At, 1, 1); PG8_STAGE(PG8_SB(1, 0), b3, voffB); PG8_STAGE(PG8_SB(1, 1), b3 + hstep, voffB); PG8_STAGE(PG8_SA(1, 0), a3, voffA);
            PG8_WAIT_V(8); PG8_WAIT_L(0); PG8_BAR; PG8_MMA(1, 0, At, B0); PG8_MMA(1, 1, At, B1); PG8_BAR; PG8_SCHED;
            } else {
            PG8_LDB(B0, 0, 0); PG8_SCHED; PG8_LDA(At, 0, 0); PG8_STAGE(PG8_SA(1, 1), a1 + hstep, voffA);
            PG8_WAIT_L(8); PG8_BAR; PG8_WAIT_L(0); PG8_MMA(0, 0, At, B0); PG8_BAR; PG8_SCHED;
            PG8_LDB(B1, 0, 1); PG8_STAGE(PG8_SB(0, 0), b2, voffB);
            PG8_BAR; PG8_WAIT_L(0); PG8_MMA(0, 1, At, B1); PG8_BAR;
            PG8_LDA(At, 0, 1); PG8_STAGE(PG8_SA(0, 0), a2, voffA);
            PG8_BAR; PG8_WAIT_L(0); PG8_MMA(1, 0, At, B0); PG8_BAR; PG8_SCHED;
            PG8_STAGE(PG8_SB(0, 1), b2 + hstep, voffB);
            PG8_WAIT_V(6); PG8_BAR; PG8_MMA(1, 1, At, B1); PG8_BAR;
            PG8_LDB(B0, 1, 0); PG8_SCHED; PG8_LDA(At, 1, 0); PG8_STAGE(PG8_SA(0, 1), a2 + hstep, voffA);
            PG8_WAIT_L(8); PG8_BAR; PG8_WAIT_L(0); PG8_MMA(0, 0, At, B0); PG8_BAR; PG8_SCHED;
            PG8_LDB(B1, 1, 1); PG8_STAGE(PG8_SB(1, 0), b3, voffB);
            PG8_BAR; PG8_WAIT_L(0); PG8_MMA(0, 1, At, B1); PG8_BAR;
            PG8_LDA(At, 1, 1); PG8_STAGE(PG8_SA(1, 0), a3, voffA);
            PG8_BAR; PG8_WAIT_L(0); PG8_MMA(1, 0, At, B0); PG8_BAR; PG8_SCHED;
            PG8_STAGE(PG8_SB(1, 1), b3 + hstep, voffB);
            PG8_WAIT_V(6); PG8_BAR; PG8_MMA(1, 1, At, B1); PG8_BAR;
            }
        }
        if constexpr (ALIGN_EPI) { if (wr == 0) PG8_BAR; }
        if constexpr (!Epi::AFTER_DRAIN) { E(acc, cur, wr, wc, fr, fq); S.done(cur); }
        if (!has_next) break;
#pragma unroll
        for (int a = 0; a < 2; ++a)
#pragma unroll
            for (int b = 0; b < 2; ++b)
#pragma unroll
                for (int m = 0; m < 4; ++m)
#pragma unroll
                    for (int n = 0; n < 2; ++n) acc[a][b][m][n] = (f32x4){0.f, 0.f, 0.f, 0.f};
        cur = nxt; cA = nA; cB = nB; ++ui;
        if constexpr (ALIGN_EPI) { if (wr == 1) PG8_BAR; }
    }
    PG8_WAIT_V(0);
    if constexpr (!ALIGN_EPI) { if (wr == 0) PG8_BAR; }
    PG8_BAR;
    if constexpr (Epi::AFTER_DRAIN) { E.fused(acc, cur, wr, wc, fr, fq, lds, wid, lane); S.done(cur); }
#undef PG8_SA
#undef PG8_SB
#undef PG8_STAGE
#undef PG8_LDA
#undef PG8_LDB
#undef PG8_MMA
#undef PG8_WAIT_V
#undef PG8_WAIT_L
#undef PG8_BAR
#undef PG8_SCHED
}
}

__device__ __forceinline__ void cvt_phase(const P& p, int wg, int nwg) {
    bf16_t* XB = WSP(bf16_t, WS_XB);
    const size_t n4 = (size_t)M * D / 4;
    const int tid = ltid();
    for (size_t i = (size_t)wg * NT + tid; i < n4; i += (size_t)nwg * NT) {
        const f32x4 v = ((const f32x4*)p.x)[i];
        u32x2 o; o.x = f2bf(v.x) | (f2bf(v.y) << 16); o.y = f2bf(v.z) | (f2bf(v.w) << 16);
        ((u32x2*)XB)[i] = o;
    }
}

__device__ __forceinline__ void cum_phase(const P& p, LAS unsigned char* lds, int wg, int nwg) {
    const float* FL = WSP(const float, WS_FL); float* CUM = WSP(float, WS_CUM);
    LAS float* wsum = (LAS float*)lds;
    const int tid = ltid(), lane = tid & 63, wv = tid >> 6;
    for (int it = wg; it < NB * NH; it += nwg) {
        const int b = it / NH, h = it % NH;
        float v[8]; float s = 0.f;
#pragma unroll
        for (int j = 0; j < 8; ++j) { const int t = tid * 8 + j; const float z = FL[((size_t)b * L + t) * 8 + h];
            const float ls = fminf(z, 0.f) - log1pf(__expf(-fabsf(z))); s += ls; v[j] = s; }
        float incl = s;
#pragma unroll
        for (int o = 1; o < 64; o <<= 1) { const float u = __shfl_up(incl, o); if (lane >= o) incl += u; }
        if (lane == 63) wsum[wv] = incl;
        __syncthreads();
        float base = incl - s;
        for (int w = 0; w < wv; ++w) base += wsum[w];
#pragma unroll
        for (int j = 0; j < 8; ++j) CUM[((size_t)b * NH + h) * L + tid * 8 + j] = base + v[j];
        __syncthreads();
    }
}

__device__ __forceinline__ void norm_phase(const P& p, unsigned* kmax2, float* qmax2, int wg, int nwg) {
    const int tid = ltid(), lane = tid & 63;
    for (int it = wg; it < 512; it += nwg) {
        const int mixer = it >> 8, bh = (it >> 2) & 63, qt = it & 3, b = bh >> 3, h = bh & 7;
        const bf16_t* Q = mixer ? WSP(const bf16_t, WS_DQ) : WSP(const bf16_t, WS_FQ); const bf16_t* K = mixer ? WSP(const bf16_t, WS_DK) : WSP(const bf16_t, WS_FK);
        float qm = 0.f, km = 0.f;
#pragma unroll
        for (int j = 0; j < 2; ++j) {
            const size_t row = (size_t)b * L + qt * 1024 + tid * 2 + j;
            const u32x4* qr = (const u32x4*)(Q + row * 512 + h * 64); const u32x4* kr = (const u32x4*)(K + row * 512 + h * 64);
            float qs = 0.f, ks = 0.f;
#pragma unroll
            for (int c = 0; c < 8; ++c) { const u32x4 a = qr[c], d = kr[c];
                const float q0 = bf2f(a.x & 0xffffu), q1 = __uint_as_float(a.x & 0xffff0000u), q2 = bf2f(a.y & 0xffffu), q3 = __uint_as_float(a.y & 0xffff0000u), q4 = bf2f(a.z & 0xffffu), q5 = __uint_as_float(a.z & 0xffff0000u), q6 = bf2f(a.w & 0xffffu), q7 = __uint_as_float(a.w & 0xffff0000u);
                const float k0 = bf2f(d.x & 0xffffu), k1 = __uint_as_float(d.x & 0xffff0000u), k2 = bf2f(d.y & 0xffffu), k3 = __uint_as_float(d.y & 0xffff0000u), k4 = bf2f(d.z & 0xffffu), k5 = __uint_as_float(d.z & 0xffff0000u), k6 = bf2f(d.w & 0xffffu), k7 = __uint_as_float(d.w & 0xffff0000u);
                qs += (q0 * q0 + q1 * q1) + (q2 * q2 + q3 * q3) + (q4 * q4 + q5 * q5) + (q6 * q6 + q7 * q7);
                ks += (k0 * k0 + k1 * k1) + (k2 * k2 + k3 * k3) + (k4 * k4 + k5 * k5) + (k6 * k6 + k7 * k7); }
            qm = fmaxf(qm, qs); km = fmaxf(km, ks);
        }
#pragma unroll
        for (int o = 1; o < 64; o <<= 1) { qm = fmaxf(qm, __shfl_xor(qm, o)); km = fmaxf(km, __shfl_xor(km, o)); }
        if (lane == 0) {
            __hip_atomic_fetch_max((unsigned*)qmax2 + (mixer * 64 + bh) * 16 + qt * 4 + (tid >> 7), __float_as_uint(qm * 1.01f), __ATOMIC_RELAXED, __HIP_MEMORY_SCOPE_AGENT);
            __hip_atomic_fetch_max(kmax2 + mixer * 64 + bh, __float_as_uint(km * 1.01f), __ATOMIC_RELAXED, __HIP_MEMORY_SCOPE_AGENT);
        }
    }
}

__device__ __forceinline__ void ln_phase(const bf16_t* Y, const float* g, const float* bta, bf16_t* XO, float* FO, int wg, int nwg) {
    const int tid = ltid(), lane = tid & 63, wv = tid >> 6;
    for (int m = wg * 8 + wv; m < M; m += nwg * 8) {
        const u32x4* yr = (const u32x4*)(Y + (size_t)m * D) + 2 * lane;
        const u32x4 a = yr[0], b = yr[1];
        float v[16] = {bf2f(a.x & 0xffffu), __uint_as_float(a.x & 0xffff0000u), bf2f(a.y & 0xffffu), __uint_as_float(a.y & 0xffff0000u), bf2f(a.z & 0xffffu), __uint_as_float(a.z & 0xffff0000u), bf2f(a.w & 0xffffu), __uint_as_float(a.w & 0xffff0000u),
                       bf2f(b.x & 0xffffu), __uint_as_float(b.x & 0xffff0000u), bf2f(b.y & 0xffffu), __uint_as_float(b.y & 0xffff0000u), bf2f(b.z & 0xffffu), __uint_as_float(b.z & 0xffff0000u), bf2f(b.w & 0xffffu), __uint_as_float(b.w & 0xffff0000u)};
        float s = 0.f;
#pragma unroll
        for (int j = 0; j < 16; ++j) s += v[j];
#pragma unroll
        for (int o = 1; o < 64; o <<= 1) s += __shfl_xor(s, o);
        const float mean = s * (1.f / D); float s2 = 0.f;
#pragma unroll
        for (int j = 0; j < 16; ++j) { v[j] -= mean; s2 += v[j] * v[j]; }
#pragma unroll
        for (int o = 1; o < 64; o <<= 1) s2 += __shfl_xor(s2, o);
        const float rstd = 1.f / sqrtf(s2 * (1.f / D) + LN_EPS);
        const f32x4* gp = (const f32x4*)g + 4 * lane; const f32x4* bp = (const f32x4*)bta + 4 * lane;
        f32x4 o4[4];
#pragma unroll
        for (int j = 0; j < 4; ++j) { const f32x4 gg = gp[j], bb = bp[j]; o4[j] = (f32x4){v[4 * j], v[4 * j + 1], v[4 * j + 2], v[4 * j + 3]} * rstd * gg + bb; }
        if (XO) { u32x4 w0, w1;
            w0.x = f2bf(o4[0].x) | (f2bf(o4[0].y) << 16); w0.y = f2bf(o4[0].z) | (f2bf(o4[0].w) << 16); w0.z = f2bf(o4[1].x) | (f2bf(o4[1].y) << 16); w0.w = f2bf(o4[1].z) | (f2bf(o4[1].w) << 16);
            w1.x = f2bf(o4[2].x) | (f2bf(o4[2].y) << 16); w1.y = f2bf(o4[2].z) | (f2bf(o4[2].w) << 16); w1.z = f2bf(o4[3].x) | (f2bf(o4[3].y) << 16); w1.w = f2bf(o4[3].z) | (f2bf(o4[3].w) << 16);
            u32x4* xo = (u32x4*)(XO + (size_t)m * D) + 2 * lane; xo[0] = w0; xo[1] = w1; }
        else { f32x4* fo = (f32x4*)(FO + (size_t)m * D) + 4 * lane;
#pragma unroll
            for (int j = 0; j < 4; ++j) fo[j] = o4[j]; }
    }
}

__device__ __forceinline__ unsigned sortable(float f) { const unsigned u = __float_as_uint(f); return (u & 0x80000000u) ? ~u : (u | 0x80000000u); }
__device__ __forceinline__ unsigned wg_sum(unsigned c, LAS unsigned* buf, int par, int tid) {
#pragma unroll
    for (int o = 1; o < 64; o <<= 1) c += __shfl_xor(c, o);
    if ((tid & 63) == 0) buf[par * 8 + (tid >> 6)] = c;
    __syncthreads();
    unsigned s = 0;
#pragma unroll
    for (int w = 0; w < 8; ++w) s += buf[par * 8 + w];
    return s;
}
__device__ __forceinline__ void idx_phase(const P& p, LAS unsigned char* lds, int wg, int nwg) {
    const bf16_t* IQ = WSP(const bf16_t, WS_IQ); const bf16_t* IK = WSP(const bf16_t, WS_IK); const float* IW = WSP(const float, WS_IW);
    unsigned* MASK = WSP(unsigned, WS_MASK);
    LAS float* iqs = (LAS float*)lds;
    LAS float* wv = iqs + 512;
    LAS unsigned* cbuf = (LAS unsigned*)(wv + 8);
    LAS unsigned* wtot = cbuf + 16;
    LAS unsigned char* bytes = (LAS unsigned char*)(wtot + 8);
    LAS unsigned* sc = (LAS unsigned*)(bytes + 512);
    const int tid = ltid(), lane = tid & 63, wave = tid >> 6;
    for (int row = wg; row < M; row += nwg) {
        const int b = row / L, t = row % L, n = t + 1;
        iqs[tid] = bf2f(IQ[(size_t)row * 512 + tid]);
        if (tid < 8) wv[tid] = IW[(size_t)row * 8 + tid] * IDX_SCALE;
        __syncthreads();
        for (int s = tid; s < L; s += NT) {
            unsigned key = 0u;
            if (s < n) {
                float kf[64];
                const u32x4* kr = (const u32x4*)(IK + ((size_t)b * L + s) * 64);
#pragma unroll
                for (int c = 0; c < 8; ++c) { const u32x4 v = kr[c];
                    kf[c * 8 + 0] = bf2f(v.x & 0xffffu); kf[c * 8 + 1] = bf2f(v.x >> 16); kf[c * 8 + 2] = bf2f(v.y & 0xffffu); kf[c * 8 + 3] = bf2f(v.y >> 16);
                    kf[c * 8 + 4] = bf2f(v.z & 0xffffu); kf[c * 8 + 5] = bf2f(v.z >> 16); kf[c * 8 + 6] = bf2f(v.w & 0xffffu); kf[c * 8 + 7] = bf2f(v.w >> 16); }
                float score = 0.f;
#pragma unroll 1
                for (int h = 0; h < 8; ++h) {
                    float d0 = 0.f, d1 = 0.f;
#pragma unroll
                    for (int d = 0; d < 64; d += 4) { const f32x4 q = *(const LAS f32x4*)(iqs + h * 64 + d);
                        d0 = fmaf(q.x, kf[d], d0); d1 = fmaf(q.y, kf[d + 1], d1); d0 = fmaf(q.z, kf[d + 2], d0); d1 = fmaf(q.w, kf[d + 3], d1); }
                    score = fmaf(wv[h], fmaxf(d0 + d1, 0.f), score);
                }
                key = sortable(score + 0.f);
                if (key == 0u) key = 1u;
            }
            sc[s] = key;
        }
        __syncthreads();
        unsigned k8[8];
#pragma unroll
        for (int j = 0; j < 8; ++j) k8[j] = sc[tid * 8 + j];
        unsigned bits = 0u;
        if (n <= TOPK) {
#pragma unroll
            for (int j = 0; j < 8; ++j) if (tid * 8 + j < n) bits |= 1u << j;
        } else {
            unsigned T = 0u; int par = 0;
            for (int bit = 31; bit >= 0; --bit) {
                const unsigned cand = T | (1u << bit); unsigned c = 0;
#pragma unroll
                for (int j = 0; j < 8; ++j) c += (k8[j] >= cand) ? 1u : 0u;
                if (wg_sum(c, cbuf, par, tid) >= (unsigned)TOPK) T = cand;
                par ^= 1;
            }
            unsigned cg = 0, ce = 0;
#pragma unroll
            for (int j = 0; j < 8; ++j) { cg += (k8[j] > T) ? 1u : 0u; ce += (k8[j] == T) ? 1u : 0u; }
            const unsigned G = wg_sum(cg, cbuf, par, tid); par ^= 1;
            const unsigned E = (unsigned)TOPK - G;
            unsigned incl = ce;
#pragma unroll
            for (int o = 1; o < 64; o <<= 1) { const unsigned u = __shfl_up(incl, o); if (lane >= o) incl += u; }
            if (lane == 63) wtot[wave] = incl;
            __syncthreads();
            unsigned rank = incl - ce;
            for (int w = 0; w < wave; ++w) rank += wtot[w];
#pragma unroll
            for (int j = 0; j < 8; ++j) {
                if (k8[j] > T) bits |= 1u << j;
                else if (k8[j] == T) { if (rank < E) bits |= 1u << j; ++rank; }
            }
        }
        bytes[tid] = (unsigned char)bits;
        __syncthreads();
        if (tid < 128) MASK[(size_t)row * 128 + tid] = ((const LAS unsigned*)bytes)[tid];
        __syncthreads();
    }
}

template <bool DSA>
__device__ __forceinline__ void attn_item(const P& p, int item) {
    const int qc = item & 7, h = (item >> 3) & 7, b = item >> 6;
    const int t = qc * 512 + ltid();
    const size_t row = (size_t)b * L + t;
    const bf16_t* Q = DSA ? WSP(const bf16_t, WS_DQ) : WSP(const bf16_t, WS_FQ);
    const bf16_t* K = DSA ? WSP(const bf16_t, WS_DK) : WSP(const bf16_t, WS_FK);
    const bf16_t* V = DSA ? WSP(const bf16_t, WS_DV) : WSP(const bf16_t, WS_FV);
    bf16_t* O = DSA ? WSP(bf16_t, WS_OB) : WSP(bf16_t, WS_OA);
    const float* cum = WSP(const float, WS_CUM) + ((size_t)b * NH + h) * L;
    const unsigned* mrow = WSP(const unsigned, WS_MASK) + row * 128;
    float q[64], o[64];
    {
        const u32x4* qr = (const u32x4*)(Q + row * 512 + h * 64);
#pragma unroll
        for (int c = 0; c < 8; ++c) { const u32x4 v = qr[c];
            q[c * 8 + 0] = bf2f(v.x & 0xffffu); q[c * 8 + 1] = bf2f(v.x >> 16); q[c * 8 + 2] = bf2f(v.y & 0xffffu); q[c * 8 + 3] = bf2f(v.y >> 16);
            q[c * 8 + 4] = bf2f(v.z & 0xffffu); q[c * 8 + 5] = bf2f(v.z >> 16); q[c * 8 + 6] = bf2f(v.w & 0xffffu); q[c * 8 + 7] = bf2f(v.w >> 16); }
    }
#pragma unroll
    for (int d = 0; d < 64; ++d) o[d] = 0.f;
    float mx = -1e30f, l = 0.f;
    const float ct = DSA ? 0.f : cum[t] * LOG2E;
    const float slope2 = exp2f(-(float)(h + 1)) * LOG2E;
    const int tmax = __builtin_amdgcn_readfirstlane(t | 63);
    const bf16_t* Kh = K + (size_t)b * L * 512 + h * 64;
    const bf16_t* Vh = V + (size_t)b * L * 512 + h * 64;
    for (int s0 = 0; s0 <= tmax; s0 += 2) {
        float xv[2]; bool ok[2];
        const unsigned mb = DSA ? (mrow[s0 >> 5] >> (s0 & 31)) : 0x3u;
#pragma unroll
        for (int j = 0; j < 2; ++j) {
            const int s = s0 + j;
            const u32x4* kr = (const u32x4*)(Kh + (size_t)s * 512);
            float d0 = 0.f, d1 = 0.f;
#pragma unroll
            for (int c = 0; c < 8; ++c) { const u32x4 v = kr[c];
                d0 = fmaf(q[c * 8 + 0], bf2f(v.x & 0xffffu), d0); d1 = fmaf(q[c * 8 + 1], bf2f(v.x >> 16), d1);
                d0 = fmaf(q[c * 8 + 2], bf2f(v.y & 0xffffu), d0); d1 = fmaf(q[c * 8 + 3], bf2f(v.y >> 16), d1);
                d0 = fmaf(q[c * 8 + 4], bf2f(v.z & 0xffffu), d0); d1 = fmaf(q[c * 8 + 5], bf2f(v.z >> 16), d1);
                d0 = fmaf(q[c * 8 + 6], bf2f(v.w & 0xffffu), d0); d1 = fmaf(q[c * 8 + 7], bf2f(v.w >> 16), d1); }
            const float dot = d0 + d1;
            ok[j] = (s <= t) && ((mb >> j) & 1u);
            const float xx = DSA ? (dot - slope2 * (float)(t - s)) : (dot + (ct - cum[s] * LOG2E));
            xv[j] = ok[j] ? xx : -1e30f;
        }
        const float mnew = fmaxf(fmaxf(xv[0], xv[1]), mx);
        const float alpha = exp2f(mx - mnew);
        mx = mnew; l *= alpha;
#pragma unroll
        for (int d = 0; d < 64; ++d) o[d] *= alpha;
#pragma unroll
        for (int j = 0; j < 2; ++j) {
            const int s = s0 + j;
            const float pj = ok[j] ? exp2f(xv[j] - mnew) : 0.f;
            l += pj;
            const u32x4* vr = (const u32x4*)(Vh + (size_t)s * 512);
#pragma unroll
            for (int c = 0; c < 8; ++c) { const u32x4 v = vr[c];
                o[c * 8 + 0] = fmaf(pj, bf2f(v.x & 0xffffu), o[c * 8 + 0]); o[c * 8 + 1] = fmaf(pj, bf2f(v.x >> 16), o[c * 8 + 1]);
                o[c * 8 + 2] = fmaf(pj, bf2f(v.y & 0xffffu), o[c * 8 + 2]); o[c * 8 + 3] = fmaf(pj, bf2f(v.y >> 16), o[c * 8 + 3]);
                o[c * 8 + 4] = fmaf(pj, bf2f(v.z & 0xffffu), o[c * 8 + 4]); o[c * 8 + 5] = fmaf(pj, bf2f(v.z >> 16), o[c * 8 + 5]);
                o[c * 8 + 6] = fmaf(pj, bf2f(v.w & 0xffffu), o[c * 8 + 6]); o[c * 8 + 7] = fmaf(pj, bf2f(v.w >> 16), o[c * 8 + 7]); }
        }
    }
    const float rl = 1.f / l;
    u32x4* orow = (u32x4*)(O + row * 512 + h * 64);
#pragma unroll
    for (int c = 0; c < 8; ++c) { u32x4 w;
        w.x = f2bf(o[c * 8 + 0] * rl) | (f2bf(o[c * 8 + 1] * rl) << 16); w.y = f2bf(o[c * 8 + 2] * rl) | (f2bf(o[c * 8 + 3] * rl) << 16);
        w.z = f2bf(o[c * 8 + 4] * rl) | (f2bf(o[c * 8 + 5] * rl) << 16); w.w = f2bf(o[c * 8 + 6] * rl) | (f2bf(o[c * 8 + 7] * rl) << 16);
        orow[c] = w; }
}
__device__ __forceinline__ void attn_phase_naive(const P& p, int wg, int nwg) {
    for (int it = wg; it < 1024; it += nwg) {
        const int r = it >> 1; const int item = (r & ~7) | (7 - (r & 7));
        if (it & 1) attn_item<true>(p, item); else attn_item<false>(p, item);
    }
}

#include <hip/hip_bf16.h>
#include <cmath>
namespace attn_body {
using bf16=__hip_bfloat16;
using bf16x8=__attribute__((ext_vector_type(8)))short;
using s16x4=__attribute__((ext_vector_type(4)))short;
using f32x16=__attribute__((ext_vector_type(16)))float;
using u32x4=__attribute__((ext_vector_type(4)))unsigned;
typedef float f32x4_t __attribute__((ext_vector_type(4)));
constexpr int BATCH=8,NHEAD=8,SEQ=4096,D=64,DM=NHEAD*D;
constexpr int NW=8,QBLK=32,QB=QBLK*NW,KVBLK=64,NQB=SEQ/QB;
constexpr int ATTN_PITCH=DM, ATTN_UNIT_ROWS=QB;
__device__ __forceinline__ int crow(int r,int hi){return (r&3)+8*(r>>2)+4*hi;}
#define SBAR() __builtin_amdgcn_sched_barrier(0)
__device__ __forceinline__ void cmask(f32x16&p0,f32x16&p1,int jb,int qrel,int hi){
  const float NEG=-INFINITY; int kb=64*jb+4*hi;
  #pragma unroll
  for(int r=0;r<16;++r){int kv=kb+(r&3)+8*(r>>2); if(kv>qrel)p0[r]=NEG; if(kv+32>qrel)p1[r]=NEG;}
}

constexpr int NSLOT=3, SLOTB=8192;
constexpr int LDS_K=0, LDS_V=NSLOT*SLOTB, LDS_WS=2*NSLOT*SLOTB, LDS_OST=LDS_WS+NW*64*4, LDS_TAB=LDS_OST+NW*4096, LDS_BYTES=LDS_TAB+SEQ*4;
constexpr float C2=0.125f*1.4426950408889634f;
__device__ __forceinline__ void glds16(const void*gsrc,unsigned lds_dst){unsigned keep;
  asm volatile("s_mov_b32 %0, m0\n\ts_mov_b32 m0, %2\n\ts_nop 0\n\tglobal_load_lds_dwordx4 %1, off\n\ts_mov_b32 m0, %0":"=&s"(keep):"v"(gsrc),"s"(lds_dst):"memory");}
__device__ __forceinline__ float max3f(float a,float b,float c){float r;asm("v_max3_f32 %0, %1, %2, %3":"=v"(r):"v"(a),"v"(b),"v"(c));return r;}
__device__ __forceinline__ float max2f(float a,float b){float r;asm("v_max_f32_e32 %0, %1, %2":"=v"(r):"v"(a),"v"(b));return r;}
__device__ __forceinline__ float fadd_s(float a,float b){float r;asm("v_add_f32_e32 %0, %1, %2":"=v"(r):"v"(a),"v"(b));return r;}
__device__ __forceinline__ float fsub_s(float a,float b){float r;asm("v_sub_f32_e32 %0, %1, %2":"=v"(r):"v"(a),"v"(b));return r;}
typedef float f32x2_t __attribute__((ext_vector_type(2))); typedef __bf16 bf16x2_t __attribute__((ext_vector_type(2)));
__device__ __forceinline__ unsigned cvtpk_s(float lo,float hi){f32x2_t v={lo,hi};bf16x2_t b=__builtin_convertvector(v,bf16x2_t);return __builtin_bit_cast(unsigned,b);}
#define WAIT_BAR(N) asm volatile("s_waitcnt vmcnt(" #N ") lgkmcnt(0)\n\ts_barrier":::"memory")

__device__ __forceinline__ void qkt(f32x16&p0,f32x16&p1,const char*Kslot,const bf16x8*qr,const f32x16&negm,int r32,int hi){
  const char*kb=Kslot+hi*1024+r32*16;
  #pragma unroll
  for(int d0=0;d0<4;++d0){
    const bf16x8 b0=*reinterpret_cast<const bf16x8*>(kb+d0*2048);
    const bf16x8 b1=*reinterpret_cast<const bf16x8*>(kb+d0*2048+512);
    if(d0==0){p0=__builtin_amdgcn_mfma_f32_32x32x16_bf16(b0,qr[0],negm,0,0,0);p1=__builtin_amdgcn_mfma_f32_32x32x16_bf16(b1,qr[0],negm,0,0,0);}
    else{p0=__builtin_amdgcn_mfma_f32_32x32x16_bf16(b0,qr[d0],p0,0,0,0);p1=__builtin_amdgcn_mfma_f32_32x32x16_bf16(b1,qr[d0],p1,0,0,0);}}
}
typedef __attribute__((address_space(3))) const char* lds_cptr;
typedef short v4i16_t __attribute__((ext_vector_type(4)));
__device__ __forceinline__ void kload8(bf16x8*kf,lds_cptr kp){
  kf[0]=*(const __attribute__((address_space(3))) bf16x8*)(kp);      kf[1]=*(const __attribute__((address_space(3))) bf16x8*)(kp+512);
  kf[2]=*(const __attribute__((address_space(3))) bf16x8*)(kp+2048); kf[3]=*(const __attribute__((address_space(3))) bf16x8*)(kp+2560);
  kf[4]=*(const __attribute__((address_space(3))) bf16x8*)(kp+4096); kf[5]=*(const __attribute__((address_space(3))) bf16x8*)(kp+4608);
  kf[6]=*(const __attribute__((address_space(3))) bf16x8*)(kp+6144); kf[7]=*(const __attribute__((address_space(3))) bf16x8*)(kp+6656);
}
__device__ __forceinline__ void kload2(bf16x8*kf,lds_cptr kp,int j){ kf[2*j]=*(const __attribute__((address_space(3))) bf16x8*)(kp+j*2048); kf[2*j+1]=*(const __attribute__((address_space(3))) bf16x8*)(kp+j*2048+512); }
__device__ __forceinline__ s16x4 vtr(lds_cptr p){ return __builtin_bit_cast(s16x4,__builtin_amdgcn_ds_read_tr16_b64_v4i16((__attribute__((address_space(3))) v4i16_t*)p)); }
__device__ __forceinline__ float rowmax(const f32x16&p0,const f32x16&p1){
  float a=max3f(p0[0],p0[1],p1[0]),b=max3f(p0[2],p0[3],p1[1]);a=max3f(a,p1[2],p1[3]);
  #pragma unroll
  for(int r=4;r<16;r+=4){a=max3f(a,p0[r],p0[r+1]);b=max3f(b,p0[r+2],p0[r+3]);a=max3f(a,p1[r],p1[r+1]);b=max3f(b,p1[r+2],p1[r+3]);}
  const float m=max2f(a,b);
  auto rr=__builtin_amdgcn_permlane32_swap(__float_as_uint(m),__float_as_uint(m),false,false);
  return max2f(__uint_as_float(rr[0]),__uint_as_float(rr[1]));
}
__device__ __forceinline__ void pv(f32x16*o,int vb,bf16x8 pa0,bf16x8 pa1,bf16x8 pa2,bf16x8 pa3){
  #pragma unroll
  for(int d0=0;d0<2;++d0){s16x4 lo[4],hi[4];
    #pragma unroll
    for(int ks=0;ks<4;++ks){
      asm volatile("ds_read_b64_tr_b16 %0,%1 offset:%c2":"=&v"(lo[ks]):"v"(vb),"i"(d0*4096+ks*1024):"memory");
      asm volatile("ds_read_b64_tr_b16 %0,%1 offset:%c2":"=&v"(hi[ks]):"v"(vb),"i"(d0*4096+ks*1024+512):"memory");}
    asm volatile("s_waitcnt lgkmcnt(0)":::"memory");SBAR();
    #define PK(k) (bf16x8){lo[k][0],lo[k][1],lo[k][2],lo[k][3],hi[k][0],hi[k][1],hi[k][2],hi[k][3]}
    o[d0]=__builtin_amdgcn_mfma_f32_32x32x16_bf16(pa0,PK(0),o[d0],0,0,0);
    o[d0]=__builtin_amdgcn_mfma_f32_32x32x16_bf16(pa1,PK(1),o[d0],0,0,0);
    o[d0]=__builtin_amdgcn_mfma_f32_32x32x16_bf16(pa2,PK(2),o[d0],0,0,0);
    o[d0]=__builtin_amdgcn_mfma_f32_32x32x16_bf16(pa3,PK(3),o[d0],0,0,0);
    #undef PK
  }
}

#ifndef ATTN_STORE16
#define ATTN_STORE16(p,v) (*(u32x4*)(p)=(v))
#endif
template<int THRL,bool DSA> __device__ __forceinline__ void attn_unit(int b,int h,int qb,int jstart,const bf16*Q,const bf16*__restrict__ K,const bf16*__restrict__ V,bf16*O,const unsigned*__restrict__ MASK,char*shm){
  const int tid=ltid(),lane=tid&63,r32=lane&31,hi=lane>>5; const int wid=__builtin_amdgcn_readfirstlane(tid>>6);
  const long rowbase=(long)b*SEQ; const int q0=qb*QB;
  const bf16*Qw=Q+(rowbase+q0+wid*QBLK)*DM+h*D;
  const bf16*Kh=K+(rowbase+(long)jstart*KVBLK)*DM+h*D,*Vh=V+(rowbase+(long)jstart*KVBLK)*DM+h*D;
  const unsigned lds0=(unsigned)(uintptr_t)shm;
  float*wsf=(float*)(shm+LDS_WS)+wid*64;
  const bf16*ksrc=Kh+(long)lane*DM+wid*8;
  const bf16*vsrc=Vh+(long)(16*(wid&3)+(lane>>2))*DM+(wid>>2)*32+(lane&3)*8;
  const unsigned kdst=lds0+LDS_K+wid*1024, vdst=lds0+LDS_V+wid*1024;
  #define DMA_K(t,slot) glds16(ksrc+(long)(t)*KVBLK*DM,(unsigned)__builtin_amdgcn_readfirstlane(kdst+(slot)))
  #define DMA_V(t,slot) glds16(vsrc+(long)(t)*KVBLK*DM,(unsigned)__builtin_amdgcn_readfirstlane(vdst+(slot)))
  const int vb0=(int)(lds0+LDS_V)+((lane>>4)&1)*32+(lane&3)*8+(4*hi+((lane&15)>>2))*64;
  const char*Kbase=shm+LDS_K; bf16x8 kf[8];
  const lds_cptr shm3=(lds_cptr)shm; const lds_cptr kp0=shm3+LDS_K+hi*1024+r32*16; const lds_cptr vp0=shm3+LDS_V+((lane>>4)&1)*32+(lane&3)*8+(4*hi+((lane&15)>>2))*64;
  const int NT=(q0+QB)/KVBLK-jstart;
  DMA_K(0,0);DMA_V(0,0);DMA_K(1,SLOTB);
  bf16x8 qr[4];
  #pragma unroll
  for(int d0=0;d0<4;++d0)qr[d0]=*reinterpret_cast<const bf16x8*>(&Qw[(long)r32*DM+d0*16+hi*8]);
  float mhat=0.f,l_reg=0.f;f32x16 o[2];o[0]=f32x16{};o[1]=f32x16{};f32x16 negm=f32x16{};
  const int qrel=wid*QBLK+r32;
  const __attribute__((address_space(3))) float* tabp0=(const __attribute__((address_space(3))) float*)((lds_cptr)shm+LDS_TAB); const __attribute__((address_space(3))) float* tabp=tabp0+jstart*KVBLK;
  const unsigned moff=(unsigned)((((b*(SEQ/32)+((q0+qrel)>>5))*64+jstart)*32+((q0+qrel)&31))*8);
  unsigned long long mw=0ull;
  #define CMASK(P0,P1,t) do{ if(!DSA){int jb_=(t)-(NT-4); if(jb_>=0)cmask(P0,P1,jb_,qrel,hi);} }while(0)
  #define BIAS(P0,P1,t) do{ const __attribute__((address_space(3))) float* tb_=tabp+(t)*64+4*hi; \
    _Pragma("unroll") for(int g_=0;g_<4;++g_){ const f32x4_t a_=*(const __attribute__((address_space(3))) f32x4_t*)(tb_+8*g_), b_=*(const __attribute__((address_space(3))) f32x4_t*)(tb_+32+8*g_); \
      _Pragma("unroll") for(int e_=0;e_<4;++e_){ P0[4*g_+e_]-=a_[e_]; P1[4*g_+e_]-=b_[e_]; } } }while(0)
  #define MLOAD(t) do{ if(DSA) mw=*(const unsigned long long*)((const char*)MASK+(moff+(unsigned)(t)*256u)); }while(0)
  #define DMASK(P0,P1) do{ if(DSA){ const unsigned w0_=~((unsigned)mw>>(4*hi)), w1_=~((unsigned)(mw>>32)>>(4*hi)); \
    _Pragma("unroll") for(int r=0;r<16;++r){ const unsigned c_=(r&3)+8*(r>>2); \
      const float t0_=__uint_as_float(((unsigned)__builtin_amdgcn_sbfe((int)w0_,c_,1u)&0x80000000u)|0x7f800000u), t1_=__uint_as_float(((unsigned)__builtin_amdgcn_sbfe((int)w1_,c_,1u)&0x80000000u)|0x7f800000u); \
      P0[r]=__builtin_fminf(P0[r],t0_); P1[r]=__builtin_fminf(P1[r],t1_); } } }while(0)
  bool resc=false;
  #define START(P0,P1) do{ const float rm=__builtin_fmaxf(rowmax(P0,P1),-4000.f); resc=false; \
    { const float dl=rm; mhat=fadd_s(mhat,dl); \
      _Pragma("unroll") for(int r=0;r<16;++r){P0[r]=fsub_s(P0[r],dl);P1[r]=fsub_s(P1[r],dl);} \
      _Pragma("unroll") for(int r=0;r<16;++r)negm[r]=-mhat; asm volatile("":"+v"(negm)); } \
    _Pragma("unroll") for(int r=0;r<16;++r)P0[r]=__builtin_amdgcn_exp2f(P0[r]); }while(0)
  #define RESC() do{ if(resc){ asm volatile("s_waitcnt lgkmcnt(0)":::"memory"); \
      _Pragma("unroll") for(int d_=0;d_<2;++d_) _Pragma("unroll") for(int r=0;r<16;++r)o[d_][r]*=wsf[crow(r,hi)]; } }while(0)
  f32x16 pA0,pA1,pB0,pB1;
  int sl_prev=0,sl_cur=0,sl_next=SLOTB;
  #define ROT() do{sl_prev=sl_cur;sl_cur=sl_next;sl_next=(sl_next==(NSLOT-1)*SLOTB)?0:sl_next+SLOTB;}while(0)
  DMA_K(2,2*SLOTB);
  MLOAD(0);
  WAIT_BAR(3);
  { const float tq=tabp0[q0+qrel]; mhat=-tq; _Pragma("unroll") for(int r=0;r<16;++r)negm[r]=tq; asm volatile("":"+v"(negm)); }
  qkt(pA0,pA1,Kbase,qr,negm,r32,hi);asm volatile("s_nop 15\n\ts_nop 7":"+v"(pA0),"+v"(pA1));BIAS(pA0,pA1,0);DMASK(pA0,pA1);CMASK(pA0,pA1,0);
  START(pA0,pA1);
  _Pragma("unroll") for(int r=0;r<16;++r)pA1[r]=__builtin_amdgcn_exp2f(pA1[r]);
  WAIT_BAR(0);
  DMA_K(3,0);DMA_V(1,SLOTB);
  MLOAD(1);
  ROT();
  kload8(kf,kp0+sl_cur);
  #define WB2() do{ if(DSA){WAIT_BAR(3);} else {WAIT_BAR(2);} }while(0)
  WB2();
  s16x4 vlo[8],vhi[8]; u32x4 pw0,pw1,pw2,pw3;
  #define PKW(P,B) cvtpk_s(P[B],P[B+1])
  #define PAF(k) __builtin_bit_cast(bf16x8,pw##k)
  #define VFR(i) (bf16x8){vlo[i][0],vlo[i][1],vlo[i][2],vlo[i][3],vhi[i][0],vhi[i][1],vhi[i][2],vhi[i][3]}
  #define PIN(x) asm volatile("":"+v"(x))
  #define MX3(a,b,c) __builtin_fmaxf(__builtin_fmaxf((a),(b)),(c))
  #define GAPA(MF,A0,A1,A2,A3,W0,W1,PW) do{ MF; sacc+=A0; sacc+=A1; sacc+=A2; sacc+=A3; PIN(sacc); W0; W1; PIN(PW); SBAR(); }while(0)
  #define EX(v) __builtin_amdgcn_exp2f(v)
  #define GAPB(MF,X,B) do{ MF; X[B]=EX(X[B]); X[B+1]=EX(X[B+1]); X[B+2]=EX(X[B+2]); X[B+3]=EX(X[B+3]); PIN(X); SBAR(); }while(0)
  #define VRD(i) do{ vlo[i]=vtr(vp_+(((i)>>2)*4096+((i)&3)*1024)); vhi[i]=vtr(vp_+(((i)>>2)*4096+((i)&3)*1024+512)); }while(0)
  #define KRD(G,j) do{ if(G){ kload2(kf,kp0+sl_next,j); SBAR(); } }while(0)
  #define STEP(C0,C1,P0,P1,t,GK,GV,GL) do{ SBAR(); \
    const lds_cptr vp_=vp0+sl_prev; \
    VRD(0); SBAR(); float sacc=(P0[0]+P0[1]); \
    GAPA(C0=__builtin_amdgcn_mfma_f32_32x32x16_bf16(kf[0],qr[0],negm,0,0,0), P0[2],P0[3],P0[4],P0[5],     pw0[0]=PKW(P0,0), pw0[1]=PKW(P0,2), pw0); \
    VRD(4); SBAR(); GAPA(C1=__builtin_amdgcn_mfma_f32_32x32x16_bf16(kf[1],qr[0],negm,0,0,0), P0[6],P0[7],P0[8],P0[9],     pw0[2]=PKW(P0,4), pw0[3]=PKW(P0,6), pw0); \
    VRD(1); SBAR(); GAPA(C0=__builtin_amdgcn_mfma_f32_32x32x16_bf16(kf[2],qr[1],C0,0,0,0),   P0[10],P0[11],P0[12],P0[13], pw1[0]=PKW(P0,8), pw1[1]=PKW(P0,10), pw1); \
    VRD(5); SBAR(); GAPA(C1=__builtin_amdgcn_mfma_f32_32x32x16_bf16(kf[3],qr[1],C1,0,0,0),   P0[14],P0[15],P1[0],P1[1],   pw1[2]=PKW(P0,12),pw1[3]=PKW(P0,14), pw1); \
    VRD(2); SBAR(); GAPA(C0=__builtin_amdgcn_mfma_f32_32x32x16_bf16(kf[4],qr[2],C0,0,0,0),   P1[2],P1[3],P1[4],P1[5],     pw2[0]=PKW(P1,0), pw2[1]=PKW(P1,2), pw2); \
    VRD(6); SBAR(); GAPA(C1=__builtin_amdgcn_mfma_f32_32x32x16_bf16(kf[5],qr[2],C1,0,0,0),   P1[6],P1[7],P1[8],P1[9],     pw2[2]=PKW(P1,4), pw2[3]=PKW(P1,6), pw2); \
    VRD(3); SBAR(); GAPA(C0=__builtin_amdgcn_mfma_f32_32x32x16_bf16(kf[6],qr[3],C0,0,0,0),   P1[10],P1[11],P1[12],P1[13], pw3[0]=PKW(P1,8), pw3[1]=PKW(P1,10), pw3); \
    VRD(7); SBAR(); GAPA(C1=__builtin_amdgcn_mfma_f32_32x32x16_bf16(kf[7],qr[3],C1,0,0,0),   P1[14],P1[15],0.f,0.f,       pw3[2]=PKW(P1,12),pw3[3]=PKW(P1,14), pw3); \
    l_reg+=sacc; \
    BIAS(C0,C1,t); DMASK(C0,C1); \
    if(GK){DMA_K((t)+3,sl_cur);} if(GV){DMA_V((t)+1,sl_next); MLOAD((t)+1);} \
    CMASK(C0,C1,t); \
    { float a=MX3(C0[0],C0[1],C1[0]),b=MX3(C0[2],C0[3],C1[1]); a=MX3(a,C1[2],C1[3]); \
      _Pragma("unroll") for(int r=4;r<16;r+=4){a=MX3(a,C0[r],C0[r+1]);b=MX3(b,C0[r+2],C0[r+3]);a=MX3(a,C1[r],C1[r+1]);b=MX3(b,C1[r+2],C1[r+3]);} \
      float rm=__builtin_fmaxf(a,b); { auto rr=__builtin_amdgcn_permlane32_swap(__float_as_uint(rm),__float_as_uint(rm),false,false); rm=__builtin_fmaxf(__uint_as_float(rr[0]),__uint_as_float(rr[1])); } \
      resc=false; \
      if(__builtin_expect(__any(rm>(float)THRL),0)){ const float dl=__builtin_fmaxf(rm,0.f); mhat+=dl; \
        _Pragma("unroll") for(int r=0;r<16;++r){C0[r]-=dl;C1[r]-=dl;} \
        _Pragma("unroll") for(int r=0;r<16;++r)negm[r]=-mhat; asm volatile("":"+v"(negm)); \
        const float f=__builtin_amdgcn_exp2f(-dl); l_reg*=f; if(hi==0)wsf[r32]=f; resc=true; } } \
    SBAR(); \
    GAPB(o[0]=__builtin_amdgcn_mfma_f32_32x32x16_bf16(PAF(0),VFR(0),o[0],0,0,0), C0,0); \
    GAPB(o[1]=__builtin_amdgcn_mfma_f32_32x32x16_bf16(PAF(0),VFR(4),o[1],0,0,0), C0,4); \
    KRD(GL,0); GAPB(o[0]=__builtin_amdgcn_mfma_f32_32x32x16_bf16(PAF(1),VFR(1),o[0],0,0,0), C0,8); \
    KRD(GL,1); GAPB(o[1]=__builtin_amdgcn_mfma_f32_32x32x16_bf16(PAF(1),VFR(5),o[1],0,0,0), C0,12); \
    KRD(GL,2); GAPB(o[0]=__builtin_amdgcn_mfma_f32_32x32x16_bf16(PAF(2),VFR(2),o[0],0,0,0), C1,0); \
    KRD(GL,3); GAPB(o[1]=__builtin_amdgcn_mfma_f32_32x32x16_bf16(PAF(2),VFR(6),o[1],0,0,0), C1,4); \
    GAPB(o[0]=__builtin_amdgcn_mfma_f32_32x32x16_bf16(PAF(3),VFR(3),o[0],0,0,0), C1,8); \
    GAPB(o[1]=__builtin_amdgcn_mfma_f32_32x32x16_bf16(PAF(3),VFR(7),o[1],0,0,0), C1,12); \
    }while(0)
  int t=1;
  #undef CMASK
  #define CMASK(P0,P1,t) do{}while(0)
  for(;t+5<NT;t+=2){
    STEP(pB0,pB1,pA0,pA1,t,true,true,true);     WB2(); RESC(); ROT();
    STEP(pA0,pA1,pB0,pB1,t+1,true,true,true);   WB2(); RESC(); ROT();
  }
  #undef CMASK
  #define CMASK(P0,P1,t) do{ if(!DSA){int jb_=(t)-(NT-4); if(jb_>=0)cmask(P0,P1,jb_,qrel,hi);} }while(0)
  #define ENDW(tt) do{ if((tt)+3<NT){WB2();} else if((tt)+2<NT){ if(DSA){WAIT_BAR(2);} else {WAIT_BAR(1);} } else { if(DSA){WAIT_BAR(1);} else {WAIT_BAR(0);} } }while(0)
  for(;t+1<NT;t+=2){
    STEP(pB0,pB1,pA0,pA1,t,(t+3<NT),(t+1<NT),(t+1<NT));       ENDW(t);   RESC(); ROT();
    STEP(pA0,pA1,pB0,pB1,t+1,(t+4<NT),(t+2<NT),(t+2<NT));     ENDW(t+1); RESC(); ROT();
  }
  STEP(pB0,pB1,pA0,pA1,NT-1,false,false,false); RESC();
  { float sacc=pB0[0]+pB0[1]; _Pragma("unroll") for(int r=2;r<16;++r)sacc+=pB0[r]; _Pragma("unroll") for(int r=0;r<16;++r)sacc+=pB1[r]; l_reg+=sacc;
    pw0=(u32x4){PKW(pB0,0),PKW(pB0,2),PKW(pB0,4),PKW(pB0,6)};pw1=(u32x4){PKW(pB0,8),PKW(pB0,10),PKW(pB0,12),PKW(pB0,14)};pw2=(u32x4){PKW(pB1,0),PKW(pB1,2),PKW(pB1,4),PKW(pB1,6)};pw3=(u32x4){PKW(pB1,8),PKW(pB1,10),PKW(pB1,12),PKW(pB1,14)};
    SBAR(); pv(o,vb0+sl_cur,PAF(0),PAF(1),PAF(2),PAF(3)); }
  #undef PKW
  #undef PAF
  #undef VFR
  #undef PIN
  #undef MX3
  #undef GAPA
  #undef GAPB
  #undef EX
  #undef VRD
  #undef KRD
  #undef STEP
  #undef ENDW
  #undef WB2
  {auto rr=__builtin_amdgcn_permlane32_swap(__float_as_uint(l_reg),__float_as_uint(l_reg),false,false);l_reg=__uint_as_float(rr[0])+__uint_as_float(rr[1]);}
  if(hi==0)wsf[32+r32]=l_reg;asm volatile("s_waitcnt lgkmcnt(0)":::"memory");
  float rli[16];
  #pragma unroll
  for(int r=0;r<16;++r)rli[r]=__builtin_amdgcn_rcpf(wsf[32+crow(r,hi)]);
  bf16*Ow=O+(rowbase+q0+wid*QBLK)*DM+h*D;
  { bf16*stg=(bf16*)(shm+LDS_OST)+wid*2048;
    #pragma unroll
    for(int r=0;r<16;++r){const int orow=crow(r,hi);
      #pragma unroll
      for(int d0=0;d0<2;++d0)stg[orow*64+d0*32+r32]=__float2bfloat16(o[d0][r]*rli[r]);}
    asm volatile("s_waitcnt lgkmcnt(0)":::"memory");
    #pragma unroll
    for(int i=0;i<4;++i){const int row=i*8+(lane>>3),ch=lane&7; const u32x4 v=*(const u32x4*)(stg+row*64+ch*8); ATTN_STORE16(Ow+(long)row*DM+ch*8,v);} }
  asm volatile("s_waitcnt lgkmcnt(0)\n\ts_barrier":::"memory");
  #undef DMA_K
  #undef DMA_V
  #undef CMASK
  #undef BIAS
  #undef MLOAD
  #undef DMASK
  #undef START
  #undef RESC
  #undef ROT
}
constexpr int ATTN_LDS_BYTES=LDS_BYTES;
struct AttnTensors { const bf16 *FQ,*FK,*FV,*DQ,*DK,*DV; bf16 *OA,*OB; const float* CUM; const unsigned* MASK;
  unsigned* qhead; const unsigned* kmax2; const float* qmax2; const unsigned* blk; };
template<bool DSA> __device__ __forceinline__ void fill_tab(int b,int h,const float*CUM,char*shm){
  __attribute__((address_space(3))) float* tab=(__attribute__((address_space(3))) float*)((lds_cptr)shm+LDS_TAB);
  const int tid=ltid(); const float L2E=1.4426950408889634f;
  if(DSA){ const float sl=__builtin_amdgcn_exp2f(-(float)(h+1))*L2E;
    #pragma unroll
    for(int j=0;j<8;++j){ const int s_=tid*8+j; tab[s_]=-sl*(float)s_; } }
  else { const f32x4_t* c=(const f32x4_t*)(CUM+((size_t)b*NHEAD+h)*SEQ)+tid*2; const f32x4_t a=c[0],d=c[1];
    *(__attribute__((address_space(3))) f32x4_t*)(tab+tid*8)=a*L2E; *(__attribute__((address_space(3))) f32x4_t*)(tab+tid*8+4)=d*L2E; }
  asm volatile("s_waitcnt vmcnt(0) lgkmcnt(0)\n\ts_barrier":::"memory");
}
template<int THRL=8,class MK> __device__ __forceinline__ void attn_phase(char*lds,unsigned char*ws_,const MK&mk,volatile __attribute__((address_space(3))) unsigned* slot){
  const float CUT=64.f;
  for(;;){
    unsigned char* wsl; { size_t z=0; asm volatile("":"+s"(z)); wsl=ws_+z; }
    const AttnTensors T=mk(wsl);
    if(ltid()==0) slot[0]=__hip_atomic_fetch_add(T.qhead,1u,__ATOMIC_RELAXED,__HIP_MEMORY_SCOPE_AGENT);
    asm volatile("s_waitcnt vmcnt(0) lgkmcnt(0)\n\ts_barrier":::"memory");
    const unsigned u=slot[0];
    if(u>=2u*BATCH*NHEAD*NQB) break;
    const int qb=NQB-1-(int)(u>>7), r=(int)(u&127u), mixer=r>>6, bh=r&63, b=bh>>3, h=bh&7, q0=qb*QB, NTfull=(q0+QB)/KVBLK;
    const float qk=__builtin_sqrtf(T.qmax2[(mixer*64+bh)*NQB+qb]*__uint_as_float(T.kmax2[mixer*64+bh]));
    const float bound=2.f*qk+1.f+CUT;
    const __attribute__((address_space(3))) float* tab=(const __attribute__((address_space(3))) float*)((lds_cptr)lds+LDS_TAB);
    int jstart=0;
    if(mixer==0){
      fill_tab<false>(b,h,T.CUM,lds);
      const int lane=ltid()&63; const int sk=64*lane+63;
      const bool skip=(lane<NTfull)&&(tab[q0]-tab[sk<SEQ?sk:SEQ-1]+bound<0.f)&&(bound==bound);
      const unsigned long long m=__ballot(skip);
      jstart=(~m==0ull)?64:__builtin_ctzll(~m);
    } else {
      fill_tab<true>(b,h,T.CUM,lds);
      const float sl=__builtin_amdgcn_exp2f(-(float)(h+1))*1.4426950408889634f;
      const int smin=SEQ-1-(int)T.blk[b*NQB+qb];
      const float f=((float)smin-bound/sl)*(1.f/64.f);
      jstart=(f>0.f&&bound==bound)?(int)f:0;
    }
    jstart=__builtin_amdgcn_readfirstlane(jstart)&~1; if(jstart>NTfull-4) jstart=NTfull-4; if(jstart<0) jstart=0;
    if(mixer==0) attn_unit<THRL,false>(b,h,qb,jstart,T.FQ,T.FK,T.FV,T.OA,T.MASK,lds);
    else         attn_unit<THRL,true >(b,h,qb,jstart,T.DQ,T.DK,T.DV,T.OB,T.MASK,lds);
  }
}
#undef SBAR
#undef WAIT_BAR
}

namespace idx_body {
using bf16x8=__attribute__((ext_vector_type(8)))short;
using f32x16=__attribute__((ext_vector_type(16)))float;
typedef float f32x4_t __attribute__((ext_vector_type(4)));
typedef unsigned u32x4_t __attribute__((ext_vector_type(4)));
typedef unsigned short u16x2_t __attribute__((ext_vector_type(2)));
#define ILAS __attribute__((address_space(3)))
constexpr int SEQ=4096, TOPK=256;
constexpr int LDS_SH=0, LDS_SL=65536, LDS_BYTES=131072;
__device__ __forceinline__ float relu_f(float x){ const int b=__builtin_bit_cast(int,x); return __builtin_bit_cast(float,b>0?b:0); }
__device__ __forceinline__ unsigned skey(float f){ const unsigned u=__float_as_uint(f+0.f); return (u&0x80000000u)?~u:(u|0x80000000u); }
__device__ __forceinline__ int wave_sum(int v){
  v+=__builtin_amdgcn_update_dpp(0,v,0xB1,0xF,0xF,true);
  v+=__builtin_amdgcn_update_dpp(0,v,0x4E,0xF,0xF,true);
  v+=__builtin_amdgcn_update_dpp(0,v,0x141,0xF,0xF,true);
  v+=__builtin_amdgcn_update_dpp(0,v,0x140,0xF,0xF,true);
  v+=__builtin_amdgcn_update_dpp(0,v,0x142,0xA,0xF,false);
  v+=__builtin_amdgcn_update_dpp(0,v,0x143,0xC,0xF,false);
  return __builtin_amdgcn_readlane(v,63);
}
__device__ __forceinline__ int wave_max(int v){
  v=max(v,__builtin_amdgcn_update_dpp(v,v,0xB1,0xF,0xF,false)); v=max(v,__builtin_amdgcn_update_dpp(v,v,0x4E,0xF,0xF,false));
  v=max(v,__builtin_amdgcn_update_dpp(v,v,0x141,0xF,0xF,false)); v=max(v,__builtin_amdgcn_update_dpp(v,v,0x140,0xF,0xF,false));
  v=max(v,__builtin_amdgcn_update_dpp(v,v,0x142,0xA,0xF,false)); v=max(v,__builtin_amdgcn_update_dpp(v,v,0x143,0xC,0xF,false));
  return __builtin_amdgcn_readlane(v,63);
}
__device__ __forceinline__ unsigned pk_count(unsigned acc,unsigned x,unsigned cm1r,unsigned one2){
  unsigned tmp;
  asm("v_pk_sub_u16 %1, %2, %3 clamp\n\tv_pk_min_u16 %1, %1, %4\n\tv_pk_add_u16 %0, %0, %1":"+v"(acc),"=&v"(tmp):"v"(x),"v"(cm1r),"v"(one2));
  return acc;
}
struct AW { bf16x8 a[2][4]; f32x4_t w[2][4]; };
__device__ __forceinline__ void load_a(AW&x,const unsigned short*__restrict__ IQ,size_t rowb,int kl,int hh){
  asm volatile("":"+v"(kl),"+v"(hh));
  const int g=kl>>3, hr=(kl>>2)&1, e=kl&3, aq=2*hr+(g>>1), ahead=4*(g&1)+e;
  #pragma unroll
  for(int at=0;at<2;++at){
    const unsigned short* ap=IQ+(rowb+4*at+aq)*512+ahead*64+8*hh;
    #pragma unroll
    for(int ks=0;ks<4;++ks) x.a[at][ks]=__builtin_bit_cast(bf16x8,*(const u32x4_t*)(ap+16*ks));
  }
}
__device__ __forceinline__ void load_w(AW&x,const float*__restrict__ IW,size_t rowb,int hh,float idx_scale){
  asm volatile("":"+v"(hh));
  #pragma unroll
  for(int at=0;at<2;++at){
    const f32x4_t* wp=(const f32x4_t*)(IW+(rowb+4*at+2*hh)*8);
    #pragma unroll
    for(int k=0;k<4;++k) x.w[at][k]=wp[k]*idx_scale;
  }
}
__device__ __forceinline__ void hu_coords(int v,int hu,int&b,int&tb){ b=v>>5; const int r=v&31, i=hu>>1, p=r+32*(i>>1), qi=(i&1)?255-p:p; tb=qi*16+8*(hu&1); }
__device__ __forceinline__ void idx_phase_fast(ILAS unsigned char*lds,const unsigned short*__restrict__ IQ,const unsigned short*__restrict__ IK,const float*__restrict__ IW,unsigned*__restrict__ MASK,unsigned*__restrict__ BLK,float idx_scale,int vcu,int ncu){
  const int tid=ltid(),lane=tid&63,kl=lane&31,hh=lane>>5; const int wave=__builtin_amdgcn_readfirstlane(tid>>6);
  for(int v=vcu;v<256;v+=ncu){
    int b,tb; hu_coords(v,0,b,tb);
    AW cur; load_a(cur,IQ,(size_t)b*SEQ+tb,kl,hh); load_w(cur,IW,(size_t)b*SEQ+tb,hh,idx_scale);
    bf16x8 b0[4],b1[4],b2[4];
    #define LDBX(dst,kt_,nkt_,bb_) do{ const int ktc_=(kt_)<(nkt_)?(kt_):(nkt_)-1; int kl_=kl,hh_=hh; asm volatile("":"+v"(kl_),"+v"(hh_)); const u32x4_t* kp_=(const u32x4_t*)(IK+((size_t)(bb_)*SEQ+kl_)*64+8*hh_+(size_t)ktc_*2048); \
      _Pragma("unroll") for(int ks=0;ks<4;++ks) dst[ks]=__builtin_bit_cast(bf16x8,kp_[2*ks]); }while(0)
    #pragma unroll 1
    for(int hu=0;hu<16;++hu){
      hu_coords(v,hu,b,tb);
      const size_t rowb=(size_t)b*SEQ+tb;
      const int nkt=(tb+8+31)>>5;
      const int tqb=tb+2*hh;
      #define LDB(dst,kt_) LDBX(dst,kt_,nkt,b)
      #define SCORE(bb,kt_) do{ const int s=32*(kt_)+kl; const int sidx=((s>>7)<<6)+(s&63), sh=(s>>6)&1; \
        _Pragma("unroll") for(int at=0;at<2;++at){ \
          f32x16 c=f32x16{}; \
          _Pragma("unroll") for(int ks=0;ks<4;++ks) c=__builtin_amdgcn_mfma_f32_32x32x16_bf16(cur.a[at][ks],bb[ks],c,0,0,0); \
          float s0=0.f,s1=0.f; \
          _Pragma("unroll") for(int q=0;q<4;++q){ s0=__builtin_fmaf(cur.w[at][0][q],relu_f(c[q]),s0); s0=__builtin_fmaf(cur.w[at][1][q],relu_f(c[4+q]),s0); \
                                s1=__builtin_fmaf(cur.w[at][2][q],relu_f(c[8+q]),s1); s1=__builtin_fmaf(cur.w[at][3][q],relu_f(c[12+q]),s1); } \
          const int tq=tqb+4*at; \
          const unsigned k0=(s<=tq)?skey(s0):0u, k1=(s<=tq+1)?skey(s1):0u; \
          ILAS unsigned short* ph=(ILAS unsigned short*)(lds+LDS_SH)+((4*at+2*hh)*2048+sidx)*2+sh; \
          ILAS unsigned short* pl=(ILAS unsigned short*)(lds+LDS_SL)+((4*at+2*hh)*2048+sidx)*2+sh; \
          ph[0]=(unsigned short)(k0>>16); pl[0]=(unsigned short)k0; ph[4096]=(unsigned short)(k1>>16); pl[4096]=(unsigned short)k1; } }while(0)
      {
        LDB(b0,wave); LDB(b1,wave+8);
        int kt=wave;
        #pragma unroll 1
        for(;kt<nkt;kt+=24){
          LDB(b2,kt+16); SCORE(b0,kt); __builtin_amdgcn_sched_barrier(0);
          if(kt+8<nkt){ LDB(b0,kt+24); SCORE(b1,kt+8); } __builtin_amdgcn_sched_barrier(0);
          if(kt+16<nkt){ LDB(b1,kt+32); SCORE(b2,kt+16); } __builtin_amdgcn_sched_barrier(0);
        }
      }
      #undef LDB
      #undef SCORE
      int nb=b,ntb=tb; if(hu+1<16){ hu_coords(v,hu+1,nb,ntb); load_a(cur,IQ,(size_t)nb*SEQ+ntb,kl,hh); }
      asm volatile("s_waitcnt lgkmcnt(0)\n\ts_barrier":::"memory");
#ifndef IDX_REP_B
#define IDX_REP_B 1
#endif
      _Pragma("unroll 1") for(int repB=0;repB<IDX_REP_B;++repB)
      {
        const int t=tb+wave; const int ngrp=(t>>10)+1;
        const ILAS unsigned* SHq=(const ILAS unsigned*)(lds+LDS_SH)+wave*2048+lane; const ILAS unsigned* SLq=(const ILAS unsigned*)(lds+LDS_SL)+wave*2048+lane;
        unsigned kh[32],kw[32];
        #pragma unroll
        for(int gI=0;gI<4;++gI){
          if(gI<ngrp){
            #pragma unroll
            for(int i=8*gI;i<8*gI+8;++i){ kh[i]=SHq[64*i]; kw[i]=SLq[64*i]; }
          } else {
            #pragma unroll
            for(int i=8*gI;i<8*gI+8;++i){ kh[i]=0u; kw[i]=0u; }
          }
        }
        #pragma unroll
        for(int gI=0;gI<4;++gI){ if(gI==ngrp-1){
          #pragma unroll
          for(int i=8*gI;i<8*gI+8;++i){ const unsigned m=((128*i+lane<=t)?0xffffu:0u)|((128*i+64+lane<=t)?0xffff0000u:0u); kh[i]&=m; kw[i]&=m; } } }
        unsigned T=1u; int X=0;
        unsigned one2=0x00010001u; asm volatile("":"+v"(one2));
        if(t>=TOPK){
          unsigned Thi=0u; int cntHi=0, G1=0; bool done=false;
          for(int bb=14;bb>=0;bb-=2){
            const unsigned c1=Thi|(1u<<bb), c2=Thi|(2u<<bb), c3=Thi|(3u<<bb);
            const unsigned m1=(c1-1u)*0x10001u, m2=(c2-1u)*0x10001u, m3=(c3-1u)*0x10001u;
            unsigned a1[2]={0u,0u},a2[2]={0u,0u},a3[2]={0u,0u};
            #pragma unroll
            for(int gI=0;gI<4;++gI){ if(gI<ngrp){
              #pragma unroll
              for(int i=8*gI;i<8*gI+8;++i){ a1[i&1]=pk_count(a1[i&1],kh[i],m1,one2); a2[i&1]=pk_count(a2[i&1],kh[i],m2,one2); a3[i&1]=pk_count(a3[i&1],kh[i],m3,one2); } } }
            const unsigned s1=a1[0]+a1[1], s2=a2[0]+a2[1], s3=a3[0]+a3[1];
            const int n12=wave_sum((int)(((s1&0xffffu)+(s1>>16))|(((s2&0xffffu)+(s2>>16))<<16)));
            const int n3=wave_sum((int)((s3&0xffffu)+(s3>>16)));
            const int n1=n12&0xffff, n2=(int)((unsigned)n12>>16);
            int nj;
            if(n3>=TOPK){ Thi=c3; nj=n3; } else if(n2>=TOPK){ Thi=c2; nj=n2; G1=n3; } else if(n1>=TOPK){ Thi=c1; nj=n1; G1=n2; } else { nj=0; G1=n1; }
            if(nj>0){ cntHi=nj; if(nj==TOPK){ done=true; break; } }
          }
          T=Thi<<16; X=0;
          if(!done){
            { const unsigned thr=Thi*0x10001u; const u16x2_t one={1,1}, ffff={0xffff,0xffff};
              #pragma unroll
              for(int gI=0;gI<4;++gI){ if(gI<ngrp){
                #pragma unroll
                for(int i=8*gI;i<8*gI+8;++i){ u16x2_t x=__builtin_bit_cast(u16x2_t,kh[i]^thr); x=__builtin_elementwise_min(x,one); x=(one-x)*ffff; kw[i]&=__builtin_bit_cast(unsigned,x); } } } }
            unsigned Tlo=0u; int cntT=cntHi;
            for(int bit=15;bit>=0;--bit){
              const unsigned cand=Tlo|(1u<<bit), cm1r=(cand-1u)*0x10001u; unsigned ac[4]={0u,0u,0u,0u};
              #pragma unroll
              for(int gI=0;gI<4;++gI){ if(gI<ngrp){
                #pragma unroll
                for(int i=8*gI;i<8*gI+8;++i) ac[i&3]=pk_count(ac[i&3],kw[i],cm1r,one2); } }
              const unsigned acc=(ac[0]+ac[1])+(ac[2]+ac[3]);
              const int cnt=G1+wave_sum((int)((acc&0xffffu)+(acc>>16)));
              if(cnt>=TOPK){ Tlo=cand; cntT=cnt; if(cnt==TOPK) break; }
            }
            T=(Thi<<16)|Tlo; X=cntT-TOPK;
          }
        }
        unsigned long long mine=0ull;
        #pragma unroll
        for(int gI=3;gI>=0;--gI){ if(gI<ngrp){
          #pragma unroll
          for(int i=8*gI+7;i>=8*gI;--i){
            const unsigned keyA=(kh[i]<<16)|(kw[i]&0xffffu), keyB=(kh[i]&0xffff0000u)|(kw[i]>>16);
            unsigned long long balB=__ballot(keyB>=T), balA=__ballot(keyA>=T);
            if(X>0){ unsigned long long eq=__ballot(keyB==T);
              while(X>0&&eq!=0ull){ const int hb=63-__builtin_clzll(eq); balB&=~(1ull<<hb); eq&=~(1ull<<hb); --X; }
              eq=__ballot(keyA==T);
              while(X>0&&eq!=0ull){ const int hb=63-__builtin_clzll(eq); balA&=~(1ull<<hb); eq&=~(1ull<<hb); --X; } }
            if(lane==2*i) mine=balA;
            if(lane==2*i+1) mine=balB;
          } } }
        { int ln_=lane; asm volatile("":"+v"(ln_)); const unsigned off_=(unsigned)((((b*128+(t>>5))*64+ln_)*32+(t&31))*8); *(unsigned long long*)((char*)MASK+off_)=mine; }
        if(hu+1<16) load_w(cur,IW,(size_t)nb*SEQ+ntb,hh,idx_scale);
        { const int smax=wave_max(mine!=0ull?64*lane+63-__builtin_clzll(mine):-1);
          if(lane==0) __hip_atomic_fetch_max(BLK+b*16+(t>>8),(unsigned)(SEQ-1-smax),__ATOMIC_RELAXED,__HIP_MEMORY_SCOPE_AGENT); }
      }
      asm volatile("s_waitcnt lgkmcnt(0)\n\ts_barrier":::"memory");
    }
  }
}
#undef ILAS
}

struct MapIdent { __device__ __forceinline__ int operator()(int j) const { return j; } };
struct MapWin {
    __device__ __forceinline__ int operator()(int j) const {
        if (j < 1536) return j;
        if (j < 3072) return 1544 + (j - 1536);
        if (j < 3584) return 3080 + (j - 3072);
        if (j < 3648) return 3592 + (j - 3584);
        if (j < 3656) return 1536 + (j - 3648);
        if (j < 3664) return 3656 + (j - 3656);
        if (j < 3840) return -1;
        return 3664 + (j - 3840);
    }
};
struct MapF1 { __device__ __forceinline__ int operator()(int j) const { const int pn = j >> 8, i = j & 255; return i < 128 ? 128 * pn + i : DFF + 128 * pn + (i - 128); } };
template <class Map>
__device__ __forceinline__ void wt_item(const float* W, int K, int ldw, bf16_t* WT, int nblk, int item, LAS float* scr, int lane, const Map& map) {
    const int kb = item / nblk, nb = item % nblk, k0 = 64 * kb, n0 = 32 * nb;
    const int src = map(n0 + (lane & 31));
#pragma unroll 8
    for (int i = 0; i < 32; ++i) { const int kk = 2 * i + (lane >> 5); scr[kk * 33 + (lane & 31)] = src >= 0 ? W[(size_t)(k0 + kk) * ldw + src] : 0.f; }
    asm volatile("s_waitcnt lgkmcnt(0)" ::: "memory");
    const int c = lane & 7;
#pragma unroll
    for (int j = 0; j < 4; ++j) { const int n = (lane >> 3) + 8 * j; const LAS float* sp = scr + (8 * c) * 33 + n;
        u32x4 o; o.x = f2bf(sp[0 * 33]) | (f2bf(sp[1 * 33]) << 16); o.y = f2bf(sp[2 * 33]) | (f2bf(sp[3 * 33]) << 16); o.z = f2bf(sp[4 * 33]) | (f2bf(sp[5 * 33]) << 16); o.w = f2bf(sp[6 * 33]) | (f2bf(sp[7 * 33]) << 16);
        *(u32x4*)(WT + (size_t)(n0 + n) * K + k0 + 8 * c) = o; }
    asm volatile("s_waitcnt lgkmcnt(0)" ::: "memory");
}
__device__ __forceinline__ void wcvt_phase(const P& p, LAS unsigned char* lds, int wg, int nwg) {
    const int tid = ltid(), lane = tid & 63, wave = tid >> 6;
    LAS float* scr = (LAS float*)(lds + wave * 16384);
    constexpr int I_IN = 16 * 184, I_A = 8 * 32, I_OUT = 16 * 32, I_F1 = 16 * 176, I_F2 = 44 * 32, I_LAYER = I_IN + 2 * I_A + I_OUT + I_F1 + I_F2;
    for (int it = wg * 8 + wave; it < DEPTH * I_LAYER; it += nwg * 8) {
        const int l = it / I_LAYER; int r = it % I_LAYER;
        unsigned char* wt = p.ws + WS_WT + (size_t)l * WT_LAYER;
        if (r < I_IN) { wt_item(p.w_in + (size_t)l * D * NIN, D, NIN, (bf16_t*)(wt + WT_IN), 184, r, scr, lane, MapWin()); continue; } r -= I_IN;
        if (r < I_A) { wt_item(p.w_a + (size_t)l * 512 * D, 512, D, (bf16_t*)(wt + WT_A), 32, r, scr, lane, MapIdent()); continue; } r -= I_A;
        if (r < I_A) { wt_item(p.w_b + (size_t)l * 512 * D, 512, D, (bf16_t*)(wt + WT_B), 32, r, scr, lane, MapIdent()); continue; } r -= I_A;
        if (r < I_OUT) { wt_item(p.w_out + (size_t)l * D * D, D, D, (bf16_t*)(wt + WT_OUT), 32, r, scr, lane, MapIdent()); continue; } r -= I_OUT;
        if (r < I_F1) { wt_item(p.w_ffn_in + (size_t)l * D * 2 * DFF, D, 2 * DFF, (bf16_t*)(wt + WT_F1), 176, r, scr, lane, MapF1()); continue; } r -= I_F1;
        wt_item(p.w_ffn_out + (size_t)l * DFF * D, DFF, D, (bf16_t*)(wt + WT_F2), 32, r, scr, lane, MapIdent());
    }
}

enum { PH_CVT = 0, PH_PROJ, PH_CUM, PH_IDX, PH_ATTN, PH_GATES, PH_BRA, PH_BRB, PH_OUT, PH_LN1, PH_FFN1, PH_FFN2, PH_LN2, PH_WCVT };

template <class Epi>
__device__ __forceinline__ void fast_gemm(LAS unsigned char* lds, const bf16_t* A, const bf16_t* Bt, int N, int K, const Epi& E) {
    pg8::Gemm g{A, Bt, M, N, K}; pg8::StaticOrder S; S.init(M, N, (int)gridDim.x, (int)blockIdx.x);
    pg8::gemm_phase<Epi, pg8::StaticOrder, true, true>(lds, g, S, E);
}

#ifndef NAIVE_MASK
#define NAIVE_MASK 0
#endif
template <int PH>
__device__ __forceinline__ void run_phase(const P& p_in, int l, LAS unsigned char* lds, int wg, int nwg) {
    P p = p_in; { size_t z = 0; asm volatile("" : "+s"(z)); p.ws = p_in.ws + z; }
    bf16_t* XB = WSP(bf16_t, WS_XB);
    const unsigned char* wt = p.ws + WS_WT + (size_t)l * WT_LAYER;
    if constexpr (PH == PH_CVT) cvt_phase(p, wg, nwg);
    if constexpr (PH == PH_WCVT) wcvt_phase(p, lds, wg, nwg);
    if constexpr (PH == PH_PROJ && (NAIVE_MASK & 1)) {
        GemmArgs g{XB, D, p.w_in + (size_t)l * D * NIN, NIN, C_GA, D, 0};
        EpiProj E{WSP(bf16_t, WS_FQ), WSP(bf16_t, WS_FK), WSP(bf16_t, WS_FV), WSP(bf16_t, WS_DQ), WSP(bf16_t, WS_DK), WSP(bf16_t, WS_DV), WSP(bf16_t, WS_IQ), WSP(bf16_t, WS_IK),
                  WSP(float, WS_FL), WSP(float, WS_IW), p.b_forget + l * NH};
        naive_gemm_phase<EpiProj, false>(lds, g, E, wg, nwg);
    } else
    if constexpr (PH == PH_PROJ) {
        pg8::EpiProjF E{WSP(bf16_t, WS_FQ), (size_t)M * 512, WSP(bf16_t, WS_IK), WSP(float, WS_FL), WSP(float, WS_IW), p.b_forget + l * NH, QSCALE};
        fast_gemm(lds, XB, (const bf16_t*)(wt + WT_IN), NPROJ, D, E);
    }
    if constexpr (PH == PH_CUM) { cum_phase(p, lds, wg, nwg); norm_phase(p, WSP(unsigned, WS_CTL) + CW_KMAX + 128 * l, (float*)(WSP(unsigned, WS_CTL) + CW_QMAX + 2048 * l), wg, nwg); }
    if constexpr (PH == PH_IDX && (NAIVE_MASK & 128)) idx_phase(p, lds, wg, nwg); else
    if constexpr (PH == PH_IDX) {
        const int G = (int)gridDim.x, bx = (int)blockIdx.x, vcu = (G % 8 == 0) ? (bx % 8) * (G / 8) + bx / 8 : bx;
        idx_body::idx_phase_fast(lds, WSP(const bf16_t, WS_IQ), WSP(const bf16_t, WS_IK), WSP(const float, WS_IW), WSP(unsigned, WS_MASK), WSP(unsigned, WS_CTL) + CW_BLK + 128 * l, IDX_SCALE, vcu, G);
    }
    if constexpr (PH == PH_ATTN && (NAIVE_MASK & 64)) attn_phase_naive(p, wg, nwg); else
    if constexpr (PH == PH_ATTN) {
        typedef attn_body::bf16 abf;
        auto mk = [l](unsigned char* ws) { unsigned* ctl = (unsigned*)(ws + WS_CTL);
            return attn_body::AttnTensors{(const abf*)(ws + WS_FQ), (const abf*)(ws + WS_FK), (const abf*)(ws + WS_FV), (const abf*)(ws + WS_DQ), (const abf*)(ws + WS_DK), (const abf*)(ws + WS_DV),
                                          (abf*)(ws + WS_OA), (abf*)(ws + WS_OB), (const float*)(ws + WS_CUM), (const unsigned*)(ws + WS_MASK),
                                          ctl + CW_QHEAD + 64 * l, ctl + CW_KMAX + 128 * l, (const float*)(ctl + CW_QMAX + 2048 * l), ctl + CW_BLK + 128 * l}; };
        attn_body::attn_phase<8>((char*)lds, p.ws, mk, (volatile LAS unsigned*)(lds + LDS_MISC_OFF + 16));
    }
    if constexpr (PH == PH_GATES && (NAIVE_MASK & 2)) {
        GemmArgs g{XB, D, p.w_in + (size_t)l * D * NIN + C_GA, NIN, 2048, D, 0};
        EpiGates E{WSP(bf16_t, WS_SGA), WSP(bf16_t, WS_SGB)};
        naive_gemm_phase<EpiGates, false>(lds, g, E, wg, nwg);
    } else
    if constexpr (PH == PH_GATES) {
        pg8::EpiGatesF E{WSP(bf16_t, WS_SGA), (size_t)M * 1024};
        fast_gemm(lds, XB, (const bf16_t*)(wt + WT_IN) + (size_t)NPROJ * D, NGATE, D, E);
    }
    if constexpr (PH == PH_BRA && (NAIVE_MASK & 4)) {
        GemmArgs g{WSP(bf16_t, WS_OA), 512, p.w_a + (size_t)l * 512 * D, D, D, 512, 0};
        EpiBranchA E{WSP(bf16_t, WS_SGA)};
        naive_gemm_phase<EpiBranchA, false>(lds, g, E, wg, nwg);
    } else
    if constexpr (PH == PH_BRA) {
        pg8::EpiBranchF<0> E{WSP(bf16_t, WS_SGA), nullptr};
        fast_gemm(lds, WSP(bf16_t, WS_OA), (const bf16_t*)(wt + WT_A), D, 512, E);
    }
    if constexpr (PH == PH_BRB && (NAIVE_MASK & 4)) {
        GemmArgs g{WSP(bf16_t, WS_OB), 512, p.w_b + (size_t)l * 512 * D, D, D, 512, 0};
        EpiBranchB E{WSP(bf16_t, WS_SGA), WSP(bf16_t, WS_SGB)};
        naive_gemm_phase<EpiBranchB, false>(lds, g, E, wg, nwg);
    } else
    if constexpr (PH == PH_BRB) {
        pg8::EpiBranchF<1> E{WSP(bf16_t, WS_SGB), WSP(bf16_t, WS_SGA)};
        fast_gemm(lds, WSP(bf16_t, WS_OB), (const bf16_t*)(wt + WT_B), D, 512, E);
    }
    if constexpr (PH == PH_OUT && (NAIVE_MASK & 8)) {
        GemmArgs g{WSP(bf16_t, WS_SGB), D, p.w_out + (size_t)l * D * D, D, D, D, 0};
        EpiResF32 E{l == 0 ? p.x : nullptr, XB, p.out};
        naive_gemm_phase<EpiResF32, false>(lds, g, E, wg, nwg);
    } else
    if constexpr (PH == PH_OUT) {
        pg8::EpiResF E{l == 0 ? p.x : nullptr, XB, WSP(bf16_t, WS_Y1), ALPHA};
        fast_gemm(lds, WSP(bf16_t, WS_SGB), (const bf16_t*)(wt + WT_OUT), D, D, E);
    }
    if constexpr (PH == PH_LN1) ln_phase(WSP(const bf16_t, WS_Y1), p.ln1_g + l * D, p.ln1_b + l * D, WSP(bf16_t, WS_X1B), nullptr, wg, nwg);
    if constexpr (PH == PH_FFN1 && (NAIVE_MASK & 16)) {
        GemmArgs g{WSP(bf16_t, WS_X1B), D, p.w_ffn_in + (size_t)l * D * 2 * DFF, 2 * DFF, DFF, D, DFF};
        EpiSwiglu E{WSP(bf16_t, WS_H)};
        naive_gemm_phase<EpiSwiglu, true>(lds, g, E, wg, nwg);
    } else
    if constexpr (PH == PH_FFN1) {
        pg8::EpiSwigluF E{WSP(bf16_t, WS_H), DFF};
        fast_gemm(lds, WSP(bf16_t, WS_X1B), (const bf16_t*)(wt + WT_F1), 2 * DFF, D, E);
    }
    if constexpr (PH == PH_FFN2 && (NAIVE_MASK & 32)) {
        GemmArgs g{WSP(bf16_t, WS_H), DFF, p.w_ffn_out + (size_t)l * DFF * D, D, D, DFF, 0};
        EpiResF32 E{nullptr, WSP(bf16_t, WS_X1B), p.out};
        naive_gemm_phase<EpiResF32, false>(lds, g, E, wg, nwg);
    } else
    if constexpr (PH == PH_FFN2) {
        pg8::EpiResF E{nullptr, WSP(bf16_t, WS_X1B), XB, ALPHA};
        fast_gemm(lds, WSP(bf16_t, WS_H), (const bf16_t*)(wt + WT_F2), D, DFF, E);
    }
    if constexpr (PH == PH_LN2) {
        if (l + 1 < DEPTH) ln_phase(XB, p.ln2_g + l * D, p.ln2_b + l * D, XB, nullptr, wg, nwg);
        else ln_phase(XB, p.ln2_g + l * D, p.ln2_b + l * D, nullptr, p.out, wg, nwg);
    }
}

#define XB_TMO      128
#define XB_XCNT(j)  (256  + 64 * (j))
#define XB_XSUB(j)  (1280 + 64 * (j))
#define XB_XGEN(j)  (2304 + 64 * (j))
#define XB_TOP      3328
#define XB_TOPGEN   3392
#define XCD_BAR_WORDS 3456
#define XB_SPIN_CAP (1u << 18)

__device__ __forceinline__ unsigned xb_ld(unsigned* p)              { return __hip_atomic_load(p, __ATOMIC_RELAXED, __HIP_MEMORY_SCOPE_AGENT); }
__device__ __forceinline__ unsigned xb_add(unsigned* p, unsigned v) { return __hip_atomic_fetch_add(p, v, __ATOMIC_RELAXED, __HIP_MEMORY_SCOPE_AGENT); }
__device__ __forceinline__ unsigned xb_xcc_id() { return (unsigned)__builtin_amdgcn_s_getreg((3 << 11) | 20) & 0xFu; }
#define XB_SPIN(cond, bar) do { unsigned _sp = 0; while (cond) { __builtin_amdgcn_s_sleep(1); \
    if ((++_sp & 255u) == 0u) { if (xb_ld(&(bar)[XB_TMO])) break; if (_sp > XB_SPIN_CAP) { atomicAdd(&(bar)[XB_TMO], 1u); break; } } } } while (0)

struct XcdBarrier {
    unsigned* bar; unsigned x;
    volatile LAS unsigned* st;
};

__device__ __forceinline__ XcdBarrier xcd_barrier_post(unsigned* bar, volatile LAS unsigned* st) {
    XcdBarrier b; b.bar = bar; b.x = xb_xcc_id(); b.st = st;
    if (ltid() == 0) (void)xb_add(&bar[XB_XCNT(b.x)], 1u);
    return b;
}
__device__ __forceinline__ void xcd_barrier_complete(unsigned* bar, unsigned x, unsigned& nloc, unsigned& nx) {
    const unsigned G = gridDim.x * gridDim.y * gridDim.z;
    unsigned sum, cnt, mine, sp = 0u;
    for (;;) {
        sum = 0u; cnt = 0u; mine = 0u;
#pragma unroll
        for (unsigned j = 0; j < 16; ++j) { const unsigned c = xb_ld(&bar[XB_XCNT(j)]); sum += c; cnt += (c > 0u) ? 1u : 0u; mine = (j == x) ? c : mine; }
        if (sum == G) break;
        __builtin_amdgcn_s_sleep(1);
        if ((++sp & 255u) == 0u) { if (xb_ld(&bar[XB_TMO])) break; if (sp > XB_SPIN_CAP) { atomicAdd(&bar[XB_TMO], 1u); break; } }
    }
    nloc = mine > 0u ? mine : 1u; nx = cnt > 0u ? cnt : 1u;
}

__device__ __forceinline__ void xcd_barrier(const XcdBarrier& b) {
    asm volatile("s_waitcnt vmcnt(0)" ::: "memory");
    __syncthreads();
    if (ltid() == 0) {
        unsigned* bar = b.bar;
        __builtin_amdgcn_s_waitcnt(0);
        unsigned nloc = b.st[0], nx = b.st[1];
        if (nloc == 0u) { xcd_barrier_complete(bar, b.x, nloc, nx); b.st[0] = nloc; b.st[1] = nx; }
        const unsigned old = xb_add(&bar[XB_XSUB(b.x)], 1u);
        const unsigned gen = old / nloc;
        if (old + 1u == (gen + 1u) * nloc) {
            __builtin_amdgcn_fence(__ATOMIC_RELEASE, "agent");
            asm volatile("s_waitcnt vmcnt(0)" ::: "memory");
            const unsigned og = xb_add(&bar[XB_TOP], 1u);
            const unsigned tg = og / nx;
            if (og + 1u == (tg + 1u) * nx) xb_add(&bar[XB_TOPGEN], 1u);
            else XB_SPIN(xb_ld(&bar[XB_TOPGEN]) == tg, bar);
            __builtin_amdgcn_fence(__ATOMIC_ACQUIRE, "agent");
            xb_add(&bar[XB_XGEN(b.x)], 1u);
            asm volatile("s_waitcnt vmcnt(0)" ::: "memory");
        } else {
            XB_SPIN(xb_ld(&bar[XB_XGEN(b.x)]) == gen, bar);
            __builtin_amdgcn_fence(__ATOMIC_ACQUIRE, "agent");
            asm volatile("s_waitcnt vmcnt(0)" ::: "memory");
        }
    }
    __syncthreads();
}

constexpr int LDS_BYTES = 147456;
constexpr int LDS_MISC = LDS_MISC_OFF;
constexpr int CW_BAR = 4096;
constexpr size_t CTL_ZERO_BYTES = 1u << 20;

#ifndef DUP_MASK
#define DUP_MASK 0
#endif
#define RUNPH(PH, bit) do { run_phase<PH>(p, l, lds, wg, nwg); if (DUP_MASK & (bit)) { xcd_barrier(bar); run_phase<PH>(p, l, lds, wg, nwg); } } while (0)
template <int LYR>
__device__ __forceinline__ void layer_body(const P& p, LAS unsigned char* lds, int wg, int nwg, const XcdBarrier& bar) {
    constexpr int l = LYR;
    RUNPH(PH_PROJ, 1); xcd_barrier(bar);
    run_phase<PH_CUM>(p, l, lds, wg, nwg); __syncthreads();
    RUNPH(PH_IDX, 2); xcd_barrier(bar);
    RUNPH(PH_ATTN, 4); xcd_barrier(bar);
    RUNPH(PH_GATES, 8); xcd_barrier(bar);
    run_phase<PH_BRA>(p, l, lds, wg, nwg); xcd_barrier(bar);
    run_phase<PH_BRB>(p, l, lds, wg, nwg); xcd_barrier(bar);
    RUNPH(PH_OUT, 16); xcd_barrier(bar);
    RUNPH(PH_LN1, 32); xcd_barrier(bar);
    RUNPH(PH_FFN1, 64); xcd_barrier(bar);
    RUNPH(PH_FFN2, 128); xcd_barrier(bar);
    run_phase<PH_LN2>(p, l, lds, wg, nwg);
}

__global__ void __launch_bounds__(NT, 2) mega_fwd(P p) {
    extern __shared__ __attribute__((aligned(16))) unsigned char lds_raw[];
    LAS unsigned char* lds = (LAS unsigned char*)lds_raw;
    volatile LAS unsigned* MISC = (volatile LAS unsigned*)(lds + LDS_MISC);
    if (threadIdx.x < 8) MISC[threadIdx.x] = 0u;
    ((volatile LAS int*)(uintptr_t)LDS_WTAB_OFF)[hw_wave_slot()] = (int)(threadIdx.x >> 6);
    __syncthreads();
    XcdBarrier bar = xcd_barrier_post((unsigned*)(p.ws + WS_CTL) + CW_BAR, MISC);
    const int wg = (int)blockIdx.x, nwg = (int)gridDim.x;
    run_phase<PH_CVT>(p, 0, lds, wg, nwg);
    run_phase<PH_WCVT>(p, 0, lds, wg, nwg); xcd_barrier(bar);
    layer_body<0>(p, lds, wg, nwg, bar); xcd_barrier(bar);
    layer_body<1>(p, lds, wg, nwg, bar);
}

extern "C" void kernel_launch(void* const* d_in, const int* in_sizes, int n_in, void* d_out, int out_size, void* d_ws, size_t ws_size, hipStream_t stream) {
    static int grid = 0;
    if (grid == 0) {
        if (n_in != 12 || ws_size < WS_END) { fprintf(stderr, "kernel_launch: unexpected inputs (n_in %d, ws %zu)\n", n_in, ws_size); grid = -1; return; }
        int dev = 0, cus = 0, per_cu = 0;
        if (hipGetDevice(&dev) != hipSuccess || hipDeviceGetAttribute(&cus, hipDeviceAttributeMultiprocessorCount, dev) != hipSuccess) { grid = -1; return; }
        if (hipFuncSetAttribute((const void*)mega_fwd, hipFuncAttributeMaxDynamicSharedMemorySize, LDS_BYTES) != hipSuccess) { fprintf(stderr, "kernel_launch: hipFuncSetAttribute failed\n"); grid = -1; return; }
        if (hipOccupancyMaxActiveBlocksPerMultiprocessor(&per_cu, (const void*)mega_fwd, NT, LDS_BYTES) != hipSuccess || per_cu < 1) { fprintf(stderr, "kernel_launch: occupancy query says %d\n", per_cu); }
        (void)hipGetLastError();
        grid = cus;
    }
    if (grid < 0) return;
    P p{};
    p.x = (const float*)d_in[0]; p.w_in = (const float*)d_in[1]; p.b_forget = (const float*)d_in[2]; p.w_a = (const float*)d_in[3]; p.w_b = (const float*)d_in[4];
    p.w_out = (const float*)d_in[5]; p.ln1_g = (const float*)d_in[6]; p.ln1_b = (const float*)d_in[7]; p.w_ffn_in = (const float*)d_in[8]; p.w_ffn_out = (const float*)d_in[9];
    p.ln2_g = (const float*)d_in[10]; p.ln2_b = (const float*)d_in[11]; p.out = (float*)d_out; p.ws = (unsigned char*)d_ws;
    if (hipMemsetAsync((char*)d_ws + WS_CTL, 0, CTL_ZERO_BYTES, stream) != hipSuccess) { fprintf(stderr, "kernel_launch: memset failed\n"); return; }
    hipLaunchKernelGGL(mega_fwd, dim3(grid), dim3(NT), LDS_BYTES, stream, p);
}
```

```cpp
#include <hip/hip_runtime.h>
#include <stdint.h>
#include <stdio.h>

#define LAS __attribute__((address_space(3)))
typedef unsigned short bf16_t;
typedef float f32x4 __attribute__((ext_vector_type(4)));
typedef unsigned u32x4 __attribute__((ext_vector_type(4)));
typedef unsigned u32x2 __attribute__((ext_vector_type(2)));

namespace cfg {
constexpr int NB = 8, L = 4096, D = 1024, M = NB * L, DEPTH = 2;
constexpr int NH = 8, HD = 64, HW = 512;
constexpr int DFF = 2816;
constexpr int NIN = 5712;
constexpr int C_GA = 3664;
constexpr float ALPHA = 1.4142135623730951f;
constexpr float LN_EPS = 1e-5f;
constexpr float LOG2E = 1.4426950408889634f;
constexpr float QSCALE = 0.125f * LOG2E;
constexpr float IDX_SCALE = 0.04419417382415922f;
constexpr int TOPK = 256;
constexpr int NT = 512;
constexpr int LDS_MISC_OFF = 135168;
constexpr size_t MiB = 1u << 20;
constexpr size_t WS_CTL = 0;
constexpr size_t WS_WT = 1 * MiB, WT_LAYER = 32 * MiB;
constexpr size_t WT_IN = 0, WT_A = 12058624, WT_B = WT_A + 1048576, WT_OUT = WT_B + 1048576, WT_F1 = WT_OUT + 2097152, WT_F2 = WT_F1 + 11534336;
constexpr int NPROJ = 3840, NGATE = 2048;
constexpr size_t WS_XB = 65 * MiB;
constexpr size_t WS_FQ = 129 * MiB, WS_FK = 161 * MiB, WS_FV = 193 * MiB, WS_DQ = 225 * MiB, WS_DK = 257 * MiB, WS_DV = 289 * MiB, WS_IQ = 321 * MiB;
constexpr size_t WS_IK = 353 * MiB;
constexpr size_t WS_FL = 357 * MiB, WS_IW = 358 * MiB, WS_CUM = 359 * MiB;
constexpr size_t WS_OA = 360 * MiB, WS_OB = 392 * MiB;
constexpr size_t WS_X1B = 360 * MiB;
constexpr size_t WS_MASK = 424 * MiB;
constexpr size_t WS_SGA = 129 * MiB, WS_SGB = 193 * MiB;
constexpr size_t WS_Y1 = 129 * MiB;
constexpr size_t WS_H8 = 129 * MiB;
constexpr size_t WS_X1F8 = 217 * MiB;
constexpr size_t WS_H = 129 * MiB;
constexpr size_t WS_END = 440 * MiB;
constexpr int CW_QHEAD = 8192;
constexpr int CW_KMAX = 8448;
constexpr int CW_BLK = 8704;
constexpr int CW_QMAX = 9216;
}
using namespace cfg;

__device__ __forceinline__ float bf2f(unsigned v) { return __uint_as_float(v << 16); }
__device__ __forceinline__ unsigned f2bf(float f) { unsigned u = __float_as_uint(f); return (u + 0x7fffu + ((u >> 16) & 1u)) >> 16; }

constexpr int LDS_WTAB_OFF = 135168 + 64;
__device__ __forceinline__ unsigned hw_wave_slot() { return ((unsigned)__builtin_amdgcn_s_getreg((3 << 11) | (0 << 6) | 4) & 15u) | (((unsigned)__builtin_amdgcn_s_getreg((1 << 11) | (4 << 6) | 4) & 3u) << 4); }
__device__ __forceinline__ int ltid() {
    const int w = ((volatile LAS int*)(uintptr_t)LDS_WTAB_OFF)[hw_wave_slot()];
    int lane; asm volatile("v_mbcnt_lo_u32_b32 %0, -1, 0\n\tv_mbcnt_hi_u32_b32 %0, -1, %0" : "=v"(lane));
    int t = w * 64 + lane;
    asm volatile("" : "+v"(t)); return t;
}

__device__ __forceinline__ unsigned pk4_fp8(float a, float b, float c, float d) { unsigned w = 0u; w = (unsigned)__builtin_amdgcn_cvt_pk_fp8_f32(a, b, (int)w, false); w = (unsigned)__builtin_amdgcn_cvt_pk_fp8_f32(c, d, (int)w, true); return w; }
constexpr float F8_WSCALE = 256.f, F8_HSCALE = 16.f;

struct P {
    const float *x, *w_in, *b_forget, *w_a, *w_b, *w_out, *ln1_g, *ln1_b, *w_ffn_in, *w_ffn_out, *ln2_g, *ln2_b;
    float* out; unsigned char* ws;
};
#define WSP(T, off) ((T*)(p.ws + (off)))

struct GemmArgs { const bf16_t* A; int lda; const float* W; int ldw; int N; int K; int dual_off; };

template <class Epi, bool DUAL>
__device__ __forceinline__ void naive_gemm_phase(LAS unsigned char* lds, const GemmArgs g, const Epi& E, int wg, int nwg) {
    LAS float* As = (LAS float*)lds;
    LAS float* Bs = As + 16 * 132;
    LAS float* Bs2 = Bs + 16 * 128;
    const int tid = ltid(), ty = tid >> 5, tx = tid & 31;
    const int ntn = (g.N + 127) / 128, ntm = M / 128, nitems = ntn * ntm;
    for (int it = wg; it < nitems; it += nwg) {
        const int tm = it / ntn, tn = it % ntn;
        const int m0 = tm * 128, n0 = tn * 128;
        float acc[8][4], acc2[8][4];
#pragma unroll
        for (int i = 0; i < 8; ++i)
#pragma unroll
            for (int j = 0; j < 4; ++j) { acc[i][j] = 0.f; acc2[i][j] = 0.f; }
        for (int k0 = 0; k0 < g.K; k0 += 16) {
            {
                const int r = tid >> 2, kq = (tid & 3) * 4;
                const u32x2 v = *(const u32x2*)(g.A + (size_t)(m0 + r) * g.lda + k0 + kq);
                As[(kq + 0) * 132 + r] = bf2f(v.x & 0xffffu); As[(kq + 1) * 132 + r] = bf2f(v.x >> 16);
                As[(kq + 2) * 132 + r] = bf2f(v.y & 0xffffu); As[(kq + 3) * 132 + r] = bf2f(v.y >> 16);
            }
            {
                const int k = tid >> 5, n4 = (tid & 31) * 4, n = n0 + n4;
                f32x4 w = (f32x4){0.f, 0.f, 0.f, 0.f}, w2 = w;
                if (n < g.N) { w = *(const f32x4*)(g.W + (size_t)(k0 + k) * g.ldw + n); if (DUAL) w2 = *(const f32x4*)(g.W + (size_t)(k0 + k) * g.ldw + n + g.dual_off); }
                *(LAS f32x4*)(Bs + k * 128 + n4) = w;
                if (DUAL) *(LAS f32x4*)(Bs2 + k * 128 + n4) = w2;
            }
            __syncthreads();
#pragma unroll 2
            for (int kk = 0; kk < 16; ++kk) {
                const f32x4 a0 = *(const LAS f32x4*)(As + kk * 132 + ty * 8), a1 = *(const LAS f32x4*)(As + kk * 132 + ty * 8 + 4);
                const f32x4 b = *(const LAS f32x4*)(Bs + kk * 128 + tx * 4);
                const float a[8] = {a0.x, a0.y, a0.z, a0.w, a1.x, a1.y, a1.z, a1.w};
                const float bb[4] = {b.x, b.y, b.z, b.w};
#pragma unroll
                for (int i = 0; i < 8; ++i)
#pragma unroll
                    for (int j = 0; j < 4; ++j) acc[i][j] = fmaf(a[i], bb[j], acc[i][j]);
                if (DUAL) {
                    const f32x4 b2 = *(const LAS f32x4*)(Bs2 + kk * 128 + tx * 4);
                    const float b2b[4] = {b2.x, b2.y, b2.z, b2.w};
#pragma unroll
                    for (int i = 0; i < 8; ++i)
#pragma unroll
                        for (int j = 0; j < 4; ++j) acc2[i][j] = fmaf(a[i], b2b[j], acc2[i][j]);
                }
            }
            __syncthreads();
        }
#pragma unroll
        for (int i = 0; i < 8; ++i)
#pragma unroll
            for (int j = 0; j < 4; ++j) { const int n = n0 + tx * 4 + j; if (n < g.N) E(m0 + ty * 8 + i, n, acc[i][j], acc2[i][j]); }
    }
}

struct EpiProj {
    bf16_t *FQ, *FK, *FV, *DQ, *DK, *DV, *IQ, *IK; float *FL, *IW; const float* bforget;
    __device__ __forceinline__ void operator()(int m, int n, float v, float) const {
        const size_t r = (size_t)m;
        if (n < 512) FQ[r * 512 + n] = (bf16_t)f2bf(v * QSCALE);
        else if (n < 1024) FK[r * 512 + (n - 512)] = (bf16_t)f2bf(v);
        else if (n < 1536) FV[r * 512 + (n - 1024)] = (bf16_t)f2bf(v);
        else if (n < 1544) FL[r * 8 + (n - 1536)] = v + bforget[n - 1536];
        else if (n < 2056) DQ[r * 512 + (n - 1544)] = (bf16_t)f2bf(v * QSCALE);
        else if (n < 2568) DK[r * 512 + (n - 2056)] = (bf16_t)f2bf(v);
        else if (n < 3080) DV[r * 512 + (n - 2568)] = (bf16_t)f2bf(v);
        else if (n < 3592) IQ[r * 512 + (n - 3080)] = (bf16_t)f2bf(v);
        else if (n < 3656) IK[r * 64 + (n - 3592)] = (bf16_t)f2bf(v);
        else IW[r * 8 + (n - 3656)] = v;
    }
};
struct EpiGates {
    bf16_t *SGA, *SGB;
    __device__ __forceinline__ void operator()(int m, int n, float v, float) const {
        const float s = 1.f / (1.f + __expf(-v));
        if (n < 1024) SGA[(size_t)m * 1024 + n] = (bf16_t)f2bf(s); else SGB[(size_t)m * 1024 + (n - 1024)] = (bf16_t)f2bf(s);
    }
};
struct EpiBranchA { bf16_t* SGA;
    __device__ __forceinline__ void operator()(int m, int n, float v, float) const { bf16_t* q = SGA + (size_t)m * 1024 + n; *q = (bf16_t)f2bf(bf2f(*q) * v); } };
struct EpiBranchB { const bf16_t* MA; bf16_t* SGB;
    __device__ __forceinline__ void operator()(int m, int n, float v, float) const { const size_t o = (size_t)m * 1024 + n; SGB[o] = (bf16_t)f2bf(bf2f(MA[o]) + bf2f(SGB[o]) * v); } };
struct EpiResF32 { const float* xf; const bf16_t* xb; float* Y;
    __device__ __forceinline__ void operator()(int m, int n, float v, float) const { const size_t o = (size_t)m * 1024 + n; const float xv = xf ? xf[o] : bf2f(xb[o]); Y[o] = ALPHA * xv + v; } };
struct EpiSwiglu { bf16_t* H;
    __device__ __forceinline__ void operator()(int m, int n, float g, float u) const { const float s = g / (1.f + __expf(-g)); H[(size_t)m * DFF + n] = (bf16_t)f2bf(s * u); } };

namespace pg8 {
#define PG8_LAS __attribute__((address_space(3)))
typedef unsigned short bf16_t;
typedef short bf16x8 __attribute__((ext_vector_type(8)));
typedef float f32x4 __attribute__((ext_vector_type(4)));
typedef unsigned u32x4 __attribute__((ext_vector_type(4)));
constexpr int BM = 256, BK = 64, HALF = 128, HTB = HALF * BK * 2  , STAGE_BYTES = 8 * HTB, NXCD = 8, WGM = 8;

__host__ __device__ __forceinline__ int lds_byte(int r, int c) { const int st = (r >> 4) * 2 + (c >> 5), rr = r & 15, cc = c & 31, ob = rr * 64 + cc * 2; return st * 1024 + (ob ^ (((ob >> 9) & 1) << 5)); }
__host__ __device__ __forceinline__ void stage_rc(int b, int& R, int& C) { const int st = b / 1024, sb = b % 1024, swz = sb ^ (((sb >> 9) & 1) << 5); R = (st >> 1) * 16 + swz / 64; C = (st & 1) * 32 + (swz % 64) / 2; }
__host__ __device__ __forceinline__ int perm32(int rho) { const int n = rho >> 4, i = rho & 15; return 8 * (i >> 2) + 4 * n + (i & 3); }

struct Unit { int pm, pn; };
struct Gemm { const bf16_t* A; const bf16_t* Bt; int M, N, K; };

struct StaticOrder {
    int nM, nN, nwg, G, c;
    __host__ __device__ void init(int M, int N, int G_, int c_) { nM = M / BM; nN = N / BM; nwg = nM * nN; G = G_; c = c_; }
    __host__ __device__ bool next(int i, Unit& u) const {
        const long L = (long)i * G + c; if (L >= nwg) return false;
        int wgid = (int)L; { const int q = nwg / NXCD, r = nwg % NXCD, xcd = wgid % NXCD, off = wgid / NXCD; wgid = (xcd < r ? xcd * (q + 1) : r * (q + 1) + (xcd - r) * q) + off; }
        const int nig = WGM * nN, gid = wgid / nig, fm = gid * WGM, gsz = (nM - fm) < WGM ? (nM - fm) : WGM;
        u.pm = fm + ((wgid % nig) % gsz); u.pn = (wgid % nig) / gsz; return true;
    }
    __device__ __forceinline__ void a_ready(const Unit&) const {}
    __device__ __forceinline__ void done(const Unit&) const {}
};


typedef float f32x2_t __attribute__((ext_vector_type(2))); typedef __bf16 bf16x2_t __attribute__((ext_vector_type(2)));
__device__ __forceinline__ unsigned cvt_pk_bf16(float lo, float hi) { f32x2_t v = {lo, hi}; bf16x2_t b = __builtin_convertvector(v, bf16x2_t); return __builtin_bit_cast(unsigned, b); }
__device__ __forceinline__ float bflo(unsigned w) { return __uint_as_float(w << 16); }
__device__ __forceinline__ float bfhi(unsigned w) { return __uint_as_float(w & 0xffff0000u); }
__device__ __forceinline__ u32x4 pack8(const f32x4 v0, const f32x4 v1) { u32x4 w; w.x = cvt_pk_bf16(v0[0], v0[1]); w.y = cvt_pk_bf16(v0[2], v0[3]); w.z = cvt_pk_bf16(v1[0], v1[1]); w.w = cvt_pk_bf16(v1[2], v1[3]); return w; }
__device__ __forceinline__ float sigmoid_f(float v) { return __builtin_amdgcn_rcpf(1.0f + __builtin_amdgcn_exp2f(-1.4426950408889634f * v)); }

struct EpiProjF {
    static constexpr bool PERM = true, AFTER_DRAIN = false;
    bf16_t* QKV; size_t tstride; bf16_t* IK; float* FL; float* IW; const float* bforget; float qs;
    __device__ __forceinline__ void operator()(const f32x4 (&acc)[2][2][4][2], const Unit& u, int wr, int wc, int fr, int fq) const {
        const int row0 = u.pm * BM + wr * 64 + fr;
        if (u.pn < 14) {
            const int t = u.pn >> 1; const float sc = (t == 0 || t == 3) ? qs : 1.f;
            bf16_t* base = QKV + (size_t)t * tstride + (u.pn & 1) * 256 + wc * 32 + 8 * fq;
#pragma unroll
            for (int ai = 0; ai < 2; ++ai)
#pragma unroll
                for (int m = 0; m < 4; ++m) { bf16_t* rowp = base + (size_t)(row0 + ai * HALF + m * 16) * 512;
#pragma unroll
                    for (int bj = 0; bj < 2; ++bj) *(u32x4*)(rowp + bj * HALF) = pack8(acc[ai][bj][m][0] * sc, acc[ai][bj][m][1] * sc); }
        } else {
#pragma unroll
            for (int ai = 0; ai < 2; ++ai)
#pragma unroll
                for (int m = 0; m < 4; ++m) { const size_t row = (size_t)(row0 + ai * HALF + m * 16);
                    const f32x4 v0 = acc[ai][0][m][0], v1 = acc[ai][0][m][1];
                    if (wc < 2) *(u32x4*)(IK + row * 64 + wc * 32 + 8 * fq) = pack8(v0, v1);
                    else if (wc == 2 && fq == 0) { *(f32x4*)(FL + row * 8) = v0 + *(const f32x4*)bforget; *(f32x4*)(FL + row * 8 + 4) = v1 + *(const f32x4*)(bforget + 4); }
                    else if (wc == 2 && fq == 1) { *(f32x4*)(IW + row * 8) = v0; *(f32x4*)(IW + row * 8 + 4) = v1; } }
        }
    }
};
struct EpiGatesF {
    static constexpr bool PERM = true, AFTER_DRAIN = false;
    bf16_t* SG; size_t tstride;
    __device__ __forceinline__ void operator()(const f32x4 (&acc)[2][2][4][2], const Unit& u, int wr, int wc, int fr, int fq) const {
        const int row0 = u.pm * BM + wr * 64 + fr;
        bf16_t* base = SG + (size_t)(u.pn >> 2) * tstride + (u.pn & 3) * 256 + wc * 32 + 8 * fq;
#pragma unroll
        for (int ai = 0; ai < 2; ++ai)
#pragma unroll
            for (int m = 0; m < 4; ++m) { bf16_t* rowp = base + (size_t)(row0 + ai * HALF + m * 16) * 1024;
#pragma unroll
                for (int bj = 0; bj < 2; ++bj) { f32x4 v0 = acc[ai][bj][m][0], v1 = acc[ai][bj][m][1];
#pragma unroll
                    for (int e = 0; e < 4; ++e) { v0[e] = sigmoid_f(v0[e]); v1[e] = sigmoid_f(v1[e]); }
                    *(u32x4*)(rowp + bj * HALF) = pack8(v0, v1); } }
    }
};
template <int MODE> struct EpiBranchF {
    static constexpr bool PERM = true, AFTER_DRAIN = false;
    bf16_t* G; const bf16_t* MA;
    __device__ __forceinline__ void operator()(const f32x4 (&acc)[2][2][4][2], const Unit& u, int wr, int wc, int fr, int fq) const {
        const int row0 = u.pm * BM + wr * 64 + fr; const int col0 = u.pn * BM + wc * 32 + 8 * fq;
#pragma unroll
        for (int ai = 0; ai < 2; ++ai)
#pragma unroll
            for (int m = 0; m < 4; ++m) { const size_t off = (size_t)(row0 + ai * HALF + m * 16) * 1024 + col0;
#pragma unroll
                for (int bj = 0; bj < 2; ++bj) { const f32x4 a0 = acc[ai][bj][m][0], a1 = acc[ai][bj][m][1];
                    const u32x4 g = *(const u32x4*)(G + off + bj * HALF);
                    f32x4 v0 = (f32x4){bflo(g.x) * a0[0], bfhi(g.x) * a0[1], bflo(g.y) * a0[2], bfhi(g.y) * a0[3]};
                    f32x4 v1 = (f32x4){bflo(g.z) * a1[0], bfhi(g.z) * a1[1], bflo(g.w) * a1[2], bfhi(g.w) * a1[3]};
                    if (MODE == 1) { const u32x4 q = *(const u32x4*)(MA + off + bj * HALF);
                        v0 = v0 + (f32x4){bflo(q.x), bfhi(q.x), bflo(q.y), bfhi(q.y)}; v1 = v1 + (f32x4){bflo(q.z), bfhi(q.z), bflo(q.w), bfhi(q.w)}; }
                    *(u32x4*)(G + off + bj * HALF) = pack8(v0, v1); } }
    }
};
struct EpiResF {
    static constexpr bool PERM = true, AFTER_DRAIN = false;
    const float* xf; const bf16_t* xb; bf16_t* Y; float alpha; float accs;
    __device__ __forceinline__ void operator()(const f32x4 (&acc)[2][2][4][2], const Unit& u, int wr, int wc, int fr, int fq) const {
        const int row0 = u.pm * BM + wr * 64 + fr; const int col0 = u.pn * BM + wc * 32 + 8 * fq;
#pragma unroll
        for (int ai = 0; ai < 2; ++ai)
#pragma unroll
            for (int m = 0; m < 4; ++m) { const size_t off = (size_t)(row0 + ai * HALF + m * 16) * 1024 + col0;
#pragma unroll
                for (int bj = 0; bj < 2; ++bj) { const size_t o = off + bj * HALF; f32x4 x0, x1;
                    if (xf) { x0 = *(const f32x4*)(xf + o); x1 = *(const f32x4*)(xf + o + 4); }
                    else { const u32x4 w = *(const u32x4*)(xb + o); x0 = (f32x4){bflo(w.x), bfhi(w.x), bflo(w.y), bfhi(w.y)}; x1 = (f32x4){bflo(w.z), bfhi(w.z), bflo(w.w), bfhi(w.w)}; }
                    *(u32x4*)(Y + o) = pack8(x0 * alpha + acc[ai][bj][m][0] * accs, x1 * alpha + acc[ai][bj][m][1] * accs); } }
    }
};
struct EpiSwigluF {
    static constexpr bool PERM = true, AFTER_DRAIN = false;
    bf16_t* H; int ldh;
    __device__ __forceinline__ void operator()(const f32x4 (&acc)[2][2][4][2], const Unit& u, int wr, int wc, int fr, int fq) const {
        const int row0 = u.pm * BM + wr * 64 + fr; const int col0 = u.pn * HALF + wc * 32 + 8 * fq;
#pragma unroll
        for (int ai = 0; ai < 2; ++ai)
#pragma unroll
            for (int m = 0; m < 4; ++m) { f32x4 v0, v1;
#pragma unroll
                for (int e = 0; e < 4; ++e) { const float g0 = acc[ai][0][m][0][e], g1 = acc[ai][0][m][1][e];
                    v0[e] = g0 * sigmoid_f(g0) * acc[ai][1][m][0][e]; v1[e] = g1 * sigmoid_f(g1) * acc[ai][1][m][1][e]; }
                *(u32x4*)(H + (size_t)(row0 + ai * HALF + m * 16) * ldh + col0) = pack8(v0, v1); }
    }
};

struct EpiSwigluF8 {
    static constexpr bool PERM = true, AFTER_DRAIN = false;
    unsigned char* H8; int ldh; float accs, hs;
    __device__ __forceinline__ void operator()(const f32x4 (&acc)[2][2][4][2], const Unit& u, int wr, int wc, int fr, int fq) const {
        typedef unsigned u32x2v __attribute__((ext_vector_type(2)));
        const int row0 = u.pm * BM + wr * 64 + fr; const int col0 = u.pn * HALF + wc * 32 + 8 * fq;
#pragma unroll
        for (int ai = 0; ai < 2; ++ai)
#pragma unroll
            for (int m = 0; m < 4; ++m) { float v[8];
#pragma unroll
                for (int e = 0; e < 4; ++e) { const float g0 = acc[ai][0][m][0][e] * accs, g1 = acc[ai][0][m][1][e] * accs;
                    v[e] = __builtin_amdgcn_fmed3f(g0 * sigmoid_f(g0) * (acc[ai][1][m][0][e] * accs) * hs, -448.f, 448.f); v[4 + e] = __builtin_amdgcn_fmed3f(g1 * sigmoid_f(g1) * (acc[ai][1][m][1][e] * accs) * hs, -448.f, 448.f); }
                u32x2v w; w.x = pk4_fp8(v[0], v[1], v[2], v[3]); w.y = pk4_fp8(v[4], v[5], v[6], v[7]);
                *(u32x2v*)(H8 + (size_t)(row0 + ai * HALF + m * 16) * ldh + col0) = w; }
    }
};

template <class Epi, class Sched, bool ALIGN_EPI = false, bool SP2 = false, bool FP8 = false>
__device__ __forceinline__ void gemm_phase(PG8_LAS unsigned char* lds, const Gemm g, const Sched& S, const Epi& E) {
    const int tid = ltid(), wid = __builtin_amdgcn_readfirstlane(tid >> 6), lane = tid & 63, wr = wid >> 2, wc = wid & 3, fr = lane & 15, fq = lane >> 4;
    const int K = g.K, rowb = FP8 ? K : 2 * K, nt = rowb / (2 * BK);
    unsigned voffA[2], voffB[2];
#pragma unroll
    for (int i = 0; i < 2; ++i) { int R, C; stage_rc(tid * 16 + i * 8192, R, C); const int Rb = Epi::PERM ? ((R & ~31) + perm32(R & 31)) : R;
        voffA[i] = (unsigned)(R * rowb + C * 2); voffB[i] = (unsigned)(Rb * rowb + C * 2); }
    const size_t kstep = (size_t)(BK * 2);
    const size_t hstep = (size_t)HALF * rowb;
    const size_t tstep = 2 * hstep;
    const unsigned ldsw = (unsigned)wid * 1024u;
    const int aoff = lds_byte(wr * 64 + fr, fq * 8), boff = lds_byte(wc * 32 + fr, fq * 8);
#define PG8_SA(b, h) (((b) * 2 + (h)) * HTB)
#define PG8_SB(b, h) ((4 + (b) * 2 + (h)) * HTB)
#define PG8_STAGE(bufoff, gbase, voff) do { _Pragma("unroll") for (int _i = 0; _i < 2; ++_i) { unsigned vo_ = (voff)[_i]; if constexpr (FP8) asm volatile("" : "+v"(vo_));     \
        __builtin_amdgcn_global_load_lds((const unsigned*)((const char*)(gbase) + vo_), (PG8_LAS unsigned*)(lds + (bufoff) + ldsw + _i * 8192), 16, 0, 0); } } while (0)
#define PG8_LDF(f, base) do { if constexpr (FP8) { const i32x4_t l0_ = *(const PG8_LAS i32x4_t*)(base), l1_ = *(const PG8_LAS i32x4_t*)((base) + 1024); f.w = __builtin_shufflevector(l0_, l1_, 0, 1, 2, 3, 4, 5, 6, 7); } \
        else { f.h[0] = *(const PG8_LAS bf16x8*)(base); f.h[1] = *(const PG8_LAS bf16x8*)((base) + 1024); } } while (0)
#define PG8_LDA(dst, b, h) do { _Pragma("unroll") for (int m = 0; m < 4; ++m) PG8_LDF(dst[m], lds + PG8_SA(b, h) + aoff + m * 2048); } while (0)
#define PG8_LDB(dst, b, h) do { _Pragma("unroll") for (int n = 0; n < 2; ++n) PG8_LDF(dst[n], lds + PG8_SB(b, h) + boff + n * 2048); } while (0)
#define PG8_MMA(ai, bj, At, Bt) do { __builtin_amdgcn_s_setprio(1); _Pragma("unroll") for (int m = 0; m < 4; ++m) _Pragma("unroll") for (int n = 0; n < 2; ++n) { \
        if constexpr (FP8) acc[ai][bj][m][n] = __builtin_amdgcn_mfma_scale_f32_16x16x128_f8f6f4(Bt[n].w, At[m].w, acc[ai][bj][m][n], 0, 0, 0, 0, 0, 0);     \
        else { _Pragma("unroll") for (int k = 0; k < 2; ++k) acc[ai][bj][m][n] = __builtin_amdgcn_mfma_f32_16x16x32_bf16(Bt[n].h[k], At[m].h[k], acc[ai][bj][m][n], 0, 0, 0); } } \
        __builtin_amdgcn_s_setprio(0); } while (0)
#define PG8_WAIT_V(n) asm volatile("s_waitcnt vmcnt(" #n ")" ::: "memory")
#define PG8_WAIT_L(n) asm volatile("s_waitcnt lgkmcnt(" #n ")" ::: "memory")
#define PG8_BAR __builtin_amdgcn_s_barrier()
#define PG8_SCHED __builtin_amdgcn_sched_barrier(0)
    Unit cur, nxt; int ui = 0;
    if (!S.next(0, cur)) return;
    f32x4 acc[2][2][4][2];
#pragma unroll
    for (int a = 0; a < 2; ++a)
#pragma unroll
        for (int b = 0; b < 2; ++b)
#pragma unroll
            for (int m = 0; m < 4; ++m)
#pragma unroll
                for (int n = 0; n < 2; ++n) acc[a][b][m][n] = (f32x4){0.f, 0.f, 0.f, 0.f};
    typedef int i32x8_t __attribute__((ext_vector_type(8))); typedef int i32x4_t __attribute__((ext_vector_type(4)));
    struct Frag { bf16x8 h[2]; i32x8_t w; };
    Frag At[4], B0[2], B1[2];
    const char* cA = (const char*)g.A + (size_t)cur.pm * tstep; const char* cB = (const char*)g.Bt + (size_t)cur.pn * tstep;
    S.a_ready(cur);
    if constexpr (SP2) {
        PG8_STAGE(PG8_SB(0, 0), cB, voffB); PG8_STAGE(PG8_SB(0, 1), cB + hstep, voffB); PG8_STAGE(PG8_SA(0, 0), cA, voffA); PG8_STAGE(PG8_SA(0, 1), cA + hstep, voffA);
        if (wr == 1) PG8_BAR;
        PG8_WAIT_V(2); PG8_BAR;
        PG8_STAGE(PG8_SB(1, 0), cB + kstep, voffB); PG8_STAGE(PG8_SA(1, 0), cA + kstep, voffA); PG8_STAGE(PG8_SB(1, 1), cB + hstep + kstep, voffB);
        PG8_WAIT_V(6); PG8_BAR;
    } else {
        PG8_STAGE(PG8_SB(0, 0), cB, voffB); PG8_STAGE(PG8_SA(0, 0), cA, voffA); PG8_STAGE(PG8_SB(0, 1), cB + hstep, voffB); PG8_STAGE(PG8_SA(0, 1), cA + hstep, voffA);
        if (wr == 1) PG8_BAR;
        PG8_WAIT_V(4); PG8_BAR;
        PG8_STAGE(PG8_SB(1, 0), cB + kstep, voffB); PG8_STAGE(PG8_SA(1, 0), cA + kstep, voffA); PG8_STAGE(PG8_SB(1, 1), cB + hstep + kstep, voffB);
        PG8_WAIT_V(6); PG8_BAR;
    }
    for (;;) {
        const bool has_next = S.next(ui + 1, nxt);
        const char* nA = has_next ? (const char*)g.A + (size_t)nxt.pm * tstep : cA; const char* nB = has_next ? (const char*)g.Bt + (size_t)nxt.pn * tstep : cB;
        for (int t = 0; t < nt; t += 2) {
            const bool last = (t == nt - 2);
            const char* a1 = cA + (size_t)(t + 1) * kstep;
            const char* a2 = last ? nA : cA + (size_t)(t + 2) * kstep; const char* b2 = last ? nB : cB + (size_t)(t + 2) * kstep;
            const char* a3 = a2 + kstep; const char* b3 = b2 + kstep;
            if (last && has_next) S.a_ready(nxt);
            if constexpr (SP2) {
            PG8_LDB(B0, 0, 0); PG8_LDB(B1, 0, 1); PG8_SCHED; PG8_LDA(At, 0, 0); PG8_STAGE(PG8_SA(1, 1), a1 + hstep, voffA);
            PG8_WAIT_V(8); PG8_WAIT_L(0); PG8_BAR; PG8_MMA(0, 0, At, B0); PG8_MMA(0, 1, At, B1); PG8_BAR; PG8_SCHED;
            PG8_LDA(At, 0, 1); PG8_STAGE(PG8_SB(0, 0), b2, voffB); PG8_STAGE(PG8_SB(0, 1), b2 + hstep, voffB); PG8_STAGE(PG8_SA(0, 0), a2, voffA);
            PG8_WAIT_V(8); PG8_WAIT_L(0); PG8_BAR; PG8_MMA(1, 0, At, B0); PG8_MMA(1, 1, At, B1); PG8_BAR; PG8_SCHED;
            PG8_LDB(B0, 1, 0); PG8_LDB(B1, 1, 1); PG8_SCHED; PG8_LDA(At, 1, 0); PG8_STAGE(PG8_SA(0, 1), a2 + hstep, voffA);
            PG8_WAIT_V(8); PG8_WAIT_L(0); PG8_BAR; PG8_MMA(0, 0, At, B0); PG8_MMA(0, 1, At, B1); PG8_BAR; PG8_SCHED;
            PG8_LDA(At, 1, 1); PG8_STAGE(PG8_SB(1, 0), b3, voffB); PG8_STAGE(PG8_SB(1, 1), b3 + hstep, voffB); PG8_STAGE(PG8_SA(1, 0), a3, voffA);
            PG8_WAIT_V(8); PG8_WAIT_L(0); PG8_BAR; PG8_MMA(1, 0, At, B0); PG8_MMA(1, 1, At, B1); PG8_BAR; PG8_SCHED;
            } else {
            PG8_LDB(B0, 0, 0); PG8_SCHED; PG8_LDA(At, 0, 0); PG8_STAGE(PG8_SA(1, 1), a1 + hstep, voffA);
            PG8_WAIT_L(8); PG8_BAR; PG8_WAIT_L(0); PG8_MMA(0, 0, At, B0); PG8_BAR; PG8_SCHED;
            PG8_LDB(B1, 0, 1); PG8_STAGE(PG8_SB(0, 0), b2, voffB);
            PG8_BAR; PG8_WAIT_L(0); PG8_MMA(0, 1, At, B1); PG8_BAR;
            PG8_LDA(At, 0, 1); PG8_STAGE(PG8_SA(0, 0), a2, voffA);
            PG8_BAR; PG8_WAIT_L(0); PG8_MMA(1, 0, At, B0); PG8_BAR; PG8_SCHED;
            PG8_STAGE(PG8_SB(0, 1), b2 + hstep, voffB);
            PG8_WAIT_V(6); PG8_BAR; PG8_MMA(1, 1, At, B1); PG8_BAR;
            PG8_LDB(B0, 1, 0); PG8_SCHED; PG8_LDA(At, 1, 0); PG8_STAGE(PG8_SA(0, 1), a2 + hstep, voffA);
            PG8_WAIT_L(8); PG8_BAR; PG8_WAIT_L(0); PG8_MMA(0, 0, At, B0); PG8_BAR; PG8_SCHED;
            PG8_LDB(B1, 1, 1); PG8_STAGE(PG8_SB(1, 0), b3, voffB);
            PG8_BAR; PG8_WAIT_L(0); PG8_MMA(0, 1, At, B1); PG8_BAR;
            PG8_LDA(At, 1, 1); PG8_STAGE(PG8_SA(1, 0), a3, voffA);
            PG8_BAR; PG8_WAIT_L(0); PG8_MMA(1, 0, At, B0); PG8_BAR; PG8_SCHED;
            PG8_STAGE(PG8_SB(1, 1), b3 + hstep, voffB);
            PG8_WAIT_V(6); PG8_BAR; PG8_MMA(1, 1, At, B1); PG8_BAR;
            }
        }
        if constexpr (ALIGN_EPI) { if (wr == 0) PG8_BAR; }
        if constexpr (!Epi::AFTER_DRAIN) { E(acc, cur, wr, wc, fr, fq); S.done(cur); }
        if (!has_next) break;
#pragma unroll
        for (int a = 0; a < 2; ++a)
#pragma unroll
            for (int b = 0; b < 2; ++b)
#pragma unroll
                for (int m = 0; m < 4; ++m)
#pragma unroll
                    for (int n = 0; n < 2; ++n) acc[a][b][m][n] = (f32x4){0.f, 0.f, 0.f, 0.f};
        cur = nxt; cA = nA; cB = nB; ++ui;
        if constexpr (ALIGN_EPI) { if (wr == 1) PG8_BAR; }
    }
    PG8_WAIT_V(0);
    if constexpr (!ALIGN_EPI) { if (wr == 0) PG8_BAR; }
    PG8_BAR;
    if constexpr (Epi::AFTER_DRAIN) { E.fused(acc, cur, wr, wc, fr, fq, lds, wid, lane); S.done(cur); }
#undef PG8_SA
#undef PG8_SB
#undef PG8_STAGE
#undef PG8_LDA
#undef PG8_LDB
#undef PG8_LDF
#undef PG8_MMA
#undef PG8_WAIT_V
#undef PG8_WAIT_L
#undef PG8_BAR
#undef PG8_SCHED
}
}

__device__ __forceinline__ void cvt_phase(const P& p, int wg, int nwg) {
    bf16_t* XB = WSP(bf16_t, WS_XB);
    const size_t n4 = (size_t)M * D / 4;
    const int tid = ltid();
    for (size_t i = (size_t)wg * NT + tid; i < n4; i += (size_t)nwg * NT) {
        const f32x4 v = ((const f32x4*)p.x)[i];
        u32x2 o; o.x = f2bf(v.x) | (f2bf(v.y) << 16); o.y = f2bf(v.z) | (f2bf(v.w) << 16);
        ((u32x2*)XB)[i] = o;
    }
}

__device__ __forceinline__ void cum_phase(const P& p, LAS unsigned char* lds, int wg, int nwg) {
    const float* FL = WSP(const float, WS_FL); float* CUM = WSP(float, WS_CUM);
    LAS float* wsum = (LAS float*)lds;
    const int tid = ltid(), lane = tid & 63, wv = tid >> 6;
    for (int it = wg; it < NB * NH; it += nwg) {
        const int b = it / NH, h = it % NH;
        float v[8]; float s = 0.f;
#pragma unroll
        for (int j = 0; j < 8; ++j) { const int t = tid * 8 + j; const float z = FL[((size_t)b * L + t) * 8 + h];
            const float ls = fminf(z, 0.f) - log1pf(__expf(-fabsf(z))); s += ls; v[j] = s; }
        float incl = s;
#pragma unroll
        for (int o = 1; o < 64; o <<= 1) { const float u = __shfl_up(incl, o); if (lane >= o) incl += u; }
        if (lane == 63) wsum[wv] = incl;
        __syncthreads();
        float base = incl - s;
        for (int w = 0; w < wv; ++w) base += wsum[w];
#pragma unroll
        for (int j = 0; j < 8; ++j) CUM[((size_t)b * NH + h) * L + tid * 8 + j] = base + v[j];
        __syncthreads();
    }
}

__device__ __forceinline__ void norm_phase(const P& p, unsigned* kmax2, float* qmax2, int wg, int nwg) {
    const int tid = ltid(), lane = tid & 63;
    for (int it = wg; it < 512; it += nwg) {
        const int mixer = it >> 8, bh = (it >> 2) & 63, qt = it & 3, b = bh >> 3, h = bh & 7;
        const bf16_t* Q = mixer ? WSP(const bf16_t, WS_DQ) : WSP(const bf16_t, WS_FQ); const bf16_t* K = mixer ? WSP(const bf16_t, WS_DK) : WSP(const bf16_t, WS_FK);
        float qm = 0.f, km = 0.f;
#pragma unroll
        for (int j = 0; j < 2; ++j) {
            const size_t row = (size_t)b * L + qt * 1024 + tid * 2 + j;
            const u32x4* qr = (const u32x4*)(Q + row * 512 + h * 64); const u32x4* kr = (const u32x4*)(K + row * 512 + h * 64);
            float qs = 0.f, ks = 0.f;
#pragma unroll
            for (int c = 0; c < 8; ++c) { const u32x4 a = qr[c], d = kr[c];
                const float q0 = bf2f(a.x & 0xffffu), q1 = __uint_as_float(a.x & 0xffff0000u), q2 = bf2f(a.y & 0xffffu), q3 = __uint_as_float(a.y & 0xffff0000u), q4 = bf2f(a.z & 0xffffu), q5 = __uint_as_float(a.z & 0xffff0000u), q6 = bf2f(a.w & 0xffffu), q7 = __uint_as_float(a.w & 0xffff0000u);
                const float k0 = bf2f(d.x & 0xffffu), k1 = __uint_as_float(d.x & 0xffff0000u), k2 = bf2f(d.y & 0xffffu), k3 = __uint_as_float(d.y & 0xffff0000u), k4 = bf2f(d.z & 0xffffu), k5 = __uint_as_float(d.z & 0xffff0000u), k6 = bf2f(d.w & 0xffffu), k7 = __uint_as_float(d.w & 0xffff0000u);
                qs += (q0 * q0 + q1 * q1) + (q2 * q2 + q3 * q3) + (q4 * q4 + q5 * q5) + (q6 * q6 + q7 * q7);
                ks += (k0 * k0 + k1 * k1) + (k2 * k2 + k3 * k3) + (k4 * k4 + k5 * k5) + (k6 * k6 + k7 * k7); }
            qm = fmaxf(qm, qs); km = fmaxf(km, ks);
        }
#pragma unroll
        for (int o = 1; o < 64; o <<= 1) { qm = fmaxf(qm, __shfl_xor(qm, o)); km = fmaxf(km, __shfl_xor(km, o)); }
        if (lane == 0) {
            __hip_atomic_fetch_max((unsigned*)qmax2 + (mixer * 64 + bh) * 16 + qt * 4 + (tid >> 7), __float_as_uint(qm * 1.01f), __ATOMIC_RELAXED, __HIP_MEMORY_SCOPE_AGENT);
            __hip_atomic_fetch_max(kmax2 + mixer * 64 + bh, __float_as_uint(km * 1.01f), __ATOMIC_RELAXED, __HIP_MEMORY_SCOPE_AGENT);
        }
    }
}

__device__ __forceinline__ void ln_phase(const bf16_t* Y, const float* g, const float* bta, bf16_t* XO, float* FO, int wg, int nwg, unsigned char* X8 = nullptr) {
    const int tid = ltid(), lane = tid & 63, wv = tid >> 6;
    for (int m = wg * 8 + wv; m < M; m += nwg * 8) {
        const u32x4* yr = (const u32x4*)(Y + (size_t)m * D) + 2 * lane;
        const u32x4 a = yr[0], b = yr[1];
        float v[16] = {bf2f(a.x & 0xffffu), __uint_as_float(a.x & 0xffff0000u), bf2f(a.y & 0xffffu), __uint_as_float(a.y & 0xffff0000u), bf2f(a.z & 0xffffu), __uint_as_float(a.z & 0xffff0000u), bf2f(a.w & 0xffffu), __uint_as_float(a.w & 0xffff0000u),
                       bf2f(b.x & 0xffffu), __uint_as_float(b.x & 0xffff0000u), bf2f(b.y & 0xffffu), __uint_as_float(b.y & 0xffff0000u), bf2f(b.z & 0xffffu), __uint_as_float(b.z & 0xffff0000u), bf2f(b.w & 0xffffu), __uint_as_float(b.w & 0xffff0000u)};
        float s = 0.f;
#pragma unroll
        for (int j = 0; j < 16; ++j) s += v[j];
#pragma unroll
        for (int o = 1; o < 64; o <<= 1) s += __shfl_xor(s, o);
        const float mean = s * (1.f / D); float s2 = 0.f;
#pragma unroll
        for (int j = 0; j < 16; ++j) { v[j] -= mean; s2 += v[j] * v[j]; }
#pragma unroll
        for (int o = 1; o < 64; o <<= 1) s2 += __shfl_xor(s2, o);
        const float rstd = 1.f / sqrtf(s2 * (1.f / D) + LN_EPS);
        const f32x4* gp = (const f32x4*)g + 4 * lane; const f32x4* bp = (const f32x4*)bta + 4 * lane;
        f32x4 o4[4];
#pragma unroll
        for (int j = 0; j < 4; ++j) { const f32x4 gg = gp[j], bb = bp[j]; o4[j] = (f32x4){v[4 * j], v[4 * j + 1], v[4 * j + 2], v[4 * j + 3]} * rstd * gg + bb; }
        if (XO) { u32x4 w0, w1;
            w0.x = f2bf(o4[0].x) | (f2bf(o4[0].y) << 16); w0.y = f2bf(o4[0].z) | (f2bf(o4[0].w) << 16); w0.z = f2bf(o4[1].x) | (f2bf(o4[1].y) << 16); w0.w = f2bf(o4[1].z) | (f2bf(o4[1].w) << 16);
            w1.x = f2bf(o4[2].x) | (f2bf(o4[2].y) << 16); w1.y = f2bf(o4[2].z) | (f2bf(o4[2].w) << 16); w1.z = f2bf(o4[3].x) | (f2bf(o4[3].y) << 16); w1.w = f2bf(o4[3].z) | (f2bf(o4[3].w) << 16);
            u32x4* xo = (u32x4*)(XO + (size_t)m * D) + 2 * lane; xo[0] = w0; xo[1] = w1;
            if (X8) { u32x4 q; q.x = pk4_fp8(o4[0].x, o4[0].y, o4[0].z, o4[0].w); q.y = pk4_fp8(o4[1].x, o4[1].y, o4[1].z, o4[1].w); q.z = pk4_fp8(o4[2].x, o4[2].y, o4[2].z, o4[2].w); q.w = pk4_fp8(o4[3].x, o4[3].y, o4[3].z, o4[3].w);
                *((u32x4*)(X8 + (size_t)m * D) + lane) = q; } }
        else { f32x4* fo = (f32x4*)(FO + (size_t)m * D) + 4 * lane;
#pragma unroll
            for (int j = 0; j < 4; ++j) fo[j] = o4[j]; }
    }
}

__device__ __forceinline__ unsigned sortable(float f) { const unsigned u = __float_as_uint(f); return (u & 0x80000000u) ? ~u : (u | 0x80000000u); }
__device__ __forceinline__ unsigned wg_sum(unsigned c, LAS unsigned* buf, int par, int tid) {
#pragma unroll
    for (int o = 1; o < 64; o <<= 1) c += __shfl_xor(c, o);
    if ((tid & 63) == 0) buf[par * 8 + (tid >> 6)] = c;
    __syncthreads();
    unsigned s = 0;
#pragma unroll
    for (int w = 0; w < 8; ++w) s += buf[par * 8 + w];
    return s;
}
__device__ __forceinline__ void idx_phase(const P& p, LAS unsigned char* lds, int wg, int nwg) {
    const bf16_t* IQ = WSP(const bf16_t, WS_IQ); const bf16_t* IK = WSP(const bf16_t, WS_IK); const float* IW = WSP(const float, WS_IW);
    unsigned* MASK = WSP(unsigned, WS_MASK);
    LAS float* iqs = (LAS float*)lds;
    LAS float* wv = iqs + 512;
    LAS unsigned* cbuf = (LAS unsigned*)(wv + 8);
    LAS unsigned* wtot = cbuf + 16;
    LAS unsigned char* bytes = (LAS unsigned char*)(wtot + 8);
    LAS unsigned* sc = (LAS unsigned*)(bytes + 512);
    const int tid = ltid(), lane = tid & 63, wave = tid >> 6;
    for (int row = wg; row < M; row += nwg) {
        const int b = row / L, t = row % L, n = t + 1;
        iqs[tid] = bf2f(IQ[(size_t)row * 512 + tid]);
        if (tid < 8) wv[tid] = IW[(size_t)row * 8 + tid] * IDX_SCALE;
        __syncthreads();
        for (int s = tid; s < L; s += NT) {
            unsigned key = 0u;
            if (s < n) {
                float kf[64];
                const u32x4* kr = (const u32x4*)(IK + ((size_t)b * L + s) * 64);
#pragma unroll
                for (int c = 0; c < 8; ++c) { const u32x4 v = kr[c];
                    kf[c * 8 + 0] = bf2f(v.x & 0xffffu); kf[c * 8 + 1] = bf2f(v.x >> 16); kf[c * 8 + 2] = bf2f(v.y & 0xffffu); kf[c * 8 + 3] = bf2f(v.y >> 16);
                    kf[c * 8 + 4] = bf2f(v.z & 0xffffu); kf[c * 8 + 5] = bf2f(v.z >> 16); kf[c * 8 + 6] = bf2f(v.w & 0xffffu); kf[c * 8 + 7] = bf2f(v.w >> 16); }
                float score = 0.f;
#pragma unroll 1
                for (int h = 0; h < 8; ++h) {
                    float d0 = 0.f, d1 = 0.f;
#pragma unroll
                    for (int d = 0; d < 64; d += 4) { const f32x4 q = *(const LAS f32x4*)(iqs + h * 64 + d);
                        d0 = fmaf(q.x, kf[d], d0); d1 = fmaf(q.y, kf[d + 1], d1); d0 = fmaf(q.z, kf[d + 2], d0); d1 = fmaf(q.w, kf[d + 3], d1); }
                    score = fmaf(wv[h], fmaxf(d0 + d1, 0.f), score);
                }
                key = sortable(score + 0.f);
                if (key == 0u) key = 1u;
            }
            sc[s] = key;
        }
        __syncthreads();
        unsigned k8[8];
#pragma unroll
        for (int j = 0; j < 8; ++j) k8[j] = sc[tid * 8 + j];
        unsigned bits = 0u;
        if (n <= TOPK) {
#pragma unroll
            for (int j = 0; j < 8; ++j) if (tid * 8 + j < n) bits |= 1u << j;
        } else {
            unsigned T = 0u; int par = 0;
            for (int bit = 31; bit >= 0; --bit) {
                const unsigned cand = T | (1u << bit); unsigned c = 0;
#pragma unroll
                for (int j = 0; j < 8; ++j) c += (k8[j] >= cand) ? 1u : 0u;
                if (wg_sum(c, cbuf, par, tid) >= (unsigned)TOPK) T = cand;
                par ^= 1;
            }
            unsigned cg = 0, ce = 0;
#pragma unroll
            for (int j = 0; j < 8; ++j) { cg += (k8[j] > T) ? 1u : 0u; ce += (k8[j] == T) ? 1u : 0u; }
            const unsigned G = wg_sum(cg, cbuf, par, tid); par ^= 1;
            const unsigned E = (unsigned)TOPK - G;
            unsigned incl = ce;
#pragma unroll
            for (int o = 1; o < 64; o <<= 1) { const unsigned u = __shfl_up(incl, o); if (lane >= o) incl += u; }
            if (lane == 63) wtot[wave] = incl;
            __syncthreads();
            unsigned rank = incl - ce;
            for (int w = 0; w < wave; ++w) rank += wtot[w];
#pragma unroll
            for (int j = 0; j < 8; ++j) {
                if (k8[j] > T) bits |= 1u << j;
                else if (k8[j] == T) { if (rank < E) bits |= 1u << j; ++rank; }
            }
        }
        bytes[tid] = (unsigned char)bits;
        __syncthreads();
        if (tid < 128) MASK[(size_t)row * 128 + tid] = ((const LAS unsigned*)bytes)[tid];
        __syncthreads();
    }
}

template <bool DSA>
__device__ __forceinline__ void attn_item(const P& p, int item) {
    const int qc = item & 7, h = (item >> 3) & 7, b = item >> 6;
    const int t = qc * 512 + ltid();
    const size_t row = (size_t)b * L + t;
    const bf16_t* Q = DSA ? WSP(const bf16_t, WS_DQ) : WSP(const bf16_t, WS_FQ);
    const bf16_t* K = DSA ? WSP(const bf16_t, WS_DK) : WSP(const bf16_t, WS_FK);
    const bf16_t* V = DSA ? WSP(const bf16_t, WS_DV) : WSP(const bf16_t, WS_FV);
    bf16_t* O = DSA ? WSP(bf16_t, WS_OB) : WSP(bf16_t, WS_OA);
    const float* cum = WSP(const float, WS_CUM) + ((size_t)b * NH + h) * L;
    const unsigned* mrow = WSP(const unsigned, WS_MASK) + row * 128;
    float q[64], o[64];
    {
        const u32x4* qr = (const u32x4*)(Q + row * 512 + h * 64);
#pragma unroll
        for (int c = 0; c < 8; ++c) { const u32x4 v = qr[c];
            q[c * 8 + 0] = bf2f(v.x & 0xffffu); q[c * 8 + 1] = bf2f(v.x >> 16); q[c * 8 + 2] = bf2f(v.y & 0xffffu); q[c * 8 + 3] = bf2f(v.y >> 16);
            q[c * 8 + 4] = bf2f(v.z & 0xffffu); q[c * 8 + 5] = bf2f(v.z >> 16); q[c * 8 + 6] = bf2f(v.w & 0xffffu); q[c * 8 + 7] = bf2f(v.w >> 16); }
    }
#pragma unroll
    for (int d = 0; d < 64; ++d) o[d] = 0.f;
    float mx = -1e30f, l = 0.f;
    const float ct = DSA ? 0.f : cum[t] * LOG2E;
    const float slope2 = exp2f(-(float)(h + 1)) * LOG2E;
    const int tmax = __builtin_amdgcn_readfirstlane(t | 63);
    const bf16_t* Kh = K + (size_t)b * L * 512 + h * 64;
    const bf16_t* Vh = V + (size_t)b * L * 512 + h * 64;
    for (int s0 = 0; s0 <= tmax; s0 += 2) {
        float xv[2]; bool ok[2];
        const unsigned mb = DSA ? (mrow[s0 >> 5] >> (s0 & 31)) : 0x3u;
#pragma unroll
        for (int j = 0; j < 2; ++j) {
            const int s = s0 + j;
            const u32x4* kr = (const u32x4*)(Kh + (size_t)s * 512);
            float d0 = 0.f, d1 = 0.f;
#pragma unroll
            for (int c = 0; c < 8; ++c) { const u32x4 v = kr[c];
                d0 = fmaf(q[c * 8 + 0], bf2f(v.x & 0xffffu), d0); d1 = fmaf(q[c * 8 + 1], bf2f(v.x >> 16), d1);
                d0 = fmaf(q[c * 8 + 2], bf2f(v.y & 0xffffu), d0); d1 = fmaf(q[c * 8 + 3], bf2f(v.y >> 16), d1);
                d0 = fmaf(q[c * 8 + 4], bf2f(v.z & 0xffffu), d0); d1 = fmaf(q[c * 8 + 5], bf2f(v.z >> 16), d1);
                d0 = fmaf(q[c * 8 + 6], bf2f(v.w & 0xffffu), d0); d1 = fmaf(q[c * 8 + 7], bf2f(v.w >> 16), d1); }
            const float dot = d0 + d1;
            ok[j] = (s <= t) && ((mb >> j) & 1u);
            const float xx = DSA ? (dot - slope2 * (float)(t - s)) : (dot + (ct - cum[s] * LOG2E));
            xv[j] = ok[j] ? xx : -1e30f;
        }
        const float mnew = fmaxf(fmaxf(xv[0], xv[1]), mx);
        const float alpha = exp2f(mx - mnew);
        mx = mnew; l *= alpha;
#pragma unroll
        for (int d = 0; d < 64; ++d) o[d] *= alpha;
#pragma unroll
        for (int j = 0; j < 2; ++j) {
            const int s = s0 + j;
            const float pj = ok[j] ? exp2f(xv[j] - mnew) : 0.f;
            l += pj;
            const u32x4* vr = (const u32x4*)(Vh + (size_t)s * 512);
#pragma unroll
            for (int c = 0; c < 8; ++c) { const u32x4 v = vr[c];
                o[c * 8 + 0] = fmaf(pj, bf2f(v.x & 0xffffu), o[c * 8 + 0]); o[c * 8 + 1] = fmaf(pj, bf2f(v.x >> 16), o[c * 8 + 1]);
                o[c * 8 + 2] = fmaf(pj, bf2f(v.y & 0xffffu), o[c * 8 + 2]); o[c * 8 + 3] = fmaf(pj, bf2f(v.y >> 16), o[c * 8 + 3]);
                o[c * 8 + 4] = fmaf(pj, bf2f(v.z & 0xffffu), o[c * 8 + 4]); o[c * 8 + 5] = fmaf(pj, bf2f(v.z >> 16), o[c * 8 + 5]);
                o[c * 8 + 6] = fmaf(pj, bf2f(v.w & 0xffffu), o[c * 8 + 6]); o[c * 8 + 7] = fmaf(pj, bf2f(v.w >> 16), o[c * 8 + 7]); }
        }
    }
    const float rl = 1.f / l;
    u32x4* orow = (u32x4*)(O + row * 512 + h * 64);
#pragma unroll
    for (int c = 0; c < 8; ++c) { u32x4 w;
        w.x = f2bf(o[c * 8 + 0] * rl) | (f2bf(o[c * 8 + 1] * rl) << 16); w.y = f2bf(o[c * 8 + 2] * rl) | (f2bf(o[c * 8 + 3] * rl) << 16);
        w.z = f2bf(o[c * 8 + 4] * rl) | (f2bf(o[c * 8 + 5] * rl) << 16); w.w = f2bf(o[c * 8 + 6] * rl) | (f2bf(o[c * 8 + 7] * rl) << 16);
        orow[c] = w; }
}
__device__ __forceinline__ void attn_phase_naive(const P& p, int wg, int nwg) {
    for (int it = wg; it < 1024; it += nwg) {
        const int r = it >> 1; const int item = (r & ~7) | (7 - (r & 7));
        if (it & 1) attn_item<true>(p, item); else attn_item<false>(p, item);
    }
}

#include <hip/hip_bf16.h>
#include <cmath>
namespace attn_body {
using bf16=__hip_bfloat16;
using bf16x8=__attribute__((ext_vector_type(8)))short;
using s16x4=__attribute__((ext_vector_type(4)))short;
using f32x16=__attribute__((ext_vector_type(16)))float;
using u32x4=__attribute__((ext_vector_type(4)))unsigned;
typedef float f32x4_t __attribute__((ext_vector_type(4)));
constexpr int BATCH=8,NHEAD=8,SEQ=4096,D=64,DM=NHEAD*D;
constexpr int NW=8,QBLK=32,QB=QBLK*NW,KVBLK=64,NQB=SEQ/QB;
constexpr int ATTN_PITCH=DM, ATTN_UNIT_ROWS=QB;
__device__ __forceinline__ int crow(int r,int hi){return (r&3)+8*(r>>2)+4*hi;}
#define SBAR() __builtin_amdgcn_sched_barrier(0)
__device__ __forceinline__ void cmask(f32x16&p0,f32x16&p1,int jb,int qrel,int hi){
  const float NEG=-INFINITY; int kb=64*jb+4*hi;
  #pragma unroll
  for(int r=0;r<16;++r){int kv=kb+(r&3)+8*(r>>2); if(kv>qrel)p0[r]=NEG; if(kv+32>qrel)p1[r]=NEG;}
}

constexpr int NSLOT=3, SLOTB=8192;
constexpr int LDS_K=0, LDS_V=NSLOT*SLOTB, LDS_WS=2*NSLOT*SLOTB, LDS_OST=LDS_WS+NW*64*4, LDS_TAB=LDS_OST+NW*4096, LDS_BYTES=LDS_TAB+SEQ*4;
constexpr float C2=0.125f*1.4426950408889634f;
__device__ __forceinline__ void glds16(const void*gsrc,unsigned lds_dst){unsigned keep;
  asm volatile("s_mov_b32 %0, m0\n\ts_mov_b32 m0, %2\n\ts_nop 0\n\tglobal_load_lds_dwordx4 %1, off\n\ts_mov_b32 m0, %0":"=&s"(keep):"v"(gsrc),"s"(lds_dst):"memory");}
__device__ __forceinline__ float max3f(float a,float b,float c){float r;asm("v_max3_f32 %0, %1, %2, %3":"=v"(r):"v"(a),"v"(b),"v"(c));return r;}
__device__ __forceinline__ float max2f(float a,float b){float r;asm("v_max_f32_e32 %0, %1, %2":"=v"(r):"v"(a),"v"(b));return r;}
__device__ __forceinline__ float fadd_s(float a,float b){float r;asm("v_add_f32_e32 %0, %1, %2":"=v"(r):"v"(a),"v"(b));return r;}
__device__ __forceinline__ float fsub_s(float a,float b){float r;asm("v_sub_f32_e32 %0, %1, %2":"=v"(r):"v"(a),"v"(b));return r;}
typedef float f32x2_t __attribute__((ext_vector_type(2))); typedef __bf16 bf16x2_t __attribute__((ext_vector_type(2)));
__device__ __forceinline__ unsigned cvtpk_s(float lo,float hi){f32x2_t v={lo,hi};bf16x2_t b=__builtin_convertvector(v,bf16x2_t);return __builtin_bit_cast(unsigned,b);}
#define WAIT_BAR(N) asm volatile("s_waitcnt vmcnt(" #N ") lgkmcnt(0)\n\ts_barrier":::"memory")

__device__ __forceinline__ void qkt(f32x16&p0,f32x16&p1,const char*Kslot,const bf16x8*qr,const f32x16&negm,int r32,int hi){
  const char*kb=Kslot+hi*1024+r32*16;
  #pragma unroll
  for(int d0=0;d0<4;++d0){
    const bf16x8 b0=*reinterpret_cast<const bf16x8*>(kb+d0*2048);
    const bf16x8 b1=*reinterpret_cast<const bf16x8*>(kb+d0*2048+512);
    if(d0==0){p0=__builtin_amdgcn_mfma_f32_32x32x16_bf16(b0,qr[0],negm,0,0,0);p1=__builtin_amdgcn_mfma_f32_32x32x16_bf16(b1,qr[0],negm,0,0,0);}
    else{p0=__builtin_amdgcn_mfma_f32_32x32x16_bf16(b0,qr[d0],p0,0,0,0);p1=__builtin_amdgcn_mfma_f32_32x32x16_bf16(b1,qr[d0],p1,0,0,0);}}
}
typedef __attribute__((address_space(3))) const char* lds_cptr;
typedef short v4i16_t __attribute__((ext_vector_type(4)));
__device__ __forceinline__ void kload8(bf16x8*kf,lds_cptr kp){
  kf[0]=*(const __attribute__((address_space(3))) bf16x8*)(kp);      kf[1]=*(const __attribute__((address_space(3))) bf16x8*)(kp+512);
  kf[2]=*(const __attribute__((address_space(3))) bf16x8*)(kp+2048); kf[3]=*(const __attribute__((address_space(3))) bf16x8*)(kp+2560);
  kf[4]=*(const __attribute__((address_space(3))) bf16x8*)(kp+4096); kf[5]=*(const __attribute__((address_space(3))) bf16x8*)(kp+4608);
  kf[6]=*(const __attribute__((address_space(3))) bf16x8*)(kp+6144); kf[7]=*(const __attribute__((address_space(3))) bf16x8*)(kp+6656);
}
__device__ __forceinline__ void kload2(bf16x8*kf,lds_cptr kp,int j){ kf[2*j]=*(const __attribute__((address_space(3))) bf16x8*)(kp+j*2048); kf[2*j+1]=*(const __attribute__((address_space(3))) bf16x8*)(kp+j*2048+512); }
__device__ __forceinline__ s16x4 vtr(lds_cptr p){ return __builtin_bit_cast(s16x4,__builtin_amdgcn_ds_read_tr16_b64_v4i16((__attribute__((address_space(3))) v4i16_t*)p)); }
__device__ __forceinline__ float rowmax(const f32x16&p0,const f32x16&p1){
  float a=max3f(p0[0],p0[1],p1[0]),b=max3f(p0[2],p0[3],p1[1]);a=max3f(a,p1[2],p1[3]);
  #pragma unroll
  for(int r=4;r<16;r+=4){a=max3f(a,p0[r],p0[r+1]);b=max3f(b,p0[r+2],p0[r+3]);a=max3f(a,p1[r],p1[r+1]);b=max3f(b,p1[r+2],p1[r+3]);}
  const float m=max2f(a,b);
  auto rr=__builtin_amdgcn_permlane32_swap(__float_as_uint(m),__float_as_uint(m),false,false);
  return max2f(__uint_as_float(rr[0]),__uint_as_float(rr[1]));
}
__device__ __forceinline__ void pv(f32x16*o,int vb,bf16x8 pa0,bf16x8 pa1,bf16x8 pa2,bf16x8 pa3){
  #pragma unroll
  for(int d0=0;d0<2;++d0){s16x4 lo[4],hi[4];
    #pragma unroll
    for(int ks=0;ks<4;++ks){
      asm volatile("ds_read_b64_tr_b16 %0,%1 offset:%c2":"=&v"(lo[ks]):"v"(vb),"i"(d0*4096+ks*1024):"memory");
      asm volatile("ds_read_b64_tr_b16 %0,%1 offset:%c2":"=&v"(hi[ks]):"v"(vb),"i"(d0*4096+ks*1024+512):"memory");}
    asm volatile("s_waitcnt lgkmcnt(0)":::"memory");SBAR();
    #define PK(k) (bf16x8){lo[k][0],lo[k][1],lo[k][2],lo[k][3],hi[k][0],hi[k][1],hi[k][2],hi[k][3]}
    o[d0]=__builtin_amdgcn_mfma_f32_32x32x16_bf16(pa0,PK(0),o[d0],0,0,0);
    o[d0]=__builtin_amdgcn_mfma_f32_32x32x16_bf16(pa1,PK(1),o[d0],0,0,0);
    o[d0]=__builtin_amdgcn_mfma_f32_32x32x16_bf16(pa2,PK(2),o[d0],0,0,0);
    o[d0]=__builtin_amdgcn_mfma_f32_32x32x16_bf16(pa3,PK(3),o[d0],0,0,0);
    #undef PK
  }
}

#ifndef ATTN_STORE16
#define ATTN_STORE16(p,v) (*(u32x4*)(p)=(v))
#endif
template<int THRL,bool DSA> __device__ __forceinline__ void attn_unit(int b,int h,int qb,int jstart,const bf16*Q,const bf16*__restrict__ K,const bf16*__restrict__ V,bf16*O,const unsigned*__restrict__ MASK,char*shm){
  const int tid=ltid(),lane=tid&63,r32=lane&31,hi=lane>>5; const int wid=__builtin_amdgcn_readfirstlane(tid>>6);
  const long rowbase=(long)b*SEQ; const int q0=qb*QB;
  const bf16*Qw=Q+(rowbase+q0+wid*QBLK)*DM+h*D;
  const bf16*Kh=K+(rowbase+(long)jstart*KVBLK)*DM+h*D,*Vh=V+(rowbase+(long)jstart*KVBLK)*DM+h*D;
  const unsigned lds0=(unsigned)(uintptr_t)shm;
  float*wsf=(float*)(shm+LDS_WS)+wid*64;
  const bf16*ksrc=Kh+(long)lane*DM+wid*8;
  const bf16*vsrc=Vh+(long)(16*(wid&3)+(lane>>2))*DM+(wid>>2)*32+(lane&3)*8;
  const unsigned kdst=lds0+LDS_K+wid*1024, vdst=lds0+LDS_V+wid*1024;
  #define DMA_K(t,slot) glds16(ksrc+(long)(t)*KVBLK*DM,(unsigned)__builtin_amdgcn_readfirstlane(kdst+(slot)))
  #define DMA_V(t,slot) glds16(vsrc+(long)(t)*KVBLK*DM,(unsigned)__builtin_amdgcn_readfirstlane(vdst+(slot)))
  const int vb0=(int)(lds0+LDS_V)+((lane>>4)&1)*32+(lane&3)*8+(4*hi+((lane&15)>>2))*64;
  const char*Kbase=shm+LDS_K; bf16x8 kf[8];
  const lds_cptr shm3=(lds_cptr)shm; const lds_cptr kp0=shm3+LDS_K+hi*1024+r32*16; const lds_cptr vp0=shm3+LDS_V+((lane>>4)&1)*32+(lane&3)*8+(4*hi+((lane&15)>>2))*64;
  const int NT=(q0+QB)/KVBLK-jstart;
  DMA_K(0,0);DMA_V(0,0);DMA_K(1,SLOTB);
  bf16x8 qr[4];
  #pragma unroll
  for(int d0=0;d0<4;++d0)qr[d0]=*reinterpret_cast<const bf16x8*>(&Qw[(long)r32*DM+d0*16+hi*8]);
  float mhat=0.f,l_reg=0.f;f32x16 o[2];o[0]=f32x16{};o[1]=f32x16{};f32x16 negm=f32x16{};
  const int qrel=wid*QBLK+r32;
  const __attribute__((address_space(3))) float* tabp0=(const __attribute__((address_space(3))) float*)((lds_cptr)shm+LDS_TAB); const __attribute__((address_space(3))) float* tabp=tabp0+jstart*KVBLK;
  const unsigned moff=(unsigned)((((b*(SEQ/32)+((q0+qrel)>>5))*64+jstart)*32+((q0+qrel)&31))*8);
  unsigned long long mw=0ull;
  #define CMASK(P0,P1,t) do{ if(!DSA){int jb_=(t)-(NT-4); if(jb_>=0)cmask(P0,P1,jb_,qrel,hi);} }while(0)
  #define BIAS(P0,P1,t) do{ const __attribute__((address_space(3))) float* tb_=tabp+(t)*64+4*hi; \
    _Pragma("unroll") for(int g_=0;g_<4;++g_){ const f32x4_t a_=*(const __attribute__((address_space(3))) f32x4_t*)(tb_+8*g_), b_=*(const __attribute__((address_space(3))) f32x4_t*)(tb_+32+8*g_); \
      _Pragma("unroll") for(int e_=0;e_<4;++e_){ P0[4*g_+e_]-=a_[e_]; P1[4*g_+e_]-=b_[e_]; } } }while(0)
  #define MLOAD(t) do{ if(DSA) mw=*(const unsigned long long*)((const char*)MASK+(moff+(unsigned)(t)*256u)); }while(0)
  #define DMASK(P0,P1) do{ if(DSA){ const unsigned w0_=~((unsigned)mw>>(4*hi)), w1_=~((unsigned)(mw>>32)>>(4*hi)); \
    _Pragma("unroll") for(int r=0;r<16;++r){ const unsigned c_=(r&3)+8*(r>>2); \
      const float t0_=__uint_as_float(((unsigned)__builtin_amdgcn_sbfe((int)w0_,c_,1u)&0x80000000u)|0x7f800000u), t1_=__uint_as_float(((unsigned)__builtin_amdgcn_sbfe((int)w1_,c_,1u)&0x80000000u)|0x7f800000u); \
      P0[r]=__builtin_fminf(P0[r],t0_); P1[r]=__builtin_fminf(P1[r],t1_); } } }while(0)
  bool resc=false;
  #define START(P0,P1) do{ const float rm=__builtin_fmaxf(rowmax(P0,P1),-4000.f); resc=false; \
    { const float dl=rm; mhat=fadd_s(mhat,dl); \
      _Pragma("unroll") for(int r=0;r<16;++r){P0[r]=fsub_s(P0[r],dl);P1[r]=fsub_s(P1[r],dl);} \
      _Pragma("unroll") for(int r=0;r<16;++r)negm[r]=-mhat; asm volatile("":"+v"(negm)); } \
    _Pragma("unroll") for(int r=0;r<16;++r)P0[r]=__builtin_amdgcn_exp2f(P0[r]); }while(0)
  #define RESC() do{ if(resc){ asm volatile("s_waitcnt lgkmcnt(0)":::"memory"); \
      _Pragma("unroll") for(int d_=0;d_<2;++d_) _Pragma("unroll") for(int r=0;r<16;++r)o[d_][r]*=wsf[crow(r,hi)]; } }while(0)
  f32x16 pA0,pA1,pB0,pB1;
  int sl_prev=0,sl_cur=0,sl_next=SLOTB;
  #define ROT() do{sl_prev=sl_cur;sl_cur=sl_next;sl_next=(sl_next==(NSLOT-1)*SLOTB)?0:sl_next+SLOTB;}while(0)
  DMA_K(2,2*SLOTB);
  MLOAD(0);
  WAIT_BAR(3);
  { const float tq=tabp0[q0+qrel]; mhat=-tq; _Pragma("unroll") for(int r=0;r<16;++r)negm[r]=tq; asm volatile("":"+v"(negm)); }
  qkt(pA0,pA1,Kbase,qr,negm,r32,hi);asm volatile("s_nop 15\n\ts_nop 7":"+v"(pA0),"+v"(pA1));BIAS(pA0,pA1,0);DMASK(pA0,pA1);CMASK(pA0,pA1,0);
  START(pA0,pA1);
  _Pragma("unroll") for(int r=0;r<16;++r)pA1[r]=__builtin_amdgcn_exp2f(pA1[r]);
  WAIT_BAR(0);
  DMA_K(3,0);DMA_V(1,SLOTB);
  MLOAD(1);
  ROT();
  kload8(kf,kp0+sl_cur);
  #define WB2() do{ if(DSA){WAIT_BAR(3);} else {WAIT_BAR(2);} }while(0)
  WB2();
  s16x4 vlo[8],vhi[8]; u32x4 pw0,pw1,pw2,pw3;
  #define PKW(P,B) cvtpk_s(P[B],P[B+1])
  #define PAF(k) __builtin_bit_cast(bf16x8,pw##k)
  #define VFR(i) (bf16x8){vlo[i][0],vlo[i][1],vlo[i][2],vlo[i][3],vhi[i][0],vhi[i][1],vhi[i][2],vhi[i][3]}
  #define PIN(x) asm volatile("":"+v"(x))
  #define MX3(a,b,c) __builtin_fmaxf(__builtin_fmaxf((a),(b)),(c))
  #define GAPA(MF,A0,A1,A2,A3,W0,W1,PW) do{ MF; sacc+=A0; sacc+=A1; sacc+=A2; sacc+=A3; PIN(sacc); W0; W1; PIN(PW); SBAR(); }while(0)
  #define EX(v) __builtin_amdgcn_exp2f(v)
  #define GAPB(MF,X,B) do{ MF; X[B]=EX(X[B]); X[B+1]=EX(X[B+1]); X[B+2]=EX(X[B+2]); X[B+3]=EX(X[B+3]); PIN(X); SBAR(); }while(0)
  #define VRD(i) do{ vlo[i]=vtr(vp_+(((i)>>2)*4096+((i)&3)*1024)); vhi[i]=vtr(vp_+(((i)>>2)*4096+((i)&3)*1024+512)); }while(0)
  #define KRD(G,j) do{ if(G){ kload2(kf,kp0+sl_next,j); SBAR(); } }while(0)
  #define STEP(C0,C1,P0,P1,t,GK,GV,GL) do{ SBAR(); \
    const lds_cptr vp_=vp0+sl_prev; \
    VRD(0); SBAR(); float sacc=(P0[0]+P0[1]); \
    GAPA(C0=__builtin_amdgcn_mfma_f32_32x32x16_bf16(kf[0],qr[0],negm,0,0,0), P0[2],P0[3],P0[4],P0[5],     pw0[0]=PKW(P0,0), pw0[1]=PKW(P0,2), pw0); \
    VRD(4); SBAR(); GAPA(C1=__builtin_amdgcn_mfma_f32_32x32x16_bf16(kf[1],qr[0],negm,0,0,0), P0[6],P0[7],P0[8],P0[9],     pw0[2]=PKW(P0,4), pw0[3]=PKW(P0,6), pw0); \
    VRD(1); SBAR(); GAPA(C0=__builtin_amdgcn_mfma_f32_32x32x16_bf16(kf[2],qr[1],C0,0,0,0),   P0[10],P0[11],P0[12],P0[13], pw1[0]=PKW(P0,8), pw1[1]=PKW(P0,10), pw1); \
    VRD(5); SBAR(); GAPA(C1=__builtin_amdgcn_mfma_f32_32x32x16_bf16(kf[3],qr[1],C1,0,0,0),   P0[14],P0[15],P1[0],P1[1],   pw1[2]=PKW(P0,12),pw1[3]=PKW(P0,14), pw1); \
    VRD(2); SBAR(); GAPA(C0=__builtin_amdgcn_mfma_f32_32x32x16_bf16(kf[4],qr[2],C0,0,0,0),   P1[2],P1[3],P1[4],P1[5],     pw2[0]=PKW(P1,0), pw2[1]=PKW(P1,2), pw2); \
    VRD(6); SBAR(); GAPA(C1=__builtin_amdgcn_mfma_f32_32x32x16_bf16(kf[5],qr[2],C1,0,0,0),   P1[6],P1[7],P1[8],P1[9],     pw2[2]=PKW(P1,4), pw2[3]=PKW(P1,6), pw2); \
    VRD(3); SBAR(); GAPA(C0=__builtin_amdgcn_mfma_f32_32x32x16_bf16(kf[6],qr[3],C0,0,0,0),   P1[10],P1[11],P1[12],P1[13], pw3[0]=PKW(P1,8), pw3[1]=PKW(P1,10), pw3); \
    VRD(7); SBAR(); GAPA(C1=__builtin_amdgcn_mfma_f32_32x32x16_bf16(kf[7],qr[3],C1,0,0,0),   P1[14],P1[15],0.f,0.f,       pw3[2]=PKW(P1,12),pw3[3]=PKW(P1,14), pw3); \
    l_reg+=sacc; \
    BIAS(C0,C1,t); DMASK(C0,C1); \
    if(GK){DMA_K((t)+3,sl_cur);} if(GV){DMA_V((t)+1,sl_next); MLOAD((t)+1);} \
    CMASK(C0,C1,t); \
    { float a=MX3(C0[0],C0[1],C1[0]),b=MX3(C0[2],C0[3],C1[1]); a=MX3(a,C1[2],C1[3]); \
      _Pragma("unroll") for(int r=4;r<16;r+=4){a=MX3(a,C0[r],C0[r+1]);b=MX3(b,C0[r+2],C0[r+3]);a=MX3(a,C1[r],C1[r+1]);b=MX3(b,C1[r+2],C1[r+3]);} \
      float rm=__builtin_fmaxf(a,b); { auto rr=__builtin_amdgcn_permlane32_swap(__float_as_uint(rm),__float_as_uint(rm),false,false); rm=__builtin_fmaxf(__uint_as_float(rr[0]),__uint_as_float(rr[1])); } \
      resc=false; \
      if(__builtin_expect(__any(rm>(float)THRL),0)){ const float dl=__builtin_fmaxf(rm,0.f); mhat+=dl; \
        _Pragma("unroll") for(int r=0;r<16;++r){C0[r]-=dl;C1[r]-=dl;} \
        _Pragma("unroll") for(int r=0;r<16;++r)negm[r]=-mhat; asm volatile("":"+v"(negm)); \
        const float f=__builtin_amdgcn_exp2f(-dl); l_reg*=f; if(hi==0)wsf[r32]=f; resc=true; } } \
    SBAR(); \
    GAPB(o[0]=__builtin_amdgcn_mfma_f32_32x32x16_bf16(PAF(0),VFR(0),o[0],0,0,0), C0,0); \
    GAPB(o[1]=__builtin_amdgcn_mfma_f32_32x32x16_bf16(PAF(0),VFR(4),o[1],0,0,0), C0,4); \
    KRD(GL,0); GAPB(o[0]=__builtin_amdgcn_mfma_f32_32x32x16_bf16(PAF(1),VFR(1),o[0],0,0,0), C0,8); \
    KRD(GL,1); GAPB(o[1]=__builtin_amdgcn_mfma_f32_32x32x16_bf16(PAF(1),VFR(5),o[1],0,0,0), C0,12); \
    KRD(GL,2); GAPB(o[0]=__builtin_amdgcn_mfma_f32_32x32x16_bf16(PAF(2),VFR(2),o[0],0,0,0), C1,0); \
    KRD(GL,3); GAPB(o[1]=__builtin_amdgcn_mfma_f32_32x32x16_bf16(PAF(2),VFR(6),o[1],0,0,0), C1,4); \
    GAPB(o[0]=__builtin_amdgcn_mfma_f32_32x32x16_bf16(PAF(3),VFR(3),o[0],0,0,0), C1,8); \
    GAPB(o[1]=__builtin_amdgcn_mfma_f32_32x32x16_bf16(PAF(3),VFR(7),o[1],0,0,0), C1,12); \
    }while(0)
  int t=1;
  #undef CMASK
  #define CMASK(P0,P1,t) do{}while(0)
  for(;t+5<NT;t+=2){
    STEP(pB0,pB1,pA0,pA1,t,true,true,true);     WB2(); RESC(); ROT();
    STEP(pA0,pA1,pB0,pB1,t+1,true,true,true);   WB2(); RESC(); ROT();
  }
  #undef CMASK
  #define CMASK(P0,P1,t) do{ if(!DSA){int jb_=(t)-(NT-4); if(jb_>=0)cmask(P0,P1,jb_,qrel,hi);} }while(0)
  #define ENDW(tt) do{ if((tt)+3<NT){WB2();} else if((tt)+2<NT){ if(DSA){WAIT_BAR(2);} else {WAIT_BAR(1);} } else { if(DSA){WAIT_BAR(1);} else {WAIT_BAR(0);} } }while(0)
  for(;t+1<NT;t+=2){
    STEP(pB0,pB1,pA0,pA1,t,(t+3<NT),(t+1<NT),(t+1<NT));       ENDW(t);   RESC(); ROT();
    STEP(pA0,pA1,pB0,pB1,t+1,(t+4<NT),(t+2<NT),(t+2<NT));     ENDW(t+1); RESC(); ROT();
  }
  STEP(pB0,pB1,pA0,pA1,NT-1,false,false,false); RESC();
  { float sacc=pB0[0]+pB0[1]; _Pragma("unroll") for(int r=2;r<16;++r)sacc+=pB0[r]; _Pragma("unroll") for(int r=0;r<16;++r)sacc+=pB1[r]; l_reg+=sacc;
    pw0=(u32x4){PKW(pB0,0),PKW(pB0,2),PKW(pB0,4),PKW(pB0,6)};pw1=(u32x4){PKW(pB0,8),PKW(pB0,10),PKW(pB0,12),PKW(pB0,14)};pw2=(u32x4){PKW(pB1,0),PKW(pB1,2),PKW(pB1,4),PKW(pB1,6)};pw3=(u32x4){PKW(pB1,8),PKW(pB1,10),PKW(pB1,12),PKW(pB1,14)};
    SBAR(); pv(o,vb0+sl_cur,PAF(0),PAF(1),PAF(2),PAF(3)); }
  #undef PKW
  #undef PAF
  #undef VFR
  #undef PIN
  #undef MX3
  #undef GAPA
  #undef GAPB
  #undef EX
  #undef VRD
  #undef KRD
  #undef STEP
  #undef ENDW
  #undef WB2
  {auto rr=__builtin_amdgcn_permlane32_swap(__float_as_uint(l_reg),__float_as_uint(l_reg),false,false);l_reg=__uint_as_float(rr[0])+__uint_as_float(rr[1]);}
  if(hi==0)wsf[32+r32]=l_reg;asm volatile("s_waitcnt lgkmcnt(0)":::"memory");
  float rli[16];
  #pragma unroll
  for(int r=0;r<16;++r)rli[r]=__builtin_amdgcn_rcpf(wsf[32+crow(r,hi)]);
  bf16*Ow=O+(rowbase+q0+wid*QBLK)*DM+h*D;
  { bf16*stg=(bf16*)(shm+LDS_OST)+wid*2048;
    #pragma unroll
    for(int r=0;r<16;++r){const int orow=crow(r,hi);
      #pragma unroll
      for(int d0=0;d0<2;++d0)stg[orow*64+d0*32+r32]=__float2bfloat16(o[d0][r]*rli[r]);}
    asm volatile("s_waitcnt lgkmcnt(0)":::"memory");
    #pragma unroll
    for(int i=0;i<4;++i){const int row=i*8+(lane>>3),ch=lane&7; const u32x4 v=*(const u32x4*)(stg+row*64+ch*8); ATTN_STORE16(Ow+(long)row*DM+ch*8,v);} }
  asm volatile("s_waitcnt lgkmcnt(0)\n\ts_barrier":::"memory");
  #undef DMA_K
  #undef DMA_V
  #undef CMASK
  #undef BIAS
  #undef MLOAD
  #undef DMASK
  #undef START
  #undef RESC
  #undef ROT
}
constexpr int ATTN_LDS_BYTES=LDS_BYTES;
struct AttnTensors { const bf16 *FQ,*FK,*FV,*DQ,*DK,*DV; bf16 *OA,*OB; const float* CUM; const unsigned* MASK;
  unsigned* qhead; const unsigned* kmax2; const float* qmax2; const unsigned* blk; };
template<bool DSA> __device__ __forceinline__ void fill_tab(int b,int h,const float*CUM,char*shm){
  __attribute__((address_space(3))) float* tab=(__attribute__((address_space(3))) float*)((lds_cptr)shm+LDS_TAB);
  const int tid=ltid(); const float L2E=1.4426950408889634f;
  if(DSA){ const float sl=__builtin_amdgcn_exp2f(-(float)(h+1))*L2E;
    #pragma unroll
    for(int j=0;j<8;++j){ const int s_=tid*8+j; tab[s_]=-sl*(float)s_; } }
  else { const f32x4_t* c=(const f32x4_t*)(CUM+((size_t)b*NHEAD+h)*SEQ)+tid*2; const f32x4_t a=c[0],d=c[1];
    *(__attribute__((address_space(3))) f32x4_t*)(tab+tid*8)=a*L2E; *(__attribute__((address_space(3))) f32x4_t*)(tab+tid*8+4)=d*L2E; }
  asm volatile("s_waitcnt vmcnt(0) lgkmcnt(0)\n\ts_barrier":::"memory");
}
template<int THRL=8,class MK> __device__ __forceinline__ void attn_phase(char*lds,unsigned char*ws_,const MK&mk,volatile __attribute__((address_space(3))) unsigned* slot){
  const float CUT=64.f;
  for(;;){
    unsigned char* wsl; { size_t z=0; asm volatile("":"+s"(z)); wsl=ws_+z; }
    const AttnTensors T=mk(wsl);
    if(ltid()==0) slot[0]=__hip_atomic_fetch_add(T.qhead,1u,__ATOMIC_RELAXED,__HIP_MEMORY_SCOPE_AGENT);
    asm volatile("s_waitcnt vmcnt(0) lgkmcnt(0)\n\ts_barrier":::"memory");
    const unsigned u=slot[0];
    if(u>=2u*BATCH*NHEAD*NQB) break;
    const int qb=NQB-1-(int)(u>>7), r=(int)(u&127u), mixer=r>>6, bh=r&63, b=bh>>3, h=bh&7, q0=qb*QB, NTfull=(q0+QB)/KVBLK;
    const float qk=__builtin_sqrtf(T.qmax2[(mixer*64+bh)*NQB+qb]*__uint_as_float(T.kmax2[mixer*64+bh]));
    const float bound=2.f*qk+1.f+CUT;
    const __attribute__((address_space(3))) float* tab=(const __attribute__((address_space(3))) float*)((lds_cptr)lds+LDS_TAB);
    int jstart=0;
    if(mixer==0){
      fill_tab<false>(b,h,T.CUM,lds);
      const int lane=ltid()&63; const int sk=64*lane+63;
      const bool skip=(lane<NTfull)&&(tab[q0]-tab[sk<SEQ?sk:SEQ-1]+bound<0.f)&&(bound==bound);
      const unsigned long long m=__ballot(skip);
      jstart=(~m==0ull)?64:__builtin_ctzll(~m);
    } else {
      fill_tab<true>(b,h,T.CUM,lds);
      const float sl=__builtin_amdgcn_exp2f(-(float)(h+1))*1.4426950408889634f;
      const int smin=SEQ-1-(int)T.blk[b*NQB+qb];
      const float f=((float)smin-bound/sl)*(1.f/64.f);
      jstart=(f>0.f&&bound==bound)?(int)f:0;
    }
    jstart=__builtin_amdgcn_readfirstlane(jstart)&~1; if(jstart>NTfull-4) jstart=NTfull-4; if(jstart<0) jstart=0;
    if(mixer==0) attn_unit<THRL,false>(b,h,qb,jstart,T.FQ,T.FK,T.FV,T.OA,T.MASK,lds);
    else         attn_unit<THRL,true >(b,h,qb,jstart,T.DQ,T.DK,T.DV,T.OB,T.MASK,lds);
  }
}
#undef SBAR
#undef WAIT_BAR
}

namespace idx_body {
using bf16x8=__attribute__((ext_vector_type(8)))short;
using f32x16=__attribute__((ext_vector_type(16)))float;
typedef float f32x4_t __attribute__((ext_vector_type(4)));
typedef unsigned u32x4_t __attribute__((ext_vector_type(4)));
typedef unsigned short u16x2_t __attribute__((ext_vector_type(2)));
#define ILAS __attribute__((address_space(3)))
constexpr int SEQ=4096, TOPK=256;
constexpr int LDS_SH=0, LDS_SL=65536, LDS_BYTES=131072;
__device__ __forceinline__ float relu_f(float x){ const int b=__builtin_bit_cast(int,x); return __builtin_bit_cast(float,b>0?b:0); }
__device__ __forceinline__ unsigned skey(float f){ const unsigned u=__float_as_uint(f+0.f); return (u&0x80000000u)?~u:(u|0x80000000u); }
__device__ __forceinline__ int wave_sum(int v){
  v+=__builtin_amdgcn_update_dpp(0,v,0xB1,0xF,0xF,true);
  v+=__builtin_amdgcn_update_dpp(0,v,0x4E,0xF,0xF,true);
  v+=__builtin_amdgcn_update_dpp(0,v,0x141,0xF,0xF,true);
  v+=__builtin_amdgcn_update_dpp(0,v,0x140,0xF,0xF,true);
  v+=__builtin_amdgcn_update_dpp(0,v,0x142,0xA,0xF,false);
  v+=__builtin_amdgcn_update_dpp(0,v,0x143,0xC,0xF,false);
  return __builtin_amdgcn_readlane(v,63);
}
__device__ __forceinline__ int wave_max(int v){
  v=max(v,__builtin_amdgcn_update_dpp(v,v,0xB1,0xF,0xF,false)); v=max(v,__builtin_amdgcn_update_dpp(v,v,0x4E,0xF,0xF,false));
  v=max(v,__builtin_amdgcn_update_dpp(v,v,0x141,0xF,0xF,false)); v=max(v,__builtin_amdgcn_update_dpp(v,v,0x140,0xF,0xF,false));
  v=max(v,__builtin_amdgcn_update_dpp(v,v,0x142,0xA,0xF,false)); v=max(v,__builtin_amdgcn_update_dpp(v,v,0x143,0xC,0xF,false));
  return __builtin_amdgcn_readlane(v,63);
}
__device__ __forceinline__ unsigned pk_count(unsigned acc,unsigned x,unsigned cm1r,unsigned one2){
  unsigned tmp;
  asm("v_pk_sub_u16 %1, %2, %3 clamp\n\tv_pk_min_u16 %1, %1, %4\n\tv_pk_add_u16 %0, %0, %1":"+v"(acc),"=&v"(tmp):"v"(x),"v"(cm1r),"v"(one2));
  return acc;
}
struct AW { bf16x8 a[2][4]; f32x4_t w[2][4]; };
__device__ __forceinline__ void load_a(AW&x,const unsigned short*__restrict__ IQ,size_t rowb,int kl,int hh){
  asm volatile("":"+v"(kl),"+v"(hh));
  const int g=kl>>3, hr=(kl>>2)&1, e=kl&3, aq=2*hr+(g>>1), ahead=4*(g&1)+e;
  #pragma unroll
  for(int at=0;at<2;++at){
    const unsigned short* ap=IQ+(rowb+4*at+aq)*512+ahead*64+8*hh;
    #pragma unroll
    for(int ks=0;ks<4;++ks) x.a[at][ks]=__builtin_bit_cast(bf16x8,*(const u32x4_t*)(ap+16*ks));
  }
}
__device__ __forceinline__ void load_w(AW&x,const float*__restrict__ IW,size_t rowb,int hh,float idx_scale){
  asm volatile("":"+v"(hh));
  #pragma unroll
  for(int at=0;at<2;++at){
    const f32x4_t* wp=(const f32x4_t*)(IW+(rowb+4*at+2*hh)*8);
    #pragma unroll
    for(int k=0;k<4;++k) x.w[at][k]=wp[k]*idx_scale;
  }
}
__device__ __forceinline__ void hu_coords(int v,int hu,int&b,int&tb){ b=v>>5; const int r=v&31, i=hu>>1, p=r+32*(i>>1), qi=(i&1)?255-p:p; tb=qi*16+8*(hu&1); }
__device__ __forceinline__ void idx_phase_fast(ILAS unsigned char*lds,const unsigned short*__restrict__ IQ,const unsigned short*__restrict__ IK,const float*__restrict__ IW,unsigned*__restrict__ MASK,unsigned*__restrict__ BLK,float idx_scale,int vcu,int ncu){
  const int tid=ltid(),lane=tid&63,kl=lane&31,hh=lane>>5; const int wave=__builtin_amdgcn_readfirstlane(tid>>6);
  for(int v=vcu;v<256;v+=ncu){
    int b,tb; hu_coords(v,0,b,tb);
    AW cur; load_a(cur,IQ,(size_t)b*SEQ+tb,kl,hh); load_w(cur,IW,(size_t)b*SEQ+tb,hh,idx_scale);
    bf16x8 b0[4],b1[4],b2[4];
    #define LDBX(dst,kt_,nkt_,bb_) do{ const int ktc_=(kt_)<(nkt_)?(kt_):(nkt_)-1; int kl_=kl,hh_=hh; asm volatile("":"+v"(kl_),"+v"(hh_)); const u32x4_t* kp_=(const u32x4_t*)(IK+((size_t)(bb_)*SEQ+kl_)*64+8*hh_+(size_t)ktc_*2048); \
      _Pragma("unroll") for(int ks=0;ks<4;++ks) dst[ks]=__builtin_bit_cast(bf16x8,kp_[2*ks]); }while(0)
    #pragma unroll 1
    for(int hu=0;hu<16;++hu){
      hu_coords(v,hu,b,tb);
      const size_t rowb=(size_t)b*SEQ+tb;
      const int nkt=(tb+8+31)>>5;
      const int tqb=tb+2*hh;
      #define LDB(dst,kt_) LDBX(dst,kt_,nkt,b)
      #define SCORE(bb,kt_) do{ const int s=32*(kt_)+kl; const int sidx=((s>>7)<<6)+(s&63), sh=(s>>6)&1; \
        _Pragma("unroll") for(int at=0;at<2;++at){ \
          f32x16 c=f32x16{}; \
          _Pragma("unroll") for(int ks=0;ks<4;++ks) c=__builtin_amdgcn_mfma_f32_32x32x16_bf16(cur.a[at][ks],bb[ks],c,0,0,0); \
          float s0=0.f,s1=0.f; \
          _Pragma("unroll") for(int q=0;q<4;++q){ s0=__builtin_fmaf(cur.w[at][0][q],relu_f(c[q]),s0); s0=__builtin_fmaf(cur.w[at][1][q],relu_f(c[4+q]),s0); \
                                s1=__builtin_fmaf(cur.w[at][2][q],relu_f(c[8+q]),s1); s1=__builtin_fmaf(cur.w[at][3][q],relu_f(c[12+q]),s1); } \
          const int tq=tqb+4*at; \
          const unsigned k0=(s<=tq)?skey(s0):0u, k1=(s<=tq+1)?skey(s1):0u; \
          ILAS unsigned short* ph=(ILAS unsigned short*)(lds+LDS_SH)+((4*at+2*hh)*2048+sidx)*2+sh; \
          ILAS unsigned short* pl=(ILAS unsigned short*)(lds+LDS_SL)+((4*at+2*hh)*2048+sidx)*2+sh; \
          ph[0]=(unsigned short)(k0>>16); pl[0]=(unsigned short)k0; ph[4096]=(unsigned short)(k1>>16); pl[4096]=(unsigned short)k1; } }while(0)
      {
        LDB(b0,wave); LDB(b1,wave+8);
        int kt=wave;
        #pragma unroll 1
        for(;kt<nkt;kt+=24){
          LDB(b2,kt+16); SCORE(b0,kt); __builtin_amdgcn_sched_barrier(0);
          if(kt+8<nkt){ LDB(b0,kt+24); SCORE(b1,kt+8); } __builtin_amdgcn_sched_barrier(0);
          if(kt+16<nkt){ LDB(b1,kt+32); SCORE(b2,kt+16); } __builtin_amdgcn_sched_barrier(0);
        }
      }
      #undef LDB
      #undef SCORE
      int nb=b,ntb=tb; if(hu+1<16){ hu_coords(v,hu+1,nb,ntb); load_a(cur,IQ,(size_t)nb*SEQ+ntb,kl,hh); }
      asm volatile("s_waitcnt lgkmcnt(0)\n\ts_barrier":::"memory");
#ifndef IDX_REP_B
#define IDX_REP_B 1
#endif
      _Pragma("unroll 1") for(int repB=0;repB<IDX_REP_B;++repB)
      {
        const int t=tb+wave; const int ngrp=(t>>10)+1;
        const ILAS unsigned* SHq=(const ILAS unsigned*)(lds+LDS_SH)+wave*2048+lane; const ILAS unsigned* SLq=(const ILAS unsigned*)(lds+LDS_SL)+wave*2048+lane;
        unsigned kh[32],kw[32];
        #pragma unroll
        for(int gI=0;gI<4;++gI){
          if(gI<ngrp){
            #pragma unroll
            for(int i=8*gI;i<8*gI+8;++i){ kh[i]=SHq[64*i]; kw[i]=SLq[64*i]; }
          } else {
            #pragma unroll
            for(int i=8*gI;i<8*gI+8;++i){ kh[i]=0u; kw[i]=0u; }
          }
        }
        #pragma unroll
        for(int gI=0;gI<4;++gI){ if(gI==ngrp-1){
          #pragma unroll
          for(int i=8*gI;i<8*gI+8;++i){ const unsigned m=((128*i+lane<=t)?0xffffu:0u)|((128*i+64+lane<=t)?0xffff0000u:0u); kh[i]&=m; kw[i]&=m; } } }
        unsigned T=1u; int X=0;
        unsigned one2=0x00010001u; asm volatile("":"+v"(one2));
        if(t>=TOPK){
          unsigned Thi=0u; int cntHi=0, G1=0; bool done=false;
          for(int bb=14;bb>=0;bb-=2){
            const unsigned c1=Thi|(1u<<bb), c2=Thi|(2u<<bb), c3=Thi|(3u<<bb);
            const unsigned m1=(c1-1u)*0x10001u, m2=(c2-1u)*0x10001u, m3=(c3-1u)*0x10001u;
            unsigned a1[2]={0u,0u},a2[2]={0u,0u},a3[2]={0u,0u};
            #pragma unroll
            for(int gI=0;gI<4;++gI){ if(gI<ngrp){
              #pragma unroll
              for(int i=8*gI;i<8*gI+8;++i){ a1[i&1]=pk_count(a1[i&1],kh[i],m1,one2); a2[i&1]=pk_count(a2[i&1],kh[i],m2,one2); a3[i&1]=pk_count(a3[i&1],kh[i],m3,one2); } } }
            const unsigned s1=a1[0]+a1[1], s2=a2[0]+a2[1], s3=a3[0]+a3[1];
            const int n12=wave_sum((int)(((s1&0xffffu)+(s1>>16))|(((s2&0xffffu)+(s2>>16))<<16)));
            const int n3=wave_sum((int)((s3&0xffffu)+(s3>>16)));
            const int n1=n12&0xffff, n2=(int)((unsigned)n12>>16);
            int nj;
            if(n3>=TOPK){ Thi=c3; nj=n3; } else if(n2>=TOPK){ Thi=c2; nj=n2; G1=n3; } else if(n1>=TOPK){ Thi=c1; nj=n1; G1=n2; } else { nj=0; G1=n1; }
            if(nj>0){ cntHi=nj; if(nj==TOPK){ done=true; break; } }
          }
          T=Thi<<16; X=0;
          if(!done){
            { const unsigned thr=Thi*0x10001u; const u16x2_t one={1,1}, ffff={0xffff,0xffff};
              #pragma unroll
              for(int gI=0;gI<4;++gI){ if(gI<ngrp){
                #pragma unroll
                for(int i=8*gI;i<8*gI+8;++i){ u16x2_t x=__builtin_bit_cast(u16x2_t,kh[i]^thr); x=__builtin_elementwise_min(x,one); x=(one-x)*ffff; kw[i]&=__builtin_bit_cast(unsigned,x); } } } }
            unsigned Tlo=0u; int cntT=cntHi;
            for(int bit=15;bit>=0;--bit){
              const unsigned cand=Tlo|(1u<<bit), cm1r=(cand-1u)*0x10001u; unsigned ac[4]={0u,0u,0u,0u};
              #pragma unroll
              for(int gI=0;gI<4;++gI){ if(gI<ngrp){
                #pragma unroll
                for(int i=8*gI;i<8*gI+8;++i) ac[i&3]=pk_count(ac[i&3],kw[i],cm1r,one2); } }
              const unsigned acc=(ac[0]+ac[1])+(ac[2]+ac[3]);
              const int cnt=G1+wave_sum((int)((acc&0xffffu)+(acc>>16)));
              if(cnt>=TOPK){ Tlo=cand; cntT=cnt; if(cnt==TOPK) break; }
            }
            T=(Thi<<16)|Tlo; X=cntT-TOPK;
          }
        }
        unsigned long long mine=0ull;
        #pragma unroll
        for(int gI=3;gI>=0;--gI){ if(gI<ngrp){
          #pragma unroll
          for(int i=8*gI+7;i>=8*gI;--i){
            const unsigned keyA=(kh[i]<<16)|(kw[i]&0xffffu), keyB=(kh[i]&0xffff0000u)|(kw[i]>>16);
            unsigned long long balB=__ballot(keyB>=T), balA=__ballot(keyA>=T);
            if(X>0){ unsigned long long eq=__ballot(keyB==T);
              while(X>0&&eq!=0ull){ const int hb=63-__builtin_clzll(eq); balB&=~(1ull<<hb); eq&=~(1ull<<hb); --X; }
              eq=__ballot(keyA==T);
              while(X>0&&eq!=0ull){ const int hb=63-__builtin_clzll(eq); balA&=~(1ull<<hb); eq&=~(1ull<<hb); --X; } }
            if(lane==2*i) mine=balA;
            if(lane==2*i+1) mine=balB;
          } } }
        { int ln_=lane; asm volatile("":"+v"(ln_)); const unsigned off_=(unsigned)((((b*128+(t>>5))*64+ln_)*32+(t&31))*8); *(unsigned long long*)((char*)MASK+off_)=mine; }
        if(hu+1<16) load_w(cur,IW,(size_t)nb*SEQ+ntb,hh,idx_scale);
        { const int smax=wave_max(mine!=0ull?64*lane+63-__builtin_clzll(mine):-1);
          if(lane==0) __hip_atomic_fetch_max(BLK+b*16+(t>>8),(unsigned)(SEQ-1-smax),__ATOMIC_RELAXED,__HIP_MEMORY_SCOPE_AGENT); }
      }
      asm volatile("s_waitcnt lgkmcnt(0)\n\ts_barrier":::"memory");
    }
  }
}
#undef ILAS
}

struct MapIdent { __device__ __forceinline__ int operator()(int j) const { return j; } };
struct MapWin {
    __device__ __forceinline__ int operator()(int j) const {
        if (j < 1536) return j;
        if (j < 3072) return 1544 + (j - 1536);
        if (j < 3584) return 3080 + (j - 3072);
        if (j < 3648) return 3592 + (j - 3584);
        if (j < 3656) return 1536 + (j - 3648);
        if (j < 3664) return 3656 + (j - 3656);
        if (j < 3840) return -1;
        return 3664 + (j - 3840);
    }
};
struct MapF1 { __device__ __forceinline__ int operator()(int j) const { const int pn = j >> 8, i = j & 255; return i < 128 ? 128 * pn + i : DFF + 128 * pn + (i - 128); } };
template <class Map, bool F8 = false>
__device__ __forceinline__ void wt_item(const float* W, int K, int ldw, bf16_t* WT, int nblk, int item, LAS float* scr, int lane, const Map& map) {
    const int kb = item / nblk, nb = item % nblk, k0 = 64 * kb, n0 = 32 * nb;
    const int src = map(n0 + (lane & 31));
#pragma unroll 8
    for (int i = 0; i < 32; ++i) { const int kk = 2 * i + (lane >> 5); scr[kk * 33 + (lane & 31)] = src >= 0 ? W[(size_t)(k0 + kk) * ldw + src] : 0.f; }
    asm volatile("s_waitcnt lgkmcnt(0)" ::: "memory");
    const int c = lane & 7;
#pragma unroll
    for (int j = 0; j < 4; ++j) { const int n = (lane >> 3) + 8 * j; const LAS float* sp = scr + (8 * c) * 33 + n;
        if constexpr (F8) { u32x2 o; o.x = pk4_fp8(sp[0 * 33] * F8_WSCALE, sp[1 * 33] * F8_WSCALE, sp[2 * 33] * F8_WSCALE, sp[3 * 33] * F8_WSCALE); o.y = pk4_fp8(sp[4 * 33] * F8_WSCALE, sp[5 * 33] * F8_WSCALE, sp[6 * 33] * F8_WSCALE, sp[7 * 33] * F8_WSCALE);
            *(u32x2*)((unsigned char*)WT + (size_t)(n0 + n) * K + k0 + 8 * c) = o; }
        else { u32x4 o; o.x = f2bf(sp[0 * 33]) | (f2bf(sp[1 * 33]) << 16); o.y = f2bf(sp[2 * 33]) | (f2bf(sp[3 * 33]) << 16); o.z = f2bf(sp[4 * 33]) | (f2bf(sp[5 * 33]) << 16); o.w = f2bf(sp[6 * 33]) | (f2bf(sp[7 * 33]) << 16);
        *(u32x4*)(WT + (size_t)(n0 + n) * K + k0 + 8 * c) = o; } }
    asm volatile("s_waitcnt lgkmcnt(0)" ::: "memory");
}
__device__ __forceinline__ void wcvt_phase(const P& p, LAS unsigned char* lds, int wg, int nwg) {
    const int tid = ltid(), lane = tid & 63, wave = tid >> 6;
    LAS float* scr = (LAS float*)(lds + wave * 16384);
    constexpr int I_IN = 16 * 184, I_A = 8 * 32, I_OUT = 16 * 32, I_F1 = 16 * 176, I_F2 = 44 * 32, I_LAYER = I_IN + 2 * I_A + I_OUT + I_F1 + I_F2;
    for (int it = wg * 8 + wave; it < DEPTH * I_LAYER; it += nwg * 8) {
        const int l = it / I_LAYER; int r = it % I_LAYER;
        unsigned char* wt = p.ws + WS_WT + (size_t)l * WT_LAYER;
        if (r < I_IN) { wt_item(p.w_in + (size_t)l * D * NIN, D, NIN, (bf16_t*)(wt + WT_IN), 184, r, scr, lane, MapWin()); continue; } r -= I_IN;
        if (r < I_A) { wt_item(p.w_a + (size_t)l * 512 * D, 512, D, (bf16_t*)(wt + WT_A), 32, r, scr, lane, MapIdent()); continue; } r -= I_A;
        if (r < I_A) { wt_item(p.w_b + (size_t)l * 512 * D, 512, D, (bf16_t*)(wt + WT_B), 32, r, scr, lane, MapIdent()); continue; } r -= I_A;
        if (r < I_OUT) { wt_item(p.w_out + (size_t)l * D * D, D, D, (bf16_t*)(wt + WT_OUT), 32, r, scr, lane, MapIdent()); continue; } r -= I_OUT;
        if (r < I_F1) { wt_item<MapF1, true>(p.w_ffn_in + (size_t)l * D * 2 * DFF, D, 2 * DFF, (bf16_t*)(wt + WT_F1), 176, r, scr, lane, MapF1()); continue; } r -= I_F1;
        wt_item<MapIdent, true>(p.w_ffn_out + (size_t)l * DFF * D, DFF, D, (bf16_t*)(wt + WT_F2), 32, r, scr, lane, MapIdent());
    }
}

enum { PH_CVT = 0, PH_PROJ, PH_CUM, PH_IDX, PH_ATTN, PH_GATES, PH_BRA, PH_BRB, PH_OUT, PH_LN1, PH_FFN1, PH_FFN2, PH_LN2, PH_WCVT };

template <class Epi>
__device__ __forceinline__ void fast_gemm(LAS unsigned char* lds, const bf16_t* A, const bf16_t* Bt, int N, int K, const Epi& E) {
    pg8::Gemm g{A, Bt, M, N, K}; pg8::StaticOrder S; S.init(M, N, (int)gridDim.x, (int)blockIdx.x);
    pg8::gemm_phase<Epi, pg8::StaticOrder, true, true>(lds, g, S, E);
}
template <class Epi>
__device__ __forceinline__ void fast_gemm8(LAS unsigned char* lds, const unsigned char* A, const unsigned char* Bt, int N, int K, const Epi& E) {
    asm volatile("" : "+s"(K));
    pg8::Gemm g{(const bf16_t*)A, (const bf16_t*)Bt, M, N, K}; pg8::StaticOrder S; S.init(M, N, (int)gridDim.x, (int)blockIdx.x);
    pg8::gemm_phase<Epi, pg8::StaticOrder, true, true, true>(lds, g, S, E);
}

#ifndef NAIVE_MASK
#define NAIVE_MASK 0
#endif
template <int PH>
__device__ __forceinline__ void run_phase(const P& p_in, int l, LAS unsigned char* lds, int wg, int nwg) {
    P p = p_in; { size_t z = 0; asm volatile("" : "+s"(z)); p.ws = p_in.ws + z; }
    bf16_t* XB = WSP(bf16_t, WS_XB);
    const unsigned char* wt = p.ws + WS_WT + (size_t)l * WT_LAYER;
    if constexpr (PH == PH_CVT) cvt_phase(p, wg, nwg);
    if constexpr (PH == PH_WCVT) wcvt_phase(p, lds, wg, nwg);
    if constexpr (PH == PH_PROJ && (NAIVE_MASK & 1)) {
        GemmArgs g{XB, D, p.w_in + (size_t)l * D * NIN, NIN, C_GA, D, 0};
        EpiProj E{WSP(bf16_t, WS_FQ), WSP(bf16_t, WS_FK), WSP(bf16_t, WS_FV), WSP(bf16_t, WS_DQ), WSP(bf16_t, WS_DK), WSP(bf16_t, WS_DV), WSP(bf16_t, WS_IQ), WSP(bf16_t, WS_IK),
                  WSP(float, WS_FL), WSP(float, WS_IW), p.b_forget + l * NH};
        naive_gemm_phase<EpiProj, false>(lds, g, E, wg, nwg);
    } else
    if constexpr (PH == PH_PROJ) {
        pg8::EpiProjF E{WSP(bf16_t, WS_FQ), (size_t)M * 512, WSP(bf16_t, WS_IK), WSP(float, WS_FL), WSP(float, WS_IW), p.b_forget + l * NH, QSCALE};
        fast_gemm(lds, XB, (const bf16_t*)(wt + WT_IN), NPROJ, D, E);
    }
    if constexpr (PH == PH_CUM) { cum_phase(p, lds, wg, nwg); norm_phase(p, WSP(unsigned, WS_CTL) + CW_KMAX + 128 * l, (float*)(WSP(unsigned, WS_CTL) + CW_QMAX + 2048 * l), wg, nwg); }
    if constexpr (PH == PH_IDX && (NAIVE_MASK & 128)) idx_phase(p, lds, wg, nwg); else
    if constexpr (PH == PH_IDX) {
        const int G = (int)gridDim.x, bx = (int)blockIdx.x, vcu = (G % 8 == 0) ? (bx % 8) * (G / 8) + bx / 8 : bx;
        idx_body::idx_phase_fast(lds, WSP(const bf16_t, WS_IQ), WSP(const bf16_t, WS_IK), WSP(const float, WS_IW), WSP(unsigned, WS_MASK), WSP(unsigned, WS_CTL) + CW_BLK + 128 * l, IDX_SCALE, vcu, G);
    }
    if constexpr (PH == PH_ATTN && (NAIVE_MASK & 64)) attn_phase_naive(p, wg, nwg); else
    if constexpr (PH == PH_ATTN) {
        typedef attn_body::bf16 abf;
        auto mk = [l](unsigned char* ws) { unsigned* ctl = (unsigned*)(ws + WS_CTL);
            return attn_body::AttnTensors{(const abf*)(ws + WS_FQ), (const abf*)(ws + WS_FK), (const abf*)(ws + WS_FV), (const abf*)(ws + WS_DQ), (const abf*)(ws + WS_DK), (const abf*)(ws + WS_DV),
                                          (abf*)(ws + WS_OA), (abf*)(ws + WS_OB), (const float*)(ws + WS_CUM), (const unsigned*)(ws + WS_MASK),
                                          ctl + CW_QHEAD + 64 * l, ctl + CW_KMAX + 128 * l, (const float*)(ctl + CW_QMAX + 2048 * l), ctl + CW_BLK + 128 * l}; };
        attn_body::attn_phase<8>((char*)lds, p.ws, mk, (volatile LAS unsigned*)(lds + LDS_MISC_OFF + 16));
    }
    if constexpr (PH == PH_GATES && (NAIVE_MASK & 2)) {
        GemmArgs g{XB, D, p.w_in + (size_t)l * D * NIN + C_GA, NIN, 2048, D, 0};
        EpiGates E{WSP(bf16_t, WS_SGA), WSP(bf16_t, WS_SGB)};
        naive_gemm_phase<EpiGates, false>(lds, g, E, wg, nwg);
    } else
    if constexpr (PH == PH_GATES) {
        pg8::EpiGatesF E{WSP(bf16_t, WS_SGA), (size_t)M * 1024};
        fast_gemm(lds, XB, (const bf16_t*)(wt + WT_IN) + (size_t)NPROJ * D, NGATE, D, E);
    }
    if constexpr (PH == PH_BRA && (NAIVE_MASK & 4)) {
        GemmArgs g{WSP(bf16_t, WS_OA), 512, p.w_a + (size_t)l * 512 * D, D, D, 512, 0};
        EpiBranchA E{WSP(bf16_t, WS_SGA)};
        naive_gemm_phase<EpiBranchA, false>(lds, g, E, wg, nwg);
    } else
    if constexpr (PH == PH_BRA) {
        pg8::EpiBranchF<0> E{WSP(bf16_t, WS_SGA), nullptr};
        fast_gemm(lds, WSP(bf16_t, WS_OA), (const bf16_t*)(wt + WT_A), D, 512, E);
    }
    if constexpr (PH == PH_BRB && (NAIVE_MASK & 4)) {
        GemmArgs g{WSP(bf16_t, WS_OB), 512, p.w_b + (size_t)l * 512 * D, D, D, 512, 0};
        EpiBranchB E{WSP(bf16_t, WS_SGA), WSP(bf16_t, WS_SGB)};
        naive_gemm_phase<EpiBranchB, false>(lds, g, E, wg, nwg);
    } else
    if constexpr (PH == PH_BRB) {
        pg8::EpiBranchF<1> E{WSP(bf16_t, WS_SGB), WSP(bf16_t, WS_SGA)};
        fast_gemm(lds, WSP(bf16_t, WS_OB), (const bf16_t*)(wt + WT_B), D, 512, E);
    }
    if constexpr (PH == PH_OUT && (NAIVE_MASK & 8)) {
        GemmArgs g{WSP(bf16_t, WS_SGB), D, p.w_out + (size_t)l * D * D, D, D, D, 0};
        EpiResF32 E{l == 0 ? p.x : nullptr, XB, p.out};
        naive_gemm_phase<EpiResF32, false>(lds, g, E, wg, nwg);
    } else
    if constexpr (PH == PH_OUT) {
        pg8::EpiResF E{l == 0 ? p.x : nullptr, XB, WSP(bf16_t, WS_Y1), ALPHA, 1.f};
        fast_gemm(lds, WSP(bf16_t, WS_SGB), (const bf16_t*)(wt + WT_OUT), D, D, E);
    }
    if constexpr (PH == PH_LN1) ln_phase(WSP(const bf16_t, WS_Y1), p.ln1_g + l * D, p.ln1_b + l * D, WSP(bf16_t, WS_X1B), nullptr, wg, nwg, WSP(unsigned char, WS_X1F8));
    if constexpr (PH == PH_FFN1 && (NAIVE_MASK & 16)) {
        GemmArgs g{WSP(bf16_t, WS_X1B), D, p.w_ffn_in + (size_t)l * D * 2 * DFF, 2 * DFF, DFF, D, DFF};
        EpiSwiglu E{WSP(bf16_t, WS_H)};
        naive_gemm_phase<EpiSwiglu, true>(lds, g, E, wg, nwg);
    } else
    if constexpr (PH == PH_FFN1) {
        pg8::EpiSwigluF8 E{WSP(unsigned char, WS_H8), DFF, 1.f / F8_WSCALE, F8_HSCALE};
        fast_gemm8(lds, WSP(const unsigned char, WS_X1F8), wt + WT_F1, 2 * DFF, D, E);
    }
    if constexpr (PH == PH_FFN2 && (NAIVE_MASK & 32)) {
        GemmArgs g{WSP(bf16_t, WS_H), DFF, p.w_ffn_out + (size_t)l * DFF * D, D, D, DFF, 0};
        EpiResF32 E{nullptr, WSP(bf16_t, WS_X1B), p.out};
        naive_gemm_phase<EpiResF32, false>(lds, g, E, wg, nwg);
    } else
    if constexpr (PH == PH_FFN2) {
        pg8::EpiResF E{nullptr, WSP(bf16_t, WS_X1B), XB, ALPHA, 1.f / (F8_WSCALE * F8_HSCALE)};
        fast_gemm8(lds, WSP(const unsigned char, WS_H8), wt + WT_F2, D, DFF, E);
    }
    if constexpr (PH == PH_LN2) {
        if (l + 1 < DEPTH) ln_phase(XB, p.ln2_g + l * D, p.ln2_b + l * D, XB, nullptr, wg, nwg);
        else ln_phase(XB, p.ln2_g + l * D, p.ln2_b + l * D, nullptr, p.out, wg, nwg);
    }
}

#define XB_TMO      128
#define XB_XCNT(j)  (256  + 64 * (j))
#define XB_XSUB(j)  (1280 + 64 * (j))
#define XB_XGEN(j)  (2304 + 64 * (j))
#define XB_TOP      3328
#define XB_TOPGEN   3392
#define XCD_BAR_WORDS 3456
#define XB_SPIN_CAP (1u << 18)

__device__ __forceinline__ unsigned xb_ld(unsigned* p)              { return __hip_atomic_load(p, __ATOMIC_RELAXED, __HIP_MEMORY_SCOPE_AGENT); }
__device__ __forceinline__ unsigned xb_add(unsigned* p, unsigned v) { return __hip_atomic_fetch_add(p, v, __ATOMIC_RELAXED, __HIP_MEMORY_SCOPE_AGENT); }
__device__ __forceinline__ unsigned xb_xcc_id() { return (unsigned)__builtin_amdgcn_s_getreg((3 << 11) | 20) & 0xFu; }
#define XB_SPIN(cond, bar) do { unsigned _sp = 0; while (cond) { __builtin_amdgcn_s_sleep(1); \
    if ((++_sp & 255u) == 0u) { if (xb_ld(&(bar)[XB_TMO])) break; if (_sp > XB_SPIN_CAP) { atomicAdd(&(bar)[XB_TMO], 1u); break; } } } } while (0)

struct XcdBarrier {
    unsigned* bar; unsigned x;
    volatile LAS unsigned* st;
};

__device__ __forceinline__ XcdBarrier xcd_barrier_post(unsigned* bar, volatile LAS unsigned* st) {
    XcdBarrier b; b.bar = bar; b.x = xb_xcc_id(); b.st = st;
    if (ltid() == 0) (void)xb_add(&bar[XB_XCNT(b.x)], 1u);
    return b;
}
__device__ __forceinline__ void xcd_barrier_complete(unsigned* bar, unsigned x, unsigned& nloc, unsigned& nx) {
    const unsigned G = gridDim.x * gridDim.y * gridDim.z;
    unsigned sum, cnt, mine, sp = 0u;
    for (;;) {
        sum = 0u; cnt = 0u; mine = 0u;
#pragma unroll
        for (unsigned j = 0; j < 16; ++j) { const unsigned c = xb_ld(&bar[XB_XCNT(j)]); sum += c; cnt += (c > 0u) ? 1u : 0u; mine = (j == x) ? c : mine; }
        if (sum == G) break;
        __builtin_amdgcn_s_sleep(1);
        if ((++sp & 255u) == 0u) { if (xb_ld(&bar[XB_TMO])) break; if (sp > XB_SPIN_CAP) { atomicAdd(&bar[XB_TMO], 1u); break; } }
    }
    nloc = mine > 0u ? mine : 1u; nx = cnt > 0u ? cnt : 1u;
}

__device__ __forceinline__ void xcd_barrier(const XcdBarrier& b) {
    asm volatile("s_waitcnt vmcnt(0)" ::: "memory");
    __syncthreads();
    if (ltid() == 0) {
        unsigned* bar = b.bar;
        __builtin_amdgcn_s_waitcnt(0);
        unsigned nloc = b.st[0], nx = b.st[1];
        if (nloc == 0u) { xcd_barrier_complete(bar, b.x, nloc, nx); b.st[0] = nloc; b.st[1] = nx; }
        const unsigned old = xb_add(&bar[XB_XSUB(b.x)], 1u);
        const unsigned gen = old / nloc;
        if (old + 1u == (gen + 1u) * nloc) {
            __builtin_amdgcn_fence(__ATOMIC_RELEASE, "agent");
            asm volatile("s_waitcnt vmcnt(0)" ::: "memory");
            const unsigned og = xb_add(&bar[XB_TOP], 1u);
            const unsigned tg = og / nx;
            if (og + 1u == (tg + 1u) * nx) xb_add(&bar[XB_TOPGEN], 1u);
            else XB_SPIN(xb_ld(&bar[XB_TOPGEN]) == tg, bar);
            __builtin_amdgcn_fence(__ATOMIC_ACQUIRE, "agent");
            xb_add(&bar[XB_XGEN(b.x)], 1u);
            asm volatile("s_waitcnt vmcnt(0)" ::: "memory");
        } else {
            XB_SPIN(xb_ld(&bar[XB_XGEN(b.x)]) == gen, bar);
            __builtin_amdgcn_fence(__ATOMIC_ACQUIRE, "agent");
            asm volatile("s_waitcnt vmcnt(0)" ::: "memory");
        }
    }
    __syncthreads();
}

constexpr int LDS_BYTES = 147456;
constexpr int LDS_MISC = LDS_MISC_OFF;
constexpr int CW_BAR = 4096;
constexpr size_t CTL_ZERO_BYTES = 1u << 20;

#ifndef DUP_MASK
#define DUP_MASK 0
#endif
#define RUNPH(PH, bit) do { run_phase<PH>(p, l, lds, wg, nwg); if (DUP_MASK & (bit)) { xcd_barrier(bar); run_phase<PH>(p, l, lds, wg, nwg); } } while (0)
template <int LYR>
__device__ __forceinline__ void layer_body(const P& p, LAS unsigned char* lds, int wg, int nwg, const XcdBarrier& bar) {
    constexpr int l = LYR;
    RUNPH(PH_PROJ, 1); xcd_barrier(bar);
    run_phase<PH_CUM>(p, l, lds, wg, nwg); __syncthreads();
    RUNPH(PH_IDX, 2); xcd_barrier(bar);
    RUNPH(PH_ATTN, 4); xcd_barrier(bar);
    RUNPH(PH_GATES, 8); xcd_barrier(bar);
    run_phase<PH_BRA>(p, l, lds, wg, nwg); xcd_barrier(bar);
    run_phase<PH_BRB>(p, l, lds, wg, nwg); xcd_barrier(bar);
    RUNPH(PH_OUT, 16); xcd_barrier(bar);
    RUNPH(PH_LN1, 32); xcd_barrier(bar);
    RUNPH(PH_FFN1, 64); xcd_barrier(bar);
    RUNPH(PH_FFN2, 128); xcd_barrier(bar);
    run_phase<PH_LN2>(p, l, lds, wg, nwg);
}

__global__ void __launch_bounds__(NT, 2) mega_fwd(P p) {
    extern __shared__ __attribute__((aligned(16))) unsigned char lds_raw[];
    LAS unsigned char* lds = (LAS unsigned char*)lds_raw;
    volatile LAS unsigned* MISC = (volatile LAS unsigned*)(lds + LDS_MISC);
    if (threadIdx.x < 8) MISC[threadIdx.x] = 0u;
    ((volatile LAS int*)(uintptr_t)LDS_WTAB_OFF)[hw_wave_slot()] = (int)(threadIdx.x >> 6);
    __syncthreads();
    XcdBarrier bar = xcd_barrier_post((unsigned*)(p.ws + WS_CTL) + CW_BAR, MISC);
    const int wg = (int)blockIdx.x, nwg = (int)gridDim.x;
    run_phase<PH_CVT>(p, 0, lds, wg, nwg);
    run_phase<PH_WCVT>(p, 0, lds, wg, nwg); xcd_barrier(bar);
    layer_body<0>(p, lds, wg, nwg, bar); xcd_barrier(bar);
    layer_body<1>(p, lds, wg, nwg, bar);
}

extern "C" void kernel_launch(void* const* d_in, const int* in_sizes, int n_in, void* d_out, int out_size, void* d_ws, size_t ws_size, hipStream_t stream) {
    static int grid = 0;
    if (grid == 0) {
        if (n_in != 12 || ws_size < WS_END) { fprintf(stderr, "kernel_launch: unexpected inputs (n_in %d, ws %zu)\n", n_in, ws_size); grid = -1; return; }
        int dev = 0, cus = 0, per_cu = 0;
        if (hipGetDevice(&dev) != hipSuccess || hipDeviceGetAttribute(&cus, hipDeviceAttributeMultiprocessorCount, dev) != hipSuccess) { grid = -1; return; }
        if (hipFuncSetAttribute((const void*)mega_fwd, hipFuncAttributeMaxDynamicSharedMemorySize, LDS_BYTES) != hipSuccess) { fprintf(stderr, "kernel_launch: hipFuncSetAttribute failed\n"); grid = -1; return; }
        if (hipOccupancyMaxActiveBlocksPerMultiprocessor(&per_cu, (const void*)mega_fwd, NT, LDS_BYTES) != hipSuccess || per_cu < 1) { fprintf(stderr, "kernel_launch: occupancy query says %d\n", per_cu); }
        (void)hipGetLastError();
        grid = cus;
    }
    if (grid < 0) return;
    P p{};
    p.x = (const float*)d_in[0]; p.w_in = (const float*)d_in[1]; p.b_forget = (const float*)d_in[2]; p.w_a = (const float*)d_in[3]; p.w_b = (const float*)d_in[4];
    p.w_out = (const float*)d_in[5]; p.ln1_g = (const float*)d_in[6]; p.ln1_b = (const float*)d_in[7]; p.w_ffn_in = (const float*)d_in[8]; p.w_ffn_out = (const float*)d_in[9];
    p.ln2_g = (const float*)d_in[10]; p.ln2_b = (const float*)d_in[11]; p.out = (float*)d_out; p.ws = (unsigned char*)d_ws;
    if (hipMemsetAsync((char*)d_ws + WS_CTL, 0, CTL_ZERO_BYTES, stream) != hipSuccess) { fprintf(stderr, "kernel_launch: memset failed\n"); return; }
    hipLaunchKernelGGL(mega_fwd, dim3(grid), dim3(NT), LDS_BYTES, stream, p);
}
```

```cpp
#include <hip/hip_runtime.h>
#include <stdint.h>
#include <stdio.h>

#define LAS __attribute__((address_space(3)))
typedef unsigned short bf16_t;
typedef float f32x4 __attribute__((ext_vector_type(4)));
typedef unsigned u32x4 __attribute__((ext_vector_type(4)));
typedef unsigned u32x2 __attribute__((ext_vector_type(2)));

namespace cfg {
constexpr int NB = 8, L = 4096, D = 1024, M = NB * L, DEPTH = 2;
constexpr int NH = 8, HD = 64, HW = 512;
constexpr int DFF = 2816;
constexpr int NIN = 5712;
constexpr int C_GA = 3664;
constexpr float ALPHA = 1.4142135623730951f;
constexpr float LN_EPS = 1e-5f;
constexpr float LOG2E = 1.4426950408889634f;
constexpr float QSCALE = 0.125f * LOG2E;
constexpr float IDX_SCALE = 0.04419417382415922f;
constexpr int TOPK = 256;
constexpr int NT = 512;
constexpr int LDS_MISC_OFF = 135168;
constexpr size_t MiB = 1u << 20;
constexpr size_t WS_CTL = 0;
constexpr size_t WS_WT = 1 * MiB, WT_LAYER = 32 * MiB;
constexpr size_t WT_G8 = 12058624 + 4 * 1048576 + 5767168, WT_A8 = WT_G8 + 2 * 1048576, WT_B8 = WT_A8 + 524288, WT_OUT8 = WT_B8 + 524288;
constexpr size_t WT_IN = 0, WT_A = 12058624, WT_B = WT_A + 1048576, WT_OUT = WT_B + 1048576, WT_F1 = WT_OUT + 2097152, WT_F2 = WT_F1 + 11534336;
constexpr int NPROJ = 3840, NGATE = 2048;
constexpr size_t WS_XB = 65 * MiB;
constexpr size_t WS_FQ = 129 * MiB, WS_FK = 161 * MiB, WS_FV = 193 * MiB, WS_DQ = 225 * MiB, WS_DK = 257 * MiB, WS_DV = 289 * MiB, WS_IQ = 321 * MiB;
constexpr size_t WS_IK = 353 * MiB;
constexpr size_t WS_FL = 357 * MiB, WS_IW = 358 * MiB, WS_CUM = 359 * MiB;
constexpr size_t WS_OA = 360 * MiB, WS_OB = 392 * MiB;
constexpr size_t WS_X1B = 360 * MiB;
constexpr size_t WS_MASK = 424 * MiB;
constexpr size_t WS_SGA = 129 * MiB, WS_SGB = 193 * MiB;
constexpr size_t WS_Y1 = 129 * MiB;
constexpr size_t WS_H8 = 129 * MiB;
constexpr size_t WS_X1F8 = 217 * MiB;
constexpr size_t WS_H = 129 * MiB;
constexpr size_t WS_XF8 = 440 * MiB;
constexpr size_t WS_MG8 = 472 * MiB;
constexpr size_t WS_END = 504 * MiB;
constexpr int CW_QHEAD = 8192;
constexpr int CW_KMAX = 8448;
constexpr int CW_BLK = 8704;
constexpr int CW_QMAX = 9216;
}
using namespace cfg;

__device__ __forceinline__ float bf2f(unsigned v) { return __uint_as_float(v << 16); }
__device__ __forceinline__ unsigned f2bf(float f) { unsigned u = __float_as_uint(f); return (u + 0x7fffu + ((u >> 16) & 1u)) >> 16; }

constexpr int LDS_WTAB_OFF = 135168 + 64;
__device__ __forceinline__ unsigned hw_wave_slot() { return ((unsigned)__builtin_amdgcn_s_getreg((3 << 11) | (0 << 6) | 4) & 15u) | (((unsigned)__builtin_amdgcn_s_getreg((1 << 11) | (4 << 6) | 4) & 3u) << 4); }
__device__ __forceinline__ int ltid() {
    const int w = ((volatile LAS int*)(uintptr_t)LDS_WTAB_OFF)[hw_wave_slot()];
    int lane; asm volatile("v_mbcnt_lo_u32_b32 %0, -1, 0\n\tv_mbcnt_hi_u32_b32 %0, -1, %0" : "=v"(lane));
    int t = w * 64 + lane;
    asm volatile("" : "+v"(t)); return t;
}

__device__ __forceinline__ unsigned pk4_fp8(float a, float b, float c, float d) { unsigned w = 0u; w = (unsigned)__builtin_amdgcn_cvt_pk_fp8_f32(a, b, (int)w, false); w = (unsigned)__builtin_amdgcn_cvt_pk_fp8_f32(c, d, (int)w, true); return w; }
constexpr float F8_WSCALE = 256.f, F8_HSCALE = 16.f, F8_W64 = 64.f, F8_OSCALE = 16.f, F8_MSCALE = 16.f;

struct P {
    const float *x, *w_in, *b_forget, *w_a, *w_b, *w_out, *ln1_g, *ln1_b, *w_ffn_in, *w_ffn_out, *ln2_g, *ln2_b;
    float* out; unsigned char* ws;
};
#define WSP(T, off) ((T*)(p.ws + (off)))

struct GemmArgs { const bf16_t* A; int lda; const float* W; int ldw; int N; int K; int dual_off; };

template <class Epi, bool DUAL>
__device__ __forceinline__ void naive_gemm_phase(LAS unsigned char* lds, const GemmArgs g, const Epi& E, int wg, int nwg) {
    LAS float* As = (LAS float*)lds;
    LAS float* Bs = As + 16 * 132;
    LAS float* Bs2 = Bs + 16 * 128;
    const int tid = ltid(), ty = tid >> 5, tx = tid & 31;
    const int ntn = (g.N + 127) / 128, ntm = M / 128, nitems = ntn * ntm;
    for (int it = wg; it < nitems; it += nwg) {
        const int tm = it / ntn, tn = it % ntn;
        const int m0 = tm * 128, n0 = tn * 128;
        float acc[8][4], acc2[8][4];
#pragma unroll
        for (int i = 0; i < 8; ++i)
#pragma unroll
            for (int j = 0; j < 4; ++j) { acc[i][j] = 0.f; acc2[i][j] = 0.f; }
        for (int k0 = 0; k0 < g.K; k0 += 16) {
            {
                const int r = tid >> 2, kq = (tid & 3) * 4;
                const u32x2 v = *(const u32x2*)(g.A + (size_t)(m0 + r) * g.lda + k0 + kq);
                As[(kq + 0) * 132 + r] = bf2f(v.x & 0xffffu); As[(kq + 1) * 132 + r] = bf2f(v.x >> 16);
                As[(kq + 2) * 132 + r] = bf2f(v.y & 0xffffu); As[(kq + 3) * 132 + r] = bf2f(v.y >> 16);
            }
            {
                const int k = tid >> 5, n4 = (tid & 31) * 4, n = n0 + n4;
                f32x4 w = (f32x4){0.f, 0.f, 0.f, 0.f}, w2 = w;
                if (n < g.N) { w = *(const f32x4*)(g.W + (size_t)(k0 + k) * g.ldw + n); if (DUAL) w2 = *(const f32x4*)(g.W + (size_t)(k0 + k) * g.ldw + n + g.dual_off); }
                *(LAS f32x4*)(Bs + k * 128 + n4) = w;
                if (DUAL) *(LAS f32x4*)(Bs2 + k * 128 + n4) = w2;
            }
            __syncthreads();
#pragma unroll 2
            for (int kk = 0; kk < 16; ++kk) {
                const f32x4 a0 = *(const LAS f32x4*)(As + kk * 132 + ty * 8), a1 = *(const LAS f32x4*)(As + kk * 132 + ty * 8 + 4);
                const f32x4 b = *(const LAS f32x4*)(Bs + kk * 128 + tx * 4);
                const float a[8] = {a0.x, a0.y, a0.z, a0.w, a1.x, a1.y, a1.z, a1.w};
                const float bb[4] = {b.x, b.y, b.z, b.w};
#pragma unroll
                for (int i = 0; i < 8; ++i)
#pragma unroll
                    for (int j = 0; j < 4; ++j) acc[i][j] = fmaf(a[i], bb[j], acc[i][j]);
                if (DUAL) {
                    const f32x4 b2 = *(const LAS f32x4*)(Bs2 + kk * 128 + tx * 4);
                    const float b2b[4] = {b2.x, b2.y, b2.z, b2.w};
#pragma unroll
                    for (int i = 0; i < 8; ++i)
#pragma unroll
                        for (int j = 0; j < 4; ++j) acc2[i][j] = fmaf(a[i], b2b[j], acc2[i][j]);
                }
            }
            __syncthreads();
        }
#pragma unroll
        for (int i = 0; i < 8; ++i)
#pragma unroll
            for (int j = 0; j < 4; ++j) { const int n = n0 + tx * 4 + j; if (n < g.N) E(m0 + ty * 8 + i, n, acc[i][j], acc2[i][j]); }
    }
}

struct EpiProj {
    bf16_t *FQ, *FK, *FV, *DQ, *DK, *DV, *IQ, *IK; float *FL, *IW; const float* bforget;
    __device__ __forceinline__ void operator()(int m, int n, float v, float) const {
        const size_t r = (size_t)m;
        if (n < 512) FQ[r * 512 + n] = (bf16_t)f2bf(v * QSCALE);
        else if (n < 1024) FK[r * 512 + (n - 512)] = (bf16_t)f2bf(v);
        else if (n < 1536) FV[r * 512 + (n - 1024)] = (bf16_t)f2bf(v);
        else if (n < 1544) FL[r * 8 + (n - 1536)] = v + bforget[n - 1536];
        else if (n < 2056) DQ[r * 512 + (n - 1544)] = (bf16_t)f2bf(v * QSCALE);
        else if (n < 2568) DK[r * 512 + (n - 2056)] = (bf16_t)f2bf(v);
        else if (n < 3080) DV[r * 512 + (n - 2568)] = (bf16_t)f2bf(v);
        else if (n < 3592) IQ[r * 512 + (n - 3080)] = (bf16_t)f2bf(v);
        else if (n < 3656) IK[r * 64 + (n - 3592)] = (bf16_t)f2bf(v);
        else IW[r * 8 + (n - 3656)] = v;
    }
};
struct EpiGates {
    bf16_t *SGA, *SGB;
    __device__ __forceinline__ void operator()(int m, int n, float v, float) const {
        const float s = 1.f / (1.f + __expf(-v));
        if (n < 1024) SGA[(size_t)m * 1024 + n] = (bf16_t)f2bf(s); else SGB[(size_t)m * 1024 + (n - 1024)] = (bf16_t)f2bf(s);
    }
};
struct EpiBranchA { bf16_t* SGA;
    __device__ __forceinline__ void operator()(int m, int n, float v, float) const { bf16_t* q = SGA + (size_t)m * 1024 + n; *q = (bf16_t)f2bf(bf2f(*q) * v); } };
struct EpiBranchB { const bf16_t* MA; bf16_t* SGB;
    __device__ __forceinline__ void operator()(int m, int n, float v, float) const { const size_t o = (size_t)m * 1024 + n; SGB[o] = (bf16_t)f2bf(bf2f(MA[o]) + bf2f(SGB[o]) * v); } };
struct EpiResF32 { const float* xf; const bf16_t* xb; float* Y;
    __device__ __forceinline__ void operator()(int m, int n, float v, float) const { const size_t o = (size_t)m * 1024 + n; const float xv = xf ? xf[o] : bf2f(xb[o]); Y[o] = ALPHA * xv + v; } };
struct EpiSwiglu { bf16_t* H;
    __device__ __forceinline__ void operator()(int m, int n, float g, float u) const { const float s = g / (1.f + __expf(-g)); H[(size_t)m * DFF + n] = (bf16_t)f2bf(s * u); } };

namespace pg8 {
#define PG8_LAS __attribute__((address_space(3)))
typedef unsigned short bf16_t;
typedef short bf16x8 __attribute__((ext_vector_type(8)));
typedef float f32x4 __attribute__((ext_vector_type(4)));
typedef unsigned u32x4 __attribute__((ext_vector_type(4)));
constexpr int BM = 256, BK = 64, HALF = 128, HTB = HALF * BK * 2  , STAGE_BYTES = 8 * HTB, NXCD = 8, WGM = 8;

__host__ __device__ __forceinline__ int lds_byte(int r, int c) { const int st = (r >> 4) * 2 + (c >> 5), rr = r & 15, cc = c & 31, ob = rr * 64 + cc * 2; return st * 1024 + (ob ^ (((ob >> 9) & 1) << 5)); }
__host__ __device__ __forceinline__ void stage_rc(int b, int& R, int& C) { const int st = b / 1024, sb = b % 1024, swz = sb ^ (((sb >> 9) & 1) << 5); R = (st >> 1) * 16 + swz / 64; C = (st & 1) * 32 + (swz % 64) / 2; }
__host__ __device__ __forceinline__ int perm32(int rho) { const int n = rho >> 4, i = rho & 15; return 8 * (i >> 2) + 4 * n + (i & 3); }

struct Unit { int pm, pn; };
struct Gemm { const bf16_t* A; const bf16_t* Bt; int M, N, K; };

struct StaticOrder {
    int nM, nN, nwg, G, c;
    __host__ __device__ void init(int M, int N, int G_, int c_) { nM = M / BM; nN = N / BM; nwg = nM * nN; G = G_; c = c_; }
    __host__ __device__ bool next(int i, Unit& u) const {
        const long L = (long)i * G + c; if (L >= nwg) return false;
        int wgid = (int)L; { const int q = nwg / NXCD, r = nwg % NXCD, xcd = wgid % NXCD, off = wgid / NXCD; wgid = (xcd < r ? xcd * (q + 1) : r * (q + 1) + (xcd - r) * q) + off; }
        const int nig = WGM * nN, gid = wgid / nig, fm = gid * WGM, gsz = (nM - fm) < WGM ? (nM - fm) : WGM;
        u.pm = fm + ((wgid % nig) % gsz); u.pn = (wgid % nig) / gsz; return true;
    }
    __device__ __forceinline__ void a_ready(const Unit&) const {}
    __device__ __forceinline__ void done(const Unit&) const {}
};


typedef float f32x2_t __attribute__((ext_vector_type(2))); typedef __bf16 bf16x2_t __attribute__((ext_vector_type(2)));
__device__ __forceinline__ unsigned cvt_pk_bf16(float lo, float hi) { f32x2_t v = {lo, hi}; bf16x2_t b = __builtin_convertvector(v, bf16x2_t); return __builtin_bit_cast(unsigned, b); }
__device__ __forceinline__ float bflo(unsigned w) { return __uint_as_float(w << 16); }
__device__ __forceinline__ float bfhi(unsigned w) { return __uint_as_float(w & 0xffff0000u); }
__device__ __forceinline__ u32x4 pack8(const f32x4 v0, const f32x4 v1) { u32x4 w; w.x = cvt_pk_bf16(v0[0], v0[1]); w.y = cvt_pk_bf16(v0[2], v0[3]); w.z = cvt_pk_bf16(v1[0], v1[1]); w.w = cvt_pk_bf16(v1[2], v1[3]); return w; }
__device__ __forceinline__ float sigmoid_f(float v) { return __builtin_amdgcn_rcpf(1.0f + __builtin_amdgcn_exp2f(-1.4426950408889634f * v)); }

struct EpiProjF {
    static constexpr bool PERM = true, AFTER_DRAIN = false;
    bf16_t* QKV; size_t tstride; bf16_t* IK; float* FL; float* IW; const float* bforget; float qs;
    __device__ __forceinline__ void operator()(const f32x4 (&acc)[2][2][4][2], const Unit& u, int wr, int wc, int fr, int fq) const {
        const int row0 = u.pm * BM + wr * 64 + fr;
        if (u.pn < 14) {
            const int t = u.pn >> 1; const float sc = (t == 0 || t == 3) ? qs : 1.f;
            bf16_t* base = QKV + (size_t)t * tstride + (u.pn & 1) * 256 + wc * 32 + 8 * fq;
#pragma unroll
            for (int ai = 0; ai < 2; ++ai)
#pragma unroll
                for (int m = 0; m < 4; ++m) { bf16_t* rowp = base + (size_t)(row0 + ai * HALF + m * 16) * 512;
#pragma unroll
                    for (int bj = 0; bj < 2; ++bj) *(u32x4*)(rowp + bj * HALF) = pack8(acc[ai][bj][m][0] * sc, acc[ai][bj][m][1] * sc); }
        } else {
#pragma unroll
            for (int ai = 0; ai < 2; ++ai)
#pragma unroll
                for (int m = 0; m < 4; ++m) { const size_t row = (size_t)(row0 + ai * HALF + m * 16);
                    const f32x4 v0 = acc[ai][0][m][0], v1 = acc[ai][0][m][1];
                    if (wc < 2) *(u32x4*)(IK + row * 64 + wc * 32 + 8 * fq) = pack8(v0, v1);
                    else if (wc == 2 && fq == 0) { *(f32x4*)(FL + row * 8) = v0 + *(const f32x4*)bforget; *(f32x4*)(FL + row * 8 + 4) = v1 + *(const f32x4*)(bforget + 4); }
                    else if (wc == 2 && fq == 1) { *(f32x4*)(IW + row * 8) = v0; *(f32x4*)(IW + row * 8 + 4) = v1; } }
        }
    }
};
struct EpiGatesF {
    static constexpr bool PERM = true, AFTER_DRAIN = false;
    bf16_t* SG; size_t tstride; float accs;
    __device__ __forceinline__ void operator()(const f32x4 (&acc)[2][2][4][2], const Unit& u, int wr, int wc, int fr, int fq) const {
        asm volatile("" : "+v"(fr), "+v"(fq));
        const int row0 = u.pm * BM + wr * 64 + fr;
        bf16_t* base = SG + (size_t)(u.pn >> 2) * tstride + (u.pn & 3) * 256 + wc * 32 + 8 * fq;
#pragma unroll
        for (int ai = 0; ai < 2; ++ai)
#pragma unroll
            for (int m = 0; m < 4; ++m) { bf16_t* rowp = base + (size_t)(row0 + ai * HALF + m * 16) * 1024;
#pragma unroll
                for (int bj = 0; bj < 2; ++bj) { f32x4 v0 = acc[ai][bj][m][0], v1 = acc[ai][bj][m][1];
#pragma unroll
                    for (int e = 0; e < 4; ++e) { v0[e] = sigmoid_f(v0[e] * accs); v1[e] = sigmoid_f(v1[e] * accs); }
                    *(u32x4*)(rowp + bj * HALF) = pack8(v0, v1); } }
    }
};
template <int MODE> struct EpiBranchF {
    static constexpr bool PERM = true, AFTER_DRAIN = false;
    bf16_t* G; const bf16_t* MA; unsigned char* M8; float accs; float ms;
    __device__ __forceinline__ void operator()(const f32x4 (&acc)[2][2][4][2], const Unit& u, int wr, int wc, int fr, int fq) const {
        asm volatile("" : "+v"(fr), "+v"(fq));
        const int row0 = u.pm * BM + wr * 64 + fr; const int col0 = u.pn * BM + wc * 32 + 8 * fq;
        float accs = this->accs, ms = this->ms; asm volatile("" : "+s"(accs), "+s"(ms));
#pragma unroll
        for (int ai = 0; ai < 2; ++ai)
#pragma unroll
            for (int m = 0; m < 4; ++m) { const size_t off = (size_t)(row0 + ai * HALF + m * 16) * 1024 + col0;
#pragma unroll
                for (int bj = 0; bj < 2; ++bj) { const f32x4 a0 = acc[ai][bj][m][0], a1 = acc[ai][bj][m][1];
                    const u32x4 g = *(const u32x4*)(G + off + bj * HALF);
                    f32x4 v0 = (f32x4){bflo(g.x) * a0[0], bfhi(g.x) * a0[1], bflo(g.y) * a0[2], bfhi(g.y) * a0[3]} * accs;
                    f32x4 v1 = (f32x4){bflo(g.z) * a1[0], bfhi(g.z) * a1[1], bflo(g.w) * a1[2], bfhi(g.w) * a1[3]} * accs;
                    if (MODE == 1) { const u32x4 q = *(const u32x4*)(MA + off + bj * HALF);
                        v0 = v0 + (f32x4){bflo(q.x), bfhi(q.x), bflo(q.y), bfhi(q.y)}; v1 = v1 + (f32x4){bflo(q.z), bfhi(q.z), bflo(q.w), bfhi(q.w)}; }
                    *(u32x4*)(G + off + bj * HALF) = pack8(v0, v1); }
                asm volatile("" ::: "memory"); }
    }
};
struct EpiResF {
    static constexpr bool PERM = true, AFTER_DRAIN = false;
    const float* xf; const bf16_t* xb; bf16_t* Y; float alpha; float accs;
    __device__ __forceinline__ void operator()(const f32x4 (&acc)[2][2][4][2], const Unit& u, int wr, int wc, int fr, int fq) const {
        asm volatile("" : "+v"(fr), "+v"(fq));
        const int row0 = u.pm * BM + wr * 64 + fr; const int col0 = u.pn * BM + wc * 32 + 8 * fq;
#pragma unroll
        for (int ai = 0; ai < 2; ++ai)
#pragma unroll
            for (int m = 0; m < 4; ++m) { const size_t off = (size_t)(row0 + ai * HALF + m * 16) * 1024 + col0;
#pragma unroll
                for (int bj = 0; bj < 2; ++bj) { const size_t o = off + bj * HALF; f32x4 x0, x1;
                    if (xf) { x0 = *(const f32x4*)(xf + o); x1 = *(const f32x4*)(xf + o + 4); }
                    else { const u32x4 w = *(const u32x4*)(xb + o); x0 = (f32x4){bflo(w.x), bfhi(w.x), bflo(w.y), bfhi(w.y)}; x1 = (f32x4){bflo(w.z), bfhi(w.z), bflo(w.w), bfhi(w.w)}; }
                    *(u32x4*)(Y + o) = pack8(x0 * alpha + acc[ai][bj][m][0] * accs, x1 * alpha + acc[ai][bj][m][1] * accs); } }
    }
};
struct EpiSwigluF {
    static constexpr bool PERM = true, AFTER_DRAIN = false;
    bf16_t* H; int ldh;
    __device__ __forceinline__ void operator()(const f32x4 (&acc)[2][2][4][2], const Unit& u, int wr, int wc, int fr, int fq) const {
        const int row0 = u.pm * BM + wr * 64 + fr; const int col0 = u.pn * HALF + wc * 32 + 8 * fq;
#pragma unroll
        for (int ai = 0; ai < 2; ++ai)
#pragma unroll
            for (int m = 0; m < 4; ++m) { f32x4 v0, v1;
#pragma unroll
                for (int e = 0; e < 4; ++e) { const float g0 = acc[ai][0][m][0][e], g1 = acc[ai][0][m][1][e];
                    v0[e] = g0 * sigmoid_f(g0) * acc[ai][1][m][0][e]; v1[e] = g1 * sigmoid_f(g1) * acc[ai][1][m][1][e]; }
                *(u32x4*)(H + (size_t)(row0 + ai * HALF + m * 16) * ldh + col0) = pack8(v0, v1); }
    }
};

struct EpiSwigluF8 {
    static constexpr bool PERM = true, AFTER_DRAIN = false;
    unsigned char* H8; int ldh; float accs, hs;
    __device__ __forceinline__ void operator()(const f32x4 (&acc)[2][2][4][2], const Unit& u, int wr, int wc, int fr, int fq) const {
        asm volatile("" : "+v"(fr), "+v"(fq));
        typedef unsigned u32x2v __attribute__((ext_vector_type(2)));
        const int row0 = u.pm * BM + wr * 64 + fr; const int col0 = u.pn * HALF + wc * 32 + 8 * fq;
#pragma unroll
        for (int ai = 0; ai < 2; ++ai)
#pragma unroll
            for (int m = 0; m < 4; ++m) { float v[8];
#pragma unroll
                for (int e = 0; e < 4; ++e) { const float g0 = acc[ai][0][m][0][e] * accs, g1 = acc[ai][0][m][1][e] * accs;
                    v[e] = __builtin_amdgcn_fmed3f(g0 * sigmoid_f(g0) * (acc[ai][1][m][0][e] * accs) * hs, -448.f, 448.f); v[4 + e] = __builtin_amdgcn_fmed3f(g1 * sigmoid_f(g1) * (acc[ai][1][m][1][e] * accs) * hs, -448.f, 448.f); }
                u32x2v w; w.x = pk4_fp8(v[0], v[1], v[2], v[3]); w.y = pk4_fp8(v[4], v[5], v[6], v[7]);
                *(u32x2v*)(H8 + (size_t)(row0 + ai * HALF + m * 16) * ldh + col0) = w; }
    }
};

template <class Epi, class Sched, bool ALIGN_EPI = false, bool SP2 = false, bool FP8 = false>
__device__ __forceinline__ void gemm_phase(PG8_LAS unsigned char* lds, const Gemm g, const Sched& S, const Epi& E) {
    const int tid = ltid(), wid = __builtin_amdgcn_readfirstlane(tid >> 6), lane = tid & 63, wr = wid >> 2, wc = wid & 3, fr = lane & 15, fq = lane >> 4;
    const int K = g.K, rowb = FP8 ? K : 2 * K, nt = rowb / (2 * BK);
    unsigned voffA[2], voffB[2];
#define PG8_VOFF() do { int t_ = tid; if constexpr (FP8) asm volatile("" : "+v"(t_));     \
    _Pragma("unroll") for (int i = 0; i < 2; ++i) { int R, C; stage_rc(t_ * 16 + i * 8192, R, C); const int Rb = Epi::PERM ? ((R & ~31) + perm32(R & 31)) : R; \
        voffA[i] = (unsigned)(R * rowb + C * 2); voffB[i] = (unsigned)(Rb * rowb + C * 2); } } while (0)
    PG8_VOFF();
    const size_t kstep = (size_t)(BK * 2);
    const size_t hstep = (size_t)HALF * rowb;
    const size_t tstep = 2 * hstep;
    const unsigned ldsw = (unsigned)wid * 1024u;
    const int aoff = lds_byte(wr * 64 + fr, fq * 8), boff = lds_byte(wc * 32 + fr, fq * 8);
#define PG8_SA(b, h) (((b) * 2 + (h)) * HTB)
#define PG8_SB(b, h) ((4 + (b) * 2 + (h)) * HTB)
#define PG8_STAGE(bufoff, gbase, voff) do { _Pragma("unroll") for (int _i = 0; _i < 2; ++_i) { unsigned vo_ = (voff)[_i]; if constexpr (FP8) asm volatile("" : "+v"(vo_));     \
        __builtin_amdgcn_global_load_lds((const unsigned*)((const char*)(gbase) + vo_), (PG8_LAS unsigned*)(lds + (bufoff) + ldsw + _i * 8192), 16, 0, 0); } } while (0)
#define PG8_LDF(f, base) do { if constexpr (FP8) { const i32x4_t l0_ = *(const PG8_LAS i32x4_t*)(base), l1_ = *(const PG8_LAS i32x4_t*)((base) + 1024); f.w = __builtin_shufflevector(l0_, l1_, 0, 1, 2, 3, 4, 5, 6, 7); } \
        else { f.h[0] = *(const PG8_LAS bf16x8*)(base); f.h[1] = *(const PG8_LAS bf16x8*)((base) + 1024); } } while (0)
#define PG8_LDA(dst, b, h) do { _Pragma("unroll") for (int m = 0; m < 4; ++m) PG8_LDF(dst[m], lds + PG8_SA(b, h) + aoff + m * 2048); } while (0)
#define PG8_LDB(dst, b, h) do { _Pragma("unroll") for (int n = 0; n < 2; ++n) PG8_LDF(dst[n], lds + PG8_SB(b, h) + boff + n * 2048); } while (0)
#define PG8_MMA(ai, bj, At, Bt) do { __builtin_amdgcn_s_setprio(1); _Pragma("unroll") for (int m = 0; m < 4; ++m) _Pragma("unroll") for (int n = 0; n < 2; ++n) { \
        if constexpr (FP8) acc[ai][bj][m][n] = __builtin_amdgcn_mfma_scale_f32_16x16x128_f8f6f4(Bt[n].w, At[m].w, acc[ai][bj][m][n], 0, 0, 0, 0, 0, 0);     \
        else { _Pragma("unroll") for (int k = 0; k < 2; ++k) acc[ai][bj][m][n] = __builtin_amdgcn_mfma_f32_16x16x32_bf16(Bt[n].h[k], At[m].h[k], acc[ai][bj][m][n], 0, 0, 0); } } \
        __builtin_amdgcn_s_setprio(0); } while (0)
#define PG8_WAIT_V(n) asm volatile("s_waitcnt vmcnt(" #n ")" ::: "memory")
#define PG8_WAIT_L(n) asm volatile("s_waitcnt lgkmcnt(" #n ")" ::: "memory")
#define PG8_BAR __builtin_amdgcn_s_barrier()
#define PG8_SCHED __builtin_amdgcn_sched_barrier(0)
    Unit cur, nxt; int ui = 0;
    if (!S.next(0, cur)) return;
    f32x4 acc[2][2][4][2];
#pragma unroll
    for (int a = 0; a < 2; ++a)
#pragma unroll
        for (int b = 0; b < 2; ++b)
#pragma unroll
            for (int m = 0; m < 4; ++m)
#pragma unroll
                for (int n = 0; n < 2; ++n) acc[a][b][m][n] = (f32x4){0.f, 0.f, 0.f, 0.f};
    typedef int i32x8_t __attribute__((ext_vector_type(8))); typedef int i32x4_t __attribute__((ext_vector_type(4)));
    struct Frag { bf16x8 h[2]; i32x8_t w; };
    Frag At[4], B0[2], B1[2];
    const char* cA = (const char*)g.A + (size_t)cur.pm * tstep; const char* cB = (const char*)g.Bt + (size_t)cur.pn * tstep;
    S.a_ready(cur);
    if constexpr (SP2) {
        PG8_STAGE(PG8_SB(0, 0), cB, voffB); PG8_STAGE(PG8_SB(0, 1), cB + hstep, voffB); PG8_STAGE(PG8_SA(0, 0), cA, voffA); PG8_STAGE(PG8_SA(0, 1), cA + hstep, voffA);
        if (wr == 1) PG8_BAR;
        PG8_WAIT_V(2); PG8_BAR;
        PG8_STAGE(PG8_SB(1, 0), cB + kstep, voffB); PG8_STAGE(PG8_SA(1, 0), cA + kstep, voffA); PG8_STAGE(PG8_SB(1, 1), cB + hstep + kstep, voffB);
        PG8_WAIT_V(6); PG8_BAR;
    } else {
        PG8_STAGE(PG8_SB(0, 0), cB, voffB); PG8_STAGE(PG8_SA(0, 0), cA, voffA); PG8_STAGE(PG8_SB(0, 1), cB + hstep, voffB); PG8_STAGE(PG8_SA(0, 1), cA + hstep, voffA);
        if (wr == 1) PG8_BAR;
        PG8_WAIT_V(4); PG8_BAR;
        PG8_STAGE(PG8_SB(1, 0), cB + kstep, voffB); PG8_STAGE(PG8_SA(1, 0), cA + kstep, voffA); PG8_STAGE(PG8_SB(1, 1), cB + hstep + kstep, voffB);
        PG8_WAIT_V(6); PG8_BAR;
    }
    for (;;) {
        const bool has_next = S.next(ui + 1, nxt);
        const char* nA = has_next ? (const char*)g.A + (size_t)nxt.pm * tstep : cA; const char* nB = has_next ? (const char*)g.Bt + (size_t)nxt.pn * tstep : cB;
        for (int t = 0; t < nt; t += 2) {
            const bool last = (t == nt - 2);
            const char* a1 = cA + (size_t)(t + 1) * kstep;
            const char* a2 = last ? nA : cA + (size_t)(t + 2) * kstep; const char* b2 = last ? nB : cB + (size_t)(t + 2) * kstep;
            const char* a3 = a2 + kstep; const char* b3 = b2 + kstep;
            if (last && has_next) S.a_ready(nxt);
            if constexpr (SP2) {
            PG8_LDB(B0, 0, 0); PG8_LDB(B1, 0, 1); PG8_SCHED; PG8_LDA(At, 0, 0); PG8_STAGE(PG8_SA(1, 1), a1 + hstep, voffA);
            PG8_WAIT_V(8); PG8_WAIT_L(0); PG8_BAR; PG8_MMA(0, 0, At, B0); PG8_MMA(0, 1, At, B1); PG8_BAR; PG8_SCHED;
            PG8_LDA(At, 0, 1); PG8_STAGE(PG8_SB(0, 0), b2, voffB); PG8_STAGE(PG8_SB(0, 1), b2 + hstep, voffB); PG8_STAGE(PG8_SA(0, 0), a2, voffA);
            PG8_WAIT_V(8); PG8_WAIT_L(0); PG8_BAR; PG8_MMA(1, 0, At, B0); PG8_MMA(1, 1, At, B1); PG8_BAR; PG8_SCHED;
            PG8_LDB(B0, 1, 0); PG8_LDB(B1, 1, 1); PG8_SCHED; PG8_LDA(At, 1, 0); PG8_STAGE(PG8_SA(0, 1), a2 + hstep, voffA);
            PG8_WAIT_V(8); PG8_WAIT_L(0); PG8_BAR; PG8_MMA(0, 0, At, B0); PG8_MMA(0, 1, At, B1); PG8_BAR; PG8_SCHED;
            PG8_LDA(At, 1, 1); PG8_STAGE(PG8_SB(1, 0), b3, voffB); PG8_STAGE(PG8_SB(1, 1), b3 + hstep, voffB); PG8_STAGE(PG8_SA(1, 0), a3, voffA);
            PG8_WAIT_V(8); PG8_WAIT_L(0); PG8_BAR; PG8_MMA(1, 0, At, B0); PG8_MMA(1, 1, At, B1); PG8_BAR; PG8_SCHED;
            } else {
            PG8_LDB(B0, 0, 0); PG8_SCHED; PG8_LDA(At, 0, 0); PG8_STAGE(PG8_SA(1, 1), a1 + hstep, voffA);
            PG8_WAIT_L(8); PG8_BAR; PG8_WAIT_L(0); PG8_MMA(0, 0, At, B0); PG8_BAR; PG8_SCHED;
            PG8_LDB(B1, 0, 1); PG8_STAGE(PG8_SB(0, 0), b2, voffB);
            PG8_BAR; PG8_WAIT_L(0); PG8_MMA(0, 1, At, B1); PG8_BAR;
            PG8_LDA(At, 0, 1); PG8_STAGE(PG8_SA(0, 0), a2, voffA);
            PG8_BAR; PG8_WAIT_L(0); PG8_MMA(1, 0, At, B0); PG8_BAR; PG8_SCHED;
            PG8_STAGE(PG8_SB(0, 1), b2 + hstep, voffB);
            PG8_WAIT_V(6); PG8_BAR; PG8_MMA(1, 1, At, B1); PG8_BAR;
            PG8_LDB(B0, 1, 0); PG8_SCHED; PG8_LDA(At, 1, 0); PG8_STAGE(PG8_SA(0, 1), a2 + hstep, voffA);
            PG8_WAIT_L(8); PG8_BAR; PG8_WAIT_L(0); PG8_MMA(0, 0, At, B0); PG8_BAR; PG8_SCHED;
            PG8_LDB(B1, 1, 1); PG8_STAGE(PG8_SB(1, 0), b3, voffB);
            PG8_BAR; PG8_WAIT_L(0); PG8_MMA(0, 1, At, B1); PG8_BAR;
            PG8_LDA(At, 1, 1); PG8_STAGE(PG8_SA(1, 0), a3, voffA);
            PG8_BAR; PG8_WAIT_L(0); PG8_MMA(1, 0, At, B0); PG8_BAR; PG8_SCHED;
            PG8_STAGE(PG8_SB(1, 1), b3 + hstep, voffB);
            PG8_WAIT_V(6); PG8_BAR; PG8_MMA(1, 1, At, B1); PG8_BAR;
            }
        }
        if constexpr (ALIGN_EPI) { if (wr == 0) PG8_BAR; }
        if constexpr (!Epi::AFTER_DRAIN) { E(acc, cur, wr, wc, fr, fq); S.done(cur); }
        if (!has_next) break;
#pragma unroll
        for (int a = 0; a < 2; ++a)
#pragma unroll
            for (int b = 0; b < 2; ++b)
#pragma unroll
                for (int m = 0; m < 4; ++m)
#pragma unroll
                    for (int n = 0; n < 2; ++n) acc[a][b][m][n] = (f32x4){0.f, 0.f, 0.f, 0.f};
        cur = nxt; cA = nA; cB = nB; ++ui;
        if constexpr (ALIGN_EPI) { if (wr == 1) PG8_BAR; }
    }
    PG8_WAIT_V(0);
    if constexpr (!ALIGN_EPI) { if (wr == 0) PG8_BAR; }
    PG8_BAR;
    if constexpr (Epi::AFTER_DRAIN) { E.fused(acc, cur, wr, wc, fr, fq, lds, wid, lane); S.done(cur); }
#undef PG8_SA
#undef PG8_SB
#undef PG8_STAGE
#undef PG8_LDA
#undef PG8_LDB
#undef PG8_LDF
#undef PG8_VOFF
#undef PG8_MMA
#undef PG8_WAIT_V
#undef PG8_WAIT_L
#undef PG8_BAR
#undef PG8_SCHED
}
}

__device__ __forceinline__ void cvt_phase(const P& p, int wg, int nwg) {
    bf16_t* XB = WSP(bf16_t, WS_XB);
    const size_t n4 = (size_t)M * D / 4;
    const int tid = ltid();
    for (size_t i = (size_t)wg * NT + tid; i < n4; i += (size_t)nwg * NT) {
        const f32x4 v = ((const f32x4*)p.x)[i];
        u32x2 o; o.x = f2bf(v.x) | (f2bf(v.y) << 16); o.y = f2bf(v.z) | (f2bf(v.w) << 16);
        ((u32x2*)XB)[i] = o;
        ((unsigned*)WSP(unsigned char, WS_XF8))[i] = pk4_fp8(v.x, v.y, v.z, v.w);
    }
}

__device__ __forceinline__ void cum_phase(const P& p, LAS unsigned char* lds, int wg, int nwg) {
    const float* FL = WSP(const float, WS_FL); float* CUM = WSP(float, WS_CUM);
    LAS float* wsum = (LAS float*)lds;
    const int tid = ltid(), lane = tid & 63, wv = tid >> 6;
    for (int it = wg; it < NB * NH; it += nwg) {
        const int b = it / NH, h = it % NH;
        float v[8]; float s = 0.f;
#pragma unroll
        for (int j = 0; j < 8; ++j) { const int t = tid * 8 + j; const float z = FL[((size_t)b * L + t) * 8 + h];
            const float ls = fminf(z, 0.f) - log1pf(__expf(-fabsf(z))); s += ls; v[j] = s; }
        float incl = s;
#pragma unroll
        for (int o = 1; o < 64; o <<= 1) { const float u = __shfl_up(incl, o); if (lane >= o) incl += u; }
        if (lane == 63) wsum[wv] = incl;
        __syncthreads();
        float base = incl - s;
        for (int w = 0; w < wv; ++w) base += wsum[w];
#pragma unroll
        for (int j = 0; j < 8; ++j) CUM[((size_t)b * NH + h) * L + tid * 8 + j] = base + v[j];
        __syncthreads();
    }
}

__device__ __forceinline__ void norm_phase(const P& p, unsigned* kmax2, float* qmax2, int wg, int nwg) {
    const int tid = ltid(), lane = tid & 63;
    for (int it = wg; it < 512; it += nwg) {
        const int mixer = it >> 8, bh = (it >> 2) & 63, qt = it & 3, b = bh >> 3, h = bh & 7;
        const bf16_t* Q = mixer ? WSP(const bf16_t, WS_DQ) : WSP(const bf16_t, WS_FQ); const bf16_t* K = mixer ? WSP(const bf16_t, WS_DK) : WSP(const bf16_t, WS_FK);
        float qm = 0.f, km = 0.f;
#pragma unroll
        for (int j = 0; j < 2; ++j) {
            const size_t row = (size_t)b * L + qt * 1024 + tid * 2 + j;
            const u32x4* qr = (const u32x4*)(Q + row * 512 + h * 64); const u32x4* kr = (const u32x4*)(K + row * 512 + h * 64);
            float qs = 0.f, ks = 0.f;
#pragma unroll
            for (int c = 0; c < 8; ++c) { const u32x4 a = qr[c], d = kr[c];
                const float q0 = bf2f(a.x & 0xffffu), q1 = __uint_as_float(a.x & 0xffff0000u), q2 = bf2f(a.y & 0xffffu), q3 = __uint_as_float(a.y & 0xffff0000u), q4 = bf2f(a.z & 0xffffu), q5 = __uint_as_float(a.z & 0xffff0000u), q6 = bf2f(a.w & 0xffffu), q7 = __uint_as_float(a.w & 0xffff0000u);
                const float k0 = bf2f(d.x & 0xffffu), k1 = __uint_as_float(d.x & 0xffff0000u), k2 = bf2f(d.y & 0xffffu), k3 = __uint_as_float(d.y & 0xffff0000u), k4 = bf2f(d.z & 0xffffu), k5 = __uint_as_float(d.z & 0xffff0000u), k6 = bf2f(d.w & 0xffffu), k7 = __uint_as_float(d.w & 0xffff0000u);
                qs += (q0 * q0 + q1 * q1) + (q2 * q2 + q3 * q3) + (q4 * q4 + q5 * q5) + (q6 * q6 + q7 * q7);
                ks += (k0 * k0 + k1 * k1) + (k2 * k2 + k3 * k3) + (k4 * k4 + k5 * k5) + (k6 * k6 + k7 * k7); }
            qm = fmaxf(qm, qs); km = fmaxf(km, ks);
        }
#pragma unroll
        for (int o = 1; o < 64; o <<= 1) { qm = fmaxf(qm, __shfl_xor(qm, o)); km = fmaxf(km, __shfl_xor(km, o)); }
        if (lane == 0) {
            __hip_atomic_fetch_max((unsigned*)qmax2 + (mixer * 64 + bh) * 16 + qt * 4 + (tid >> 7), __float_as_uint(qm * 1.01f), __ATOMIC_RELAXED, __HIP_MEMORY_SCOPE_AGENT);
            __hip_atomic_fetch_max(kmax2 + mixer * 64 + bh, __float_as_uint(km * 1.01f), __ATOMIC_RELAXED, __HIP_MEMORY_SCOPE_AGENT);
        }
    }
}

__device__ __forceinline__ void ln_phase(const bf16_t* Y, const float* g, const float* bta, bf16_t* XO, float* FO, int wg, int nwg, unsigned char* X8 = nullptr) {
    const int tid = ltid(), lane = tid & 63, wv = tid >> 6;
    for (int m = wg * 8 + wv; m < M; m += nwg * 8) {
        const u32x4* yr = (const u32x4*)(Y + (size_t)m * D) + 2 * lane;
        const u32x4 a = yr[0], b = yr[1];
        float v[16] = {bf2f(a.x & 0xffffu), __uint_as_float(a.x & 0xffff0000u), bf2f(a.y & 0xffffu), __uint_as_float(a.y & 0xffff0000u), bf2f(a.z & 0xffffu), __uint_as_float(a.z & 0xffff0000u), bf2f(a.w & 0xffffu), __uint_as_float(a.w & 0xffff0000u),
                       bf2f(b.x & 0xffffu), __uint_as_float(b.x & 0xffff0000u), bf2f(b.y & 0xffffu), __uint_as_float(b.y & 0xffff0000u), bf2f(b.z & 0xffffu), __uint_as_float(b.z & 0xffff0000u), bf2f(b.w & 0xffffu), __uint_as_float(b.w & 0xffff0000u)};
        float s = 0.f;
#pragma unroll
        for (int j = 0; j < 16; ++j) s += v[j];
#pragma unroll
        for (int o = 1; o < 64; o <<= 1) s += __shfl_xor(s, o);
        const float mean = s * (1.f / D); float s2 = 0.f;
#pragma unroll
        for (int j = 0; j < 16; ++j) { v[j] -= mean; s2 += v[j] * v[j]; }
#pragma unroll
        for (int o = 1; o < 64; o <<= 1) s2 += __shfl_xor(s2, o);
        const float rstd = 1.f / sqrtf(s2 * (1.f / D) + LN_EPS);
        const f32x4* gp = (const f32x4*)g + 4 * lane; const f32x4* bp = (const f32x4*)bta + 4 * lane;
        f32x4 o4[4];
#pragma unroll
        for (int j = 0; j < 4; ++j) { const f32x4 gg = gp[j], bb = bp[j]; o4[j] = (f32x4){v[4 * j], v[4 * j + 1], v[4 * j + 2], v[4 * j + 3]} * rstd * gg + bb; }
        if (XO) { u32x4 w0, w1;
            w0.x = f2bf(o4[0].x) | (f2bf(o4[0].y) << 16); w0.y = f2bf(o4[0].z) | (f2bf(o4[0].w) << 16); w0.z = f2bf(o4[1].x) | (f2bf(o4[1].y) << 16); w0.w = f2bf(o4[1].z) | (f2bf(o4[1].w) << 16);
            w1.x = f2bf(o4[2].x) | (f2bf(o4[2].y) << 16); w1.y = f2bf(o4[2].z) | (f2bf(o4[2].w) << 16); w1.z = f2bf(o4[3].x) | (f2bf(o4[3].y) << 16); w1.w = f2bf(o4[3].z) | (f2bf(o4[3].w) << 16);
            u32x4* xo = (u32x4*)(XO + (size_t)m * D) + 2 * lane; xo[0] = w0; xo[1] = w1;
            if (X8) { u32x4 q; q.x = pk4_fp8(o4[0].x, o4[0].y, o4[0].z, o4[0].w); q.y = pk4_fp8(o4[1].x, o4[1].y, o4[1].z, o4[1].w); q.z = pk4_fp8(o4[2].x, o4[2].y, o4[2].z, o4[2].w); q.w = pk4_fp8(o4[3].x, o4[3].y, o4[3].z, o4[3].w);
                *((u32x4*)(X8 + (size_t)m * D) + lane) = q; } }
        else { f32x4* fo = (f32x4*)(FO + (size_t)m * D) + 4 * lane;
#pragma unroll
            for (int j = 0; j < 4; ++j) fo[j] = o4[j]; }
    }
}

__device__ __forceinline__ unsigned sortable(float f) { const unsigned u = __float_as_uint(f); return (u & 0x80000000u) ? ~u : (u | 0x80000000u); }
__device__ __forceinline__ unsigned wg_sum(unsigned c, LAS unsigned* buf, int par, int tid) {
#pragma unroll
    for (int o = 1; o < 64; o <<= 1) c += __shfl_xor(c, o);
    if ((tid & 63) == 0) buf[par * 8 + (tid >> 6)] = c;
    __syncthreads();
    unsigned s = 0;
#pragma unroll
    for (int w = 0; w < 8; ++w) s += buf[par * 8 + w];
    return s;
}
__device__ __forceinline__ void idx_phase(const P& p, LAS unsigned char* lds, int wg, int nwg) {
    const bf16_t* IQ = WSP(const bf16_t, WS_IQ); const bf16_t* IK = WSP(const bf16_t, WS_IK); const float* IW = WSP(const float, WS_IW);
    unsigned* MASK = WSP(unsigned, WS_MASK);
    LAS float* iqs = (LAS float*)lds;
    LAS float* wv = iqs + 512;
    LAS unsigned* cbuf = (LAS unsigned*)(wv + 8);
    LAS unsigned* wtot = cbuf + 16;
    LAS unsigned char* bytes = (LAS unsigned char*)(wtot + 8);
    LAS unsigned* sc = (LAS unsigned*)(bytes + 512);
    const int tid = ltid(), lane = tid & 63, wave = tid >> 6;
    for (int row = wg; row < M; row += nwg) {
        const int b = row / L, t = row % L, n = t + 1;
        iqs[tid] = bf2f(IQ[(size_t)row * 512 + tid]);
        if (tid < 8) wv[tid] = IW[(size_t)row * 8 + tid] * IDX_SCALE;
        __syncthreads();
        for (int s = tid; s < L; s += NT) {
            unsigned key = 0u;
            if (s < n) {
                float kf[64];
                const u32x4* kr = (const u32x4*)(IK + ((size_t)b * L + s) * 64);
#pragma unroll
                for (int c = 0; c < 8; ++c) { const u32x4 v = kr[c];
                    kf[c * 8 + 0] = bf2f(v.x & 0xffffu); kf[c * 8 + 1] = bf2f(v.x >> 16); kf[c * 8 + 2] = bf2f(v.y & 0xffffu); kf[c * 8 + 3] = bf2f(v.y >> 16);
                    kf[c * 8 + 4] = bf2f(v.z & 0xffffu); kf[c * 8 + 5] = bf2f(v.z >> 16); kf[c * 8 + 6] = bf2f(v.w & 0xffffu); kf[c * 8 + 7] = bf2f(v.w >> 16); }
                float score = 0.f;
#pragma unroll 1
                for (int h = 0; h < 8; ++h) {
                    float d0 = 0.f, d1 = 0.f;
#pragma unroll
                    for (int d = 0; d < 64; d += 4) { const f32x4 q = *(const LAS f32x4*)(iqs + h * 64 + d);
                        d0 = fmaf(q.x, kf[d], d0); d1 = fmaf(q.y, kf[d + 1], d1); d0 = fmaf(q.z, kf[d + 2], d0); d1 = fmaf(q.w, kf[d + 3], d1); }
                    score = fmaf(wv[h], fmaxf(d0 + d1, 0.f), score);
                }
                key = sortable(score + 0.f);
                if (key == 0u) key = 1u;
            }
            sc[s] = key;
        }
        __syncthreads();
        unsigned k8[8];
#pragma unroll
        for (int j = 0; j < 8; ++j) k8[j] = sc[tid * 8 + j];
        unsigned bits = 0u;
        if (n <= TOPK) {
#pragma unroll
            for (int j = 0; j < 8; ++j) if (tid * 8 + j < n) bits |= 1u << j;
        } else {
            unsigned T = 0u; int par = 0;
            for (int bit = 31; bit >= 0; --bit) {
                const unsigned cand = T | (1u << bit); unsigned c = 0;
#pragma unroll
                for (int j = 0; j < 8; ++j) c += (k8[j] >= cand) ? 1u : 0u;
                if (wg_sum(c, cbuf, par, tid) >= (unsigned)TOPK) T = cand;
                par ^= 1;
            }
            unsigned cg = 0, ce = 0;
#pragma unroll
            for (int j = 0; j < 8; ++j) { cg += (k8[j] > T) ? 1u : 0u; ce += (k8[j] == T) ? 1u : 0u; }
            const unsigned G = wg_sum(cg, cbuf, par, tid); par ^= 1;
            const unsigned E = (unsigned)TOPK - G;
            unsigned incl = ce;
#pragma unroll
            for (int o = 1; o < 64; o <<= 1) { const unsigned u = __shfl_up(incl, o); if (lane >= o) incl += u; }
            if (lane == 63) wtot[wave] = incl;
            __syncthreads();
            unsigned rank = incl - ce;
            for (int w = 0; w < wave; ++w) rank += wtot[w];
#pragma unroll
            for (int j = 0; j < 8; ++j) {
                if (k8[j] > T) bits |= 1u << j;
                else if (k8[j] == T) { if (rank < E) bits |= 1u << j; ++rank; }
            }
        }
        bytes[tid] = (unsigned char)bits;
        __syncthreads();
        if (tid < 128) MASK[(size_t)row * 128 + tid] = ((const LAS unsigned*)bytes)[tid];
        __syncthreads();
    }
}

template <bool DSA>
__device__ __forceinline__ void attn_item(const P& p, int item) {
    const int qc = item & 7, h = (item >> 3) & 7, b = item >> 6;
    const int t = qc * 512 + ltid();
    const size_t row = (size_t)b * L + t;
    const bf16_t* Q = DSA ? WSP(const bf16_t, WS_DQ) : WSP(const bf16_t, WS_FQ);
    const bf16_t* K = DSA ? WSP(const bf16_t, WS_DK) : WSP(const bf16_t, WS_FK);
    const bf16_t* V = DSA ? WSP(const bf16_t, WS_DV) : WSP(const bf16_t, WS_FV);
    bf16_t* O = DSA ? WSP(bf16_t, WS_OB) : WSP(bf16_t, WS_OA);
    const float* cum = WSP(const float, WS_CUM) + ((size_t)b * NH + h) * L;
    const unsigned* mrow = WSP(const unsigned, WS_MASK) + row * 128;
    float q[64], o[64];
    {
        const u32x4* qr = (const u32x4*)(Q + row * 512 + h * 64);
#pragma unroll
        for (int c = 0; c < 8; ++c) { const u32x4 v = qr[c];
            q[c * 8 + 0] = bf2f(v.x & 0xffffu); q[c * 8 + 1] = bf2f(v.x >> 16); q[c * 8 + 2] = bf2f(v.y & 0xffffu); q[c * 8 + 3] = bf2f(v.y >> 16);
            q[c * 8 + 4] = bf2f(v.z & 0xffffu); q[c * 8 + 5] = bf2f(v.z >> 16); q[c * 8 + 6] = bf2f(v.w & 0xffffu); q[c * 8 + 7] = bf2f(v.w >> 16); }
    }
#pragma unroll
    for (int d = 0; d < 64; ++d) o[d] = 0.f;
    float mx = -1e30f, l = 0.f;
    const float ct = DSA ? 0.f : cum[t] * LOG2E;
    const float slope2 = exp2f(-(float)(h + 1)) * LOG2E;
    const int tmax = __builtin_amdgcn_readfirstlane(t | 63);
    const bf16_t* Kh = K + (size_t)b * L * 512 + h * 64;
    const bf16_t* Vh = V + (size_t)b * L * 512 + h * 64;
    for (int s0 = 0; s0 <= tmax; s0 += 2) {
        float xv[2]; bool ok[2];
        const unsigned mb = DSA ? (mrow[s0 >> 5] >> (s0 & 31)) : 0x3u;
#pragma unroll
        for (int j = 0; j < 2; ++j) {
            const int s = s0 + j;
            const u32x4* kr = (const u32x4*)(Kh + (size_t)s * 512);
            float d0 = 0.f, d1 = 0.f;
#pragma unroll
            for (int c = 0; c < 8; ++c) { const u32x4 v = kr[c];
                d0 = fmaf(q[c * 8 + 0], bf2f(v.x & 0xffffu), d0); d1 = fmaf(q[c * 8 + 1], bf2f(v.x >> 16), d1);
                d0 = fmaf(q[c * 8 + 2], bf2f(v.y & 0xffffu), d0); d1 = fmaf(q[c * 8 + 3], bf2f(v.y >> 16), d1);
                d0 = fmaf(q[c * 8 + 4], bf2f(v.z & 0xffffu), d0); d1 = fmaf(q[c * 8 + 5], bf2f(v.z >> 16), d1);
                d0 = fmaf(q[c * 8 + 6], bf2f(v.w & 0xffffu), d0); d1 = fmaf(q[c * 8 + 7], bf2f(v.w >> 16), d1); }
            const float dot = d0 + d1;
            ok[j] = (s <= t) && ((mb >> j) & 1u);
            const float xx = DSA ? (dot - slope2 * (float)(t - s)) : (dot + (ct - cum[s] * LOG2E));
            xv[j] = ok[j] ? xx : -1e30f;
        }
        const float mnew = fmaxf(fmaxf(xv[0], xv[1]), mx);
        const float alpha = exp2f(mx - mnew);
        mx = mnew; l *= alpha;
#pragma unroll
        for (int d = 0; d < 64; ++d) o[d] *= alpha;
#pragma unroll
        for (int j = 0; j < 2; ++j) {
            const int s = s0 + j;
            const float pj = ok[j] ? exp2f(xv[j] - mnew) : 0.f;
            l += pj;
            const u32x4* vr = (const u32x4*)(Vh + (size_t)s * 512);
#pragma unroll
            for (int c = 0; c < 8; ++c) { const u32x4 v = vr[c];
                o[c * 8 + 0] = fmaf(pj, bf2f(v.x & 0xffffu), o[c * 8 + 0]); o[c * 8 + 1] = fmaf(pj, bf2f(v.x >> 16), o[c * 8 + 1]);
                o[c * 8 + 2] = fmaf(pj, bf2f(v.y & 0xffffu), o[c * 8 + 2]); o[c * 8 + 3] = fmaf(pj, bf2f(v.y >> 16), o[c * 8 + 3]);
                o[c * 8 + 4] = fmaf(pj, bf2f(v.z & 0xffffu), o[c * 8 + 4]); o[c * 8 + 5] = fmaf(pj, bf2f(v.z >> 16), o[c * 8 + 5]);
                o[c * 8 + 6] = fmaf(pj, bf2f(v.w & 0xffffu), o[c * 8 + 6]); o[c * 8 + 7] = fmaf(pj, bf2f(v.w >> 16), o[c * 8 + 7]); }
        }
    }
    const float rl = 1.f / l;
    u32x4* orow = (u32x4*)(O + row * 512 + h * 64);
#pragma unroll
    for (int c = 0; c < 8; ++c) { u32x4 w;
        w.x = f2bf(o[c * 8 + 0] * rl) | (f2bf(o[c * 8 + 1] * rl) << 16); w.y = f2bf(o[c * 8 + 2] * rl) | (f2bf(o[c * 8 + 3] * rl) << 16);
        w.z = f2bf(o[c * 8 + 4] * rl) | (f2bf(o[c * 8 + 5] * rl) << 16); w.w = f2bf(o[c * 8 + 6] * rl) | (f2bf(o[c * 8 + 7] * rl) << 16);
        orow[c] = w; }
}
__device__ __forceinline__ void attn_phase_naive(const P& p, int wg, int nwg) {
    for (int it = wg; it < 1024; it += nwg) {
        const int r = it >> 1; const int item = (r & ~7) | (7 - (r & 7));
        if (it & 1) attn_item<true>(p, item); else attn_item<false>(p, item);
    }
}

#include <hip/hip_bf16.h>
#include <cmath>
namespace attn_body {
using bf16=__hip_bfloat16;
using bf16x8=__attribute__((ext_vector_type(8)))short;
using s16x4=__attribute__((ext_vector_type(4)))short;
using f32x16=__attribute__((ext_vector_type(16)))float;
using u32x4=__attribute__((ext_vector_type(4)))unsigned;
typedef float f32x4_t __attribute__((ext_vector_type(4)));
constexpr int BATCH=8,NHEAD=8,SEQ=4096,D=64,DM=NHEAD*D;
constexpr int NW=8,QBLK=32,QB=QBLK*NW,KVBLK=64,NQB=SEQ/QB;
constexpr int ATTN_PITCH=DM, ATTN_UNIT_ROWS=QB;
__device__ __forceinline__ int crow(int r,int hi){return (r&3)+8*(r>>2)+4*hi;}
#define SBAR() __builtin_amdgcn_sched_barrier(0)
__device__ __forceinline__ void cmask(f32x16&p0,f32x16&p1,int jb,int qrel,int hi){
  const float NEG=-INFINITY; int kb=64*jb+4*hi;
  #pragma unroll
  for(int r=0;r<16;++r){int kv=kb+(r&3)+8*(r>>2); if(kv>qrel)p0[r]=NEG; if(kv+32>qrel)p1[r]=NEG;}
}

constexpr int NSLOT=3, SLOTB=8192;
constexpr int LDS_K=0, LDS_V=NSLOT*SLOTB, LDS_WS=2*NSLOT*SLOTB, LDS_OST=LDS_WS+NW*64*4, LDS_TAB=LDS_OST+NW*4096, LDS_BYTES=LDS_TAB+SEQ*4;
constexpr float C2=0.125f*1.4426950408889634f;
__device__ __forceinline__ void glds16(const void*gsrc,unsigned lds_dst){unsigned keep;
  asm volatile("s_mov_b32 %0, m0\n\ts_mov_b32 m0, %2\n\ts_nop 0\n\tglobal_load_lds_dwordx4 %1, off\n\ts_mov_b32 m0, %0":"=&s"(keep):"v"(gsrc),"s"(lds_dst):"memory");}
__device__ __forceinline__ float max3f(float a,float b,float c){float r;asm("v_max3_f32 %0, %1, %2, %3":"=v"(r):"v"(a),"v"(b),"v"(c));return r;}
__device__ __forceinline__ float max2f(float a,float b){float r;asm("v_max_f32_e32 %0, %1, %2":"=v"(r):"v"(a),"v"(b));return r;}
__device__ __forceinline__ float fadd_s(float a,float b){float r;asm("v_add_f32_e32 %0, %1, %2":"=v"(r):"v"(a),"v"(b));return r;}
__device__ __forceinline__ float fsub_s(float a,float b){float r;asm("v_sub_f32_e32 %0, %1, %2":"=v"(r):"v"(a),"v"(b));return r;}
typedef float f32x2_t __attribute__((ext_vector_type(2))); typedef __bf16 bf16x2_t __attribute__((ext_vector_type(2)));
__device__ __forceinline__ unsigned cvtpk_s(float lo,float hi){f32x2_t v={lo,hi};bf16x2_t b=__builtin_convertvector(v,bf16x2_t);return __builtin_bit_cast(unsigned,b);}
#define WAIT_BAR(N) asm volatile("s_waitcnt vmcnt(" #N ") lgkmcnt(0)\n\ts_barrier":::"memory")

__device__ __forceinline__ void qkt(f32x16&p0,f32x16&p1,const char*Kslot,const bf16x8*qr,const f32x16&negm,int r32,int hi){
  const char*kb=Kslot+hi*1024+r32*16;
  #pragma unroll
  for(int d0=0;d0<4;++d0){
    const bf16x8 b0=*reinterpret_cast<const bf16x8*>(kb+d0*2048);
    const bf16x8 b1=*reinterpret_cast<const bf16x8*>(kb+d0*2048+512);
    if(d0==0){p0=__builtin_amdgcn_mfma_f32_32x32x16_bf16(b0,qr[0],negm,0,0,0);p1=__builtin_amdgcn_mfma_f32_32x32x16_bf16(b1,qr[0],negm,0,0,0);}
    else{p0=__builtin_amdgcn_mfma_f32_32x32x16_bf16(b0,qr[d0],p0,0,0,0);p1=__builtin_amdgcn_mfma_f32_32x32x16_bf16(b1,qr[d0],p1,0,0,0);}}
}
typedef __attribute__((address_space(3))) const char* lds_cptr;
typedef short v4i16_t __attribute__((ext_vector_type(4)));
__device__ __forceinline__ void kload8(bf16x8*kf,lds_cptr kp){
  kf[0]=*(const __attribute__((address_space(3))) bf16x8*)(kp);      kf[1]=*(const __attribute__((address_space(3))) bf16x8*)(kp+512);
  kf[2]=*(const __attribute__((address_space(3))) bf16x8*)(kp+2048); kf[3]=*(const __attribute__((address_space(3))) bf16x8*)(kp+2560);
  kf[4]=*(const __attribute__((address_space(3))) bf16x8*)(kp+4096); kf[5]=*(const __attribute__((address_space(3))) bf16x8*)(kp+4608);
  kf[6]=*(const __attribute__((address_space(3))) bf16x8*)(kp+6144); kf[7]=*(const __attribute__((address_space(3))) bf16x8*)(kp+6656);
}
__device__ __forceinline__ void kload2(bf16x8*kf,lds_cptr kp,int j){ kf[2*j]=*(const __attribute__((address_space(3))) bf16x8*)(kp+j*2048); kf[2*j+1]=*(const __attribute__((address_space(3))) bf16x8*)(kp+j*2048+512); }
__device__ __forceinline__ s16x4 vtr(lds_cptr p){ return __builtin_bit_cast(s16x4,__builtin_amdgcn_ds_read_tr16_b64_v4i16((__attribute__((address_space(3))) v4i16_t*)p)); }
__device__ __forceinline__ float rowmax(const f32x16&p0,const f32x16&p1){
  float a=max3f(p0[0],p0[1],p1[0]),b=max3f(p0[2],p0[3],p1[1]);a=max3f(a,p1[2],p1[3]);
  #pragma unroll
  for(int r=4;r<16;r+=4){a=max3f(a,p0[r],p0[r+1]);b=max3f(b,p0[r+2],p0[r+3]);a=max3f(a,p1[r],p1[r+1]);b=max3f(b,p1[r+2],p1[r+3]);}
  const float m=max2f(a,b);
  auto rr=__builtin_amdgcn_permlane32_swap(__float_as_uint(m),__float_as_uint(m),false,false);
  return max2f(__uint_as_float(rr[0]),__uint_as_float(rr[1]));
}
__device__ __forceinline__ void pv(f32x16*o,int vb,bf16x8 pa0,bf16x8 pa1,bf16x8 pa2,bf16x8 pa3){
  #pragma unroll
  for(int d0=0;d0<2;++d0){s16x4 lo[4],hi[4];
    #pragma unroll
    for(int ks=0;ks<4;++ks){
      asm volatile("ds_read_b64_tr_b16 %0,%1 offset:%c2":"=&v"(lo[ks]):"v"(vb),"i"(d0*4096+ks*1024):"memory");
      asm volatile("ds_read_b64_tr_b16 %0,%1 offset:%c2":"=&v"(hi[ks]):"v"(vb),"i"(d0*4096+ks*1024+512):"memory");}
    asm volatile("s_waitcnt lgkmcnt(0)":::"memory");SBAR();
    #define PK(k) (bf16x8){lo[k][0],lo[k][1],lo[k][2],lo[k][3],hi[k][0],hi[k][1],hi[k][2],hi[k][3]}
    o[d0]=__builtin_amdgcn_mfma_f32_32x32x16_bf16(pa0,PK(0),o[d0],0,0,0);
    o[d0]=__builtin_amdgcn_mfma_f32_32x32x16_bf16(pa1,PK(1),o[d0],0,0,0);
    o[d0]=__builtin_amdgcn_mfma_f32_32x32x16_bf16(pa2,PK(2),o[d0],0,0,0);
    o[d0]=__builtin_amdgcn_mfma_f32_32x32x16_bf16(pa3,PK(3),o[d0],0,0,0);
    #undef PK
  }
}

#ifndef ATTN_STORE16
#define ATTN_STORE16(p,v) (*(u32x4*)(p)=(v))
#endif
template<int THRL,bool DSA> __device__ __forceinline__ void attn_unit(int b,int h,int qb,int jstart,const bf16*Q,const bf16*__restrict__ K,const bf16*__restrict__ V,bf16*O,const unsigned*__restrict__ MASK,char*shm){
  const int tid=ltid(),lane=tid&63,r32=lane&31,hi=lane>>5; const int wid=__builtin_amdgcn_readfirstlane(tid>>6);
  const long rowbase=(long)b*SEQ; const int q0=qb*QB;
  const bf16*Qw=Q+(rowbase+q0+wid*QBLK)*DM+h*D;
  const bf16*Kh=K+(rowbase+(long)jstart*KVBLK)*DM+h*D,*Vh=V+(rowbase+(long)jstart*KVBLK)*DM+h*D;
  const unsigned lds0=(unsigned)(uintptr_t)shm;
  float*wsf=(float*)(shm+LDS_WS)+wid*64;
  const bf16*ksrc=Kh+(long)lane*DM+wid*8;
  const bf16*vsrc=Vh+(long)(16*(wid&3)+(lane>>2))*DM+(wid>>2)*32+(lane&3)*8;
  const unsigned kdst=lds0+LDS_K+wid*1024, vdst=lds0+LDS_V+wid*1024;
  #define DMA_K(t,slot) glds16(ksrc+(long)(t)*KVBLK*DM,(unsigned)__builtin_amdgcn_readfirstlane(kdst+(slot)))
  #define DMA_V(t,slot) glds16(vsrc+(long)(t)*KVBLK*DM,(unsigned)__builtin_amdgcn_readfirstlane(vdst+(slot)))
  const int vb0=(int)(lds0+LDS_V)+((lane>>4)&1)*32+(lane&3)*8+(4*hi+((lane&15)>>2))*64;
  const char*Kbase=shm+LDS_K; bf16x8 kf[8];
  const lds_cptr shm3=(lds_cptr)shm; const lds_cptr kp0=shm3+LDS_K+hi*1024+r32*16; const lds_cptr vp0=shm3+LDS_V+((lane>>4)&1)*32+(lane&3)*8+(4*hi+((lane&15)>>2))*64;
  const int NT=(q0+QB)/KVBLK-jstart;
  DMA_K(0,0);DMA_V(0,0);DMA_K(1,SLOTB);
  bf16x8 qr[4];
  #pragma unroll
  for(int d0=0;d0<4;++d0)qr[d0]=*reinterpret_cast<const bf16x8*>(&Qw[(long)r32*DM+d0*16+hi*8]);
  float mhat=0.f,l_reg=0.f;f32x16 o[2];o[0]=f32x16{};o[1]=f32x16{};f32x16 negm=f32x16{};
  const int qrel=wid*QBLK+r32;
  const __attribute__((address_space(3))) float* tabp0=(const __attribute__((address_space(3))) float*)((lds_cptr)shm+LDS_TAB); const __attribute__((address_space(3))) float* tabp=tabp0+jstart*KVBLK;
  const unsigned moff=(unsigned)((((b*(SEQ/32)+((q0+qrel)>>5))*64+jstart)*32+((q0+qrel)&31))*8);
  unsigned long long mw=0ull;
  #define CMASK(P0,P1,t) do{ if(!DSA){int jb_=(t)-(NT-4); if(jb_>=0)cmask(P0,P1,jb_,qrel,hi);} }while(0)
  #define BIAS(P0,P1,t) do{ const __attribute__((address_space(3))) float* tb_=tabp+(t)*64+4*hi; \
    _Pragma("unroll") for(int g_=0;g_<4;++g_){ const f32x4_t a_=*(const __attribute__((address_space(3))) f32x4_t*)(tb_+8*g_), b_=*(const __attribute__((address_space(3))) f32x4_t*)(tb_+32+8*g_); \
      _Pragma("unroll") for(int e_=0;e_<4;++e_){ P0[4*g_+e_]-=a_[e_]; P1[4*g_+e_]-=b_[e_]; } } }while(0)
  #define MLOAD(t) do{ if(DSA) mw=*(const unsigned long long*)((const char*)MASK+(moff+(unsigned)(t)*256u)); }while(0)
  #define DMASK(P0,P1) do{ if(DSA){ const unsigned w0_=~((unsigned)mw>>(4*hi)), w1_=~((unsigned)(mw>>32)>>(4*hi)); \
    _Pragma("unroll") for(int r=0;r<16;++r){ const unsigned c_=(r&3)+8*(r>>2); \
      const float t0_=__uint_as_float(((unsigned)__builtin_amdgcn_sbfe((int)w0_,c_,1u)&0x80000000u)|0x7f800000u), t1_=__uint_as_float(((unsigned)__builtin_amdgcn_sbfe((int)w1_,c_,1u)&0x80000000u)|0x7f800000u); \
      P0[r]=__builtin_fminf(P0[r],t0_); P1[r]=__builtin_fminf(P1[r],t1_); } } }while(0)
  bool resc=false;
  #define START(P0,P1) do{ const float rm=__builtin_fmaxf(rowmax(P0,P1),-4000.f); resc=false; \
    { const float dl=rm; mhat=fadd_s(mhat,dl); \
      _Pragma("unroll") for(int r=0;r<16;++r){P0[r]=fsub_s(P0[r],dl);P1[r]=fsub_s(P1[r],dl);} \
      _Pragma("unroll") for(int r=0;r<16;++r)negm[r]=-mhat; asm volatile("":"+v"(negm)); } \
    _Pragma("unroll") for(int r=0;r<16;++r)P0[r]=__builtin_amdgcn_exp2f(P0[r]); }while(0)
  #define RESC() do{ if(resc){ asm volatile("s_waitcnt lgkmcnt(0)":::"memory"); \
      _Pragma("unroll") for(int d_=0;d_<2;++d_) _Pragma("unroll") for(int r=0;r<16;++r)o[d_][r]*=wsf[crow(r,hi)]; } }while(0)
  f32x16 pA0,pA1,pB0,pB1;
  int sl_prev=0,sl_cur=0,sl_next=SLOTB;
  #define ROT() do{sl_prev=sl_cur;sl_cur=sl_next;sl_next=(sl_next==(NSLOT-1)*SLOTB)?0:sl_next+SLOTB;}while(0)
  DMA_K(2,2*SLOTB);
  MLOAD(0);
  WAIT_BAR(3);
  { const float tq=tabp0[q0+qrel]; mhat=-tq; _Pragma("unroll") for(int r=0;r<16;++r)negm[r]=tq; asm volatile("":"+v"(negm)); }
  qkt(pA0,pA1,Kbase,qr,negm,r32,hi);asm volatile("s_nop 15\n\ts_nop 7":"+v"(pA0),"+v"(pA1));BIAS(pA0,pA1,0);DMASK(pA0,pA1);CMASK(pA0,pA1,0);
  START(pA0,pA1);
  _Pragma("unroll") for(int r=0;r<16;++r)pA1[r]=__builtin_amdgcn_exp2f(pA1[r]);
  WAIT_BAR(0);
  DMA_K(3,0);DMA_V(1,SLOTB);
  MLOAD(1);
  ROT();
  kload8(kf,kp0+sl_cur);
  #define WB2() do{ if(DSA){WAIT_BAR(3);} else {WAIT_BAR(2);} }while(0)
  WB2();
  s16x4 vlo[8],vhi[8]; u32x4 pw0,pw1,pw2,pw3;
  #define PKW(P,B) cvtpk_s(P[B],P[B+1])
  #define PAF(k) __builtin_bit_cast(bf16x8,pw##k)
  #define VFR(i) (bf16x8){vlo[i][0],vlo[i][1],vlo[i][2],vlo[i][3],vhi[i][0],vhi[i][1],vhi[i][2],vhi[i][3]}
  #define PIN(x) asm volatile("":"+v"(x))
  #define MX3(a,b,c) __builtin_fmaxf(__builtin_fmaxf((a),(b)),(c))
  #define GAPA(MF,A0,A1,A2,A3,W0,W1,PW) do{ MF; sacc+=A0; sacc+=A1; sacc+=A2; sacc+=A3; PIN(sacc); W0; W1; PIN(PW); SBAR(); }while(0)
  #define EX(v) __builtin_amdgcn_exp2f(v)
  #define GAPB(MF,X,B) do{ MF; X[B]=EX(X[B]); X[B+1]=EX(X[B+1]); X[B+2]=EX(X[B+2]); X[B+3]=EX(X[B+3]); PIN(X); SBAR(); }while(0)
  #define VRD(i) do{ vlo[i]=vtr(vp_+(((i)>>2)*4096+((i)&3)*1024)); vhi[i]=vtr(vp_+(((i)>>2)*4096+((i)&3)*1024+512)); }while(0)
  #define KRD(G,j) do{ if(G){ kload2(kf,kp0+sl_next,j); SBAR(); } }while(0)
  #define STEP(C0,C1,P0,P1,t,GK,GV,GL) do{ SBAR(); \
    const lds_cptr vp_=vp0+sl_prev; \
    VRD(0); SBAR(); float sacc=(P0[0]+P0[1]); \
    GAPA(C0=__builtin_amdgcn_mfma_f32_32x32x16_bf16(kf[0],qr[0],negm,0,0,0), P0[2],P0[3],P0[4],P0[5],     pw0[0]=PKW(P0,0), pw0[1]=PKW(P0,2), pw0); \
    VRD(4); SBAR(); GAPA(C1=__builtin_amdgcn_mfma_f32_32x32x16_bf16(kf[1],qr[0],negm,0,0,0), P0[6],P0[7],P0[8],P0[9],     pw0[2]=PKW(P0,4), pw0[3]=PKW(P0,6), pw0); \
    VRD(1); SBAR(); GAPA(C0=__builtin_amdgcn_mfma_f32_32x32x16_bf16(kf[2],qr[1],C0,0,0,0),   P0[10],P0[11],P0[12],P0[13], pw1[0]=PKW(P0,8), pw1[1]=PKW(P0,10), pw1); \
    VRD(5); SBAR(); GAPA(C1=__builtin_amdgcn_mfma_f32_32x32x16_bf16(kf[3],qr[1],C1,0,0,0),   P0[14],P0[15],P1[0],P1[1],   pw1[2]=PKW(P0,12),pw1[3]=PKW(P0,14), pw1); \
    VRD(2); SBAR(); GAPA(C0=__builtin_amdgcn_mfma_f32_32x32x16_bf16(kf[4],qr[2],C0,0,0,0),   P1[2],P1[3],P1[4],P1[5],     pw2[0]=PKW(P1,0), pw2[1]=PKW(P1,2), pw2); \
    VRD(6); SBAR(); GAPA(C1=__builtin_amdgcn_mfma_f32_32x32x16_bf16(kf[5],qr[2],C1,0,0,0),   P1[6],P1[7],P1[8],P1[9],     pw2[2]=PKW(P1,4), pw2[3]=PKW(P1,6), pw2); \
    VRD(3); SBAR(); GAPA(C0=__builtin_amdgcn_mfma_f32_32x32x16_bf16(kf[6],qr[3],C0,0,0,0),   P1[10],P1[11],P1[12],P1[13], pw3[0]=PKW(P1,8), pw3[1]=PKW(P1,10), pw3); \
    VRD(7); SBAR(); GAPA(C1=__builtin_amdgcn_mfma_f32_32x32x16_bf16(kf[7],qr[3],C1,0,0,0),   P1[14],P1[15],0.f,0.f,       pw3[2]=PKW(P1,12),pw3[3]=PKW(P1,14), pw3); \
    l_reg+=sacc; \
    BIAS(C0,C1,t); DMASK(C0,C1); \
    if(GK){DMA_K((t)+3,sl_cur);} if(GV){DMA_V((t)+1,sl_next); MLOAD((t)+1);} \
    CMASK(C0,C1,t); \
    { float a=MX3(C0[0],C0[1],C1[0]),b=MX3(C0[2],C0[3],C1[1]); a=MX3(a,C1[2],C1[3]); \
      _Pragma("unroll") for(int r=4;r<16;r+=4){a=MX3(a,C0[r],C0[r+1]);b=MX3(b,C0[r+2],C0[r+3]);a=MX3(a,C1[r],C1[r+1]);b=MX3(b,C1[r+2],C1[r+3]);} \
      float rm=__builtin_fmaxf(a,b); { auto rr=__builtin_amdgcn_permlane32_swap(__float_as_uint(rm),__float_as_uint(rm),false,false); rm=__builtin_fmaxf(__uint_as_float(rr[0]),__uint_as_float(rr[1])); } \
      resc=false; \
      if(__builtin_expect(__any(rm>(float)THRL),0)){ const float dl=__builtin_fmaxf(rm,0.f); mhat+=dl; \
        _Pragma("unroll") for(int r=0;r<16;++r){C0[r]-=dl;C1[r]-=dl;} \
        _Pragma("unroll") for(int r=0;r<16;++r)negm[r]=-mhat; asm volatile("":"+v"(negm)); \
        const float f=__builtin_amdgcn_exp2f(-dl); l_reg*=f; if(hi==0)wsf[r32]=f; resc=true; } } \
    SBAR(); \
    GAPB(o[0]=__builtin_amdgcn_mfma_f32_32x32x16_bf16(PAF(0),VFR(0),o[0],0,0,0), C0,0); \
    GAPB(o[1]=__builtin_amdgcn_mfma_f32_32x32x16_bf16(PAF(0),VFR(4),o[1],0,0,0), C0,4); \
    KRD(GL,0); GAPB(o[0]=__builtin_amdgcn_mfma_f32_32x32x16_bf16(PAF(1),VFR(1),o[0],0,0,0), C0,8); \
    KRD(GL,1); GAPB(o[1]=__builtin_amdgcn_mfma_f32_32x32x16_bf16(PAF(1),VFR(5),o[1],0,0,0), C0,12); \
    KRD(GL,2); GAPB(o[0]=__builtin_amdgcn_mfma_f32_32x32x16_bf16(PAF(2),VFR(2),o[0],0,0,0), C1,0); \
    KRD(GL,3); GAPB(o[1]=__builtin_amdgcn_mfma_f32_32x32x16_bf16(PAF(2),VFR(6),o[1],0,0,0), C1,4); \
    GAPB(o[0]=__builtin_amdgcn_mfma_f32_32x32x16_bf16(PAF(3),VFR(3),o[0],0,0,0), C1,8); \
    GAPB(o[1]=__builtin_amdgcn_mfma_f32_32x32x16_bf16(PAF(3),VFR(7),o[1],0,0,0), C1,12); \
    }while(0)
  int t=1;
  #undef CMASK
  #define CMASK(P0,P1,t) do{}while(0)
  for(;t+5<NT;t+=2){
    STEP(pB0,pB1,pA0,pA1,t,true,true,true);     WB2(); RESC(); ROT();
    STEP(pA0,pA1,pB0,pB1,t+1,true,true,true);   WB2(); RESC(); ROT();
  }
  #undef CMASK
  #define CMASK(P0,P1,t) do{ if(!DSA){int jb_=(t)-(NT-4); if(jb_>=0)cmask(P0,P1,jb_,qrel,hi);} }while(0)
  #define ENDW(tt) do{ if((tt)+3<NT){WB2();} else if((tt)+2<NT){ if(DSA){WAIT_BAR(2);} else {WAIT_BAR(1);} } else { if(DSA){WAIT_BAR(1);} else {WAIT_BAR(0);} } }while(0)
  for(;t+1<NT;t+=2){
    STEP(pB0,pB1,pA0,pA1,t,(t+3<NT),(t+1<NT),(t+1<NT));       ENDW(t);   RESC(); ROT();
    STEP(pA0,pA1,pB0,pB1,t+1,(t+4<NT),(t+2<NT),(t+2<NT));     ENDW(t+1); RESC(); ROT();
  }
  STEP(pB0,pB1,pA0,pA1,NT-1,false,false,false); RESC();
  { float sacc=pB0[0]+pB0[1]; _Pragma("unroll") for(int r=2;r<16;++r)sacc+=pB0[r]; _Pragma("unroll") for(int r=0;r<16;++r)sacc+=pB1[r]; l_reg+=sacc;
    pw0=(u32x4){PKW(pB0,0),PKW(pB0,2),PKW(pB0,4),PKW(pB0,6)};pw1=(u32x4){PKW(pB0,8),PKW(pB0,10),PKW(pB0,12),PKW(pB0,14)};pw2=(u32x4){PKW(pB1,0),PKW(pB1,2),PKW(pB1,4),PKW(pB1,6)};pw3=(u32x4){PKW(pB1,8),PKW(pB1,10),PKW(pB1,12),PKW(pB1,14)};
    SBAR(); pv(o,vb0+sl_cur,PAF(0),PAF(1),PAF(2),PAF(3)); }
  #undef PKW
  #undef PAF
  #undef VFR
  #undef PIN
  #undef MX3
  #undef GAPA
  #undef GAPB
  #undef EX
  #undef VRD
  #undef KRD
  #undef STEP
  #undef ENDW
  #undef WB2
  {auto rr=__builtin_amdgcn_permlane32_swap(__float_as_uint(l_reg),__float_as_uint(l_reg),false,false);l_reg=__uint_as_float(rr[0])+__uint_as_float(rr[1]);}
  if(hi==0)wsf[32+r32]=l_reg;asm volatile("s_waitcnt lgkmcnt(0)":::"memory");
  float rli[16];
  #pragma unroll
  for(int r=0;r<16;++r)rli[r]=__builtin_amdgcn_rcpf(wsf[32+crow(r,hi)]);
  bf16*Ow=O+(rowbase+q0+wid*QBLK)*DM+h*D;
  { bf16*stg=(bf16*)(shm+LDS_OST)+wid*2048;
    #pragma unroll
    for(int r=0;r<16;++r){const int orow=crow(r,hi);
      #pragma unroll
      for(int d0=0;d0<2;++d0)stg[orow*64+d0*32+r32]=__float2bfloat16(o[d0][r]*rli[r]);}
    asm volatile("s_waitcnt lgkmcnt(0)":::"memory");
    #pragma unroll
    for(int i=0;i<4;++i){const int row=i*8+(lane>>3),ch=lane&7; const u32x4 v=*(const u32x4*)(stg+row*64+ch*8);
      const float SC=16.f; typedef unsigned u32x2v __attribute__((ext_vector_type(2))); u32x2v w;
      w.x=pk4_fp8(__uint_as_float(v.x<<16)*SC,__uint_as_float(v.x&0xffff0000u)*SC,__uint_as_float(v.y<<16)*SC,__uint_as_float(v.y&0xffff0000u)*SC);
      w.y=pk4_fp8(__uint_as_float(v.z<<16)*SC,__uint_as_float(v.z&0xffff0000u)*SC,__uint_as_float(v.w<<16)*SC,__uint_as_float(v.w&0xffff0000u)*SC);
      *(u32x2v*)((unsigned char*)O+((rowbase+q0+wid*QBLK+row)*DM+h*D+ch*8))=w;} }
  asm volatile("s_waitcnt lgkmcnt(0)\n\ts_barrier":::"memory");
  #undef DMA_K
  #undef DMA_V
  #undef CMASK
  #undef BIAS
  #undef MLOAD
  #undef DMASK
  #undef START
  #undef RESC
  #undef ROT
}
constexpr int ATTN_LDS_BYTES=LDS_BYTES;
struct AttnTensors { const bf16 *FQ,*FK,*FV,*DQ,*DK,*DV; bf16 *OA,*OB; const float* CUM; const unsigned* MASK;
  unsigned* qhead; const unsigned* kmax2; const float* qmax2; const unsigned* blk; };
template<bool DSA> __device__ __forceinline__ void fill_tab(int b,int h,const float*CUM,char*shm){
  __attribute__((address_space(3))) float* tab=(__attribute__((address_space(3))) float*)((lds_cptr)shm+LDS_TAB);
  const int tid=ltid(); const float L2E=1.4426950408889634f;
  if(DSA){ const float sl=__builtin_amdgcn_exp2f(-(float)(h+1))*L2E;
    #pragma unroll
    for(int j=0;j<8;++j){ const int s_=tid*8+j; tab[s_]=-sl*(float)s_; } }
  else { const f32x4_t* c=(const f32x4_t*)(CUM+((size_t)b*NHEAD+h)*SEQ)+tid*2; const f32x4_t a=c[0],d=c[1];
    *(__attribute__((address_space(3))) f32x4_t*)(tab+tid*8)=a*L2E; *(__attribute__((address_space(3))) f32x4_t*)(tab+tid*8+4)=d*L2E; }
  asm volatile("s_waitcnt vmcnt(0) lgkmcnt(0)\n\ts_barrier":::"memory");
}
template<int THRL=8,class MK> __device__ __forceinline__ void attn_phase(char*lds,unsigned char*ws_,const MK&mk,volatile __attribute__((address_space(3))) unsigned* slot){
  const float CUT=64.f;
  for(;;){
    unsigned char* wsl; { size_t z=0; asm volatile("":"+s"(z)); wsl=ws_+z; }
    const AttnTensors T=mk(wsl);
    if(ltid()==0) slot[0]=__hip_atomic_fetch_add(T.qhead,1u,__ATOMIC_RELAXED,__HIP_MEMORY_SCOPE_AGENT);
    asm volatile("s_waitcnt vmcnt(0) lgkmcnt(0)\n\ts_barrier":::"memory");
    const unsigned u=slot[0];
    if(u>=2u*BATCH*NHEAD*NQB) break;
    const int qb=NQB-1-(int)(u>>7), r=(int)(u&127u), mixer=r>>6, bh=r&63, b=bh>>3, h=bh&7, q0=qb*QB, NTfull=(q0+QB)/KVBLK;
    const float qk=__builtin_sqrtf(T.qmax2[(mixer*64+bh)*NQB+qb]*__uint_as_float(T.kmax2[mixer*64+bh]));
    const float bound=2.f*qk+1.f+CUT;
    const __attribute__((address_space(3))) float* tab=(const __attribute__((address_space(3))) float*)((lds_cptr)lds+LDS_TAB);
    int jstart=0;
    if(mixer==0){
      fill_tab<false>(b,h,T.CUM,lds);
      const int lane=ltid()&63; const int sk=64*lane+63;
      const bool skip=(lane<NTfull)&&(tab[q0]-tab[sk<SEQ?sk:SEQ-1]+bound<0.f)&&(bound==bound);
      const unsigned long long m=__ballot(skip);
      jstart=(~m==0ull)?64:__builtin_ctzll(~m);
    } else {
      fill_tab<true>(b,h,T.CUM,lds);
      const float sl=__builtin_amdgcn_exp2f(-(float)(h+1))*1.4426950408889634f;
      const int smin=SEQ-1-(int)T.blk[b*NQB+qb];
      const float f=((float)smin-bound/sl)*(1.f/64.f);
      jstart=(f>0.f&&bound==bound)?(int)f:0;
    }
    jstart=__builtin_amdgcn_readfirstlane(jstart)&~1; if(jstart>NTfull-4) jstart=NTfull-4; if(jstart<0) jstart=0;
    if(mixer==0) attn_unit<THRL,false>(b,h,qb,jstart,T.FQ,T.FK,T.FV,T.OA,T.MASK,lds);
    else         attn_unit<THRL,true >(b,h,qb,jstart,T.DQ,T.DK,T.DV,T.OB,T.MASK,lds);
  }
}
#undef SBAR
#undef WAIT_BAR
}

namespace idx_body {
using bf16x8=__attribute__((ext_vector_type(8)))short;
using f32x16=__attribute__((ext_vector_type(16)))float;
typedef float f32x4_t __attribute__((ext_vector_type(4)));
typedef unsigned u32x4_t __attribute__((ext_vector_type(4)));
typedef unsigned short u16x2_t __attribute__((ext_vector_type(2)));
#define ILAS __attribute__((address_space(3)))
constexpr int SEQ=4096, TOPK=256;
constexpr int LDS_SH=0, LDS_SL=65536, LDS_BYTES=131072;
__device__ __forceinline__ float relu_f(float x){ const int b=__builtin_bit_cast(int,x); return __builtin_bit_cast(float,b>0?b:0); }
__device__ __forceinline__ unsigned skey(float f){ const unsigned u=__float_as_uint(f+0.f); return (u&0x80000000u)?~u:(u|0x80000000u); }
__device__ __forceinline__ int wave_sum(int v){
  v+=__builtin_amdgcn_update_dpp(0,v,0xB1,0xF,0xF,true);
  v+=__builtin_amdgcn_update_dpp(0,v,0x4E,0xF,0xF,true);
  v+=__builtin_amdgcn_update_dpp(0,v,0x141,0xF,0xF,true);
  v+=__builtin_amdgcn_update_dpp(0,v,0x140,0xF,0xF,true);
  v+=__builtin_amdgcn_update_dpp(0,v,0x142,0xA,0xF,false);
  v+=__builtin_amdgcn_update_dpp(0,v,0x143,0xC,0xF,false);
  return __builtin_amdgcn_readlane(v,63);
}
__device__ __forceinline__ int wave_max(int v){
  v=max(v,__builtin_amdgcn_update_dpp(v,v,0xB1,0xF,0xF,false)); v=max(v,__builtin_amdgcn_update_dpp(v,v,0x4E,0xF,0xF,false));
  v=max(v,__builtin_amdgcn_update_dpp(v,v,0x141,0xF,0xF,false)); v=max(v,__builtin_amdgcn_update_dpp(v,v,0x140,0xF,0xF,false));
  v=max(v,__builtin_amdgcn_update_dpp(v,v,0x142,0xA,0xF,false)); v=max(v,__builtin_amdgcn_update_dpp(v,v,0x143,0xC,0xF,false));
  return __builtin_amdgcn_readlane(v,63);
}
__device__ __forceinline__ unsigned pk_count(unsigned acc,unsigned x,unsigned cm1r,unsigned one2){
  unsigned tmp;
  asm("v_pk_sub_u16 %1, %2, %3 clamp\n\tv_pk_min_u16 %1, %1, %4\n\tv_pk_add_u16 %0, %0, %1":"+v"(acc),"=&v"(tmp):"v"(x),"v"(cm1r),"v"(one2));
  return acc;
}
struct AW { bf16x8 a[2][4]; f32x4_t w[2][4]; };
__device__ __forceinline__ void load_a(AW&x,const unsigned short*__restrict__ IQ,size_t rowb,int kl,int hh){
  asm volatile("":"+v"(kl),"+v"(hh));
  const int g=kl>>3, hr=(kl>>2)&1, e=kl&3, aq=2*hr+(g>>1), ahead=4*(g&1)+e;
  #pragma unroll
  for(int at=0;at<2;++at){
    const unsigned short* ap=IQ+(rowb+4*at+aq)*512+ahead*64+8*hh;
    #pragma unroll
    for(int ks=0;ks<4;++ks) x.a[at][ks]=__builtin_bit_cast(bf16x8,*(const u32x4_t*)(ap+16*ks));
  }
}
__device__ __forceinline__ void load_w(AW&x,const float*__restrict__ IW,size_t rowb,int hh,float idx_scale){
  asm volatile("":"+v"(hh));
  #pragma unroll
  for(int at=0;at<2;++at){
    const f32x4_t* wp=(const f32x4_t*)(IW+(rowb+4*at+2*hh)*8);
    #pragma unroll
    for(int k=0;k<4;++k) x.w[at][k]=wp[k]*idx_scale;
  }
}
__device__ __forceinline__ void hu_coords(int v,int hu,int&b,int&tb){ b=v>>5; const int r=v&31, i=hu>>1, p=r+32*(i>>1), qi=(i&1)?255-p:p; tb=qi*16+8*(hu&1); }
__device__ __forceinline__ void idx_phase_fast(ILAS unsigned char*lds,const unsigned short*__restrict__ IQ,const unsigned short*__restrict__ IK,const float*__restrict__ IW,unsigned*__restrict__ MASK,unsigned*__restrict__ BLK,float idx_scale,int vcu,int ncu){
  const int tid=ltid(),lane=tid&63,kl=lane&31,hh=lane>>5; const int wave=__builtin_amdgcn_readfirstlane(tid>>6);
  for(int v=vcu;v<256;v+=ncu){
    int b,tb; hu_coords(v,0,b,tb);
    AW cur; load_a(cur,IQ,(size_t)b*SEQ+tb,kl,hh); load_w(cur,IW,(size_t)b*SEQ+tb,hh,idx_scale);
    bf16x8 b0[4],b1[4],b2[4];
    #define LDBX(dst,kt_,nkt_,bb_) do{ const int ktc_=(kt_)<(nkt_)?(kt_):(nkt_)-1; int kl_=kl,hh_=hh; asm volatile("":"+v"(kl_),"+v"(hh_)); const u32x4_t* kp_=(const u32x4_t*)(IK+((size_t)(bb_)*SEQ+kl_)*64+8*hh_+(size_t)ktc_*2048); \
      _Pragma("unroll") for(int ks=0;ks<4;++ks) dst[ks]=__builtin_bit_cast(bf16x8,kp_[2*ks]); }while(0)
    #pragma unroll 1
    for(int hu=0;hu<16;++hu){
      hu_coords(v,hu,b,tb);
      const size_t rowb=(size_t)b*SEQ+tb;
      const int nkt=(tb+8+31)>>5;
      const int tqb=tb+2*hh;
      #define LDB(dst,kt_) LDBX(dst,kt_,nkt,b)
      #define SCORE(bb,kt_) do{ const int s=32*(kt_)+kl; const int sidx=((s>>7)<<6)+(s&63), sh=(s>>6)&1; \
        _Pragma("unroll") for(int at=0;at<2;++at){ \
          f32x16 c=f32x16{}; \
          _Pragma("unroll") for(int ks=0;ks<4;++ks) c=__builtin_amdgcn_mfma_f32_32x32x16_bf16(cur.a[at][ks],bb[ks],c,0,0,0); \
          float s0=0.f,s1=0.f; \
          _Pragma("unroll") for(int q=0;q<4;++q){ s0=__builtin_fmaf(cur.w[at][0][q],relu_f(c[q]),s0); s0=__builtin_fmaf(cur.w[at][1][q],relu_f(c[4+q]),s0); \
                                s1=__builtin_fmaf(cur.w[at][2][q],relu_f(c[8+q]),s1); s1=__builtin_fmaf(cur.w[at][3][q],relu_f(c[12+q]),s1); } \
          const int tq=tqb+4*at; \
          const unsigned k0=(s<=tq)?skey(s0):0u, k1=(s<=tq+1)?skey(s1):0u; \
          ILAS unsigned short* ph=(ILAS unsigned short*)(lds+LDS_SH)+((4*at+2*hh)*2048+sidx)*2+sh; \
          ILAS unsigned short* pl=(ILAS unsigned short*)(lds+LDS_SL)+((4*at+2*hh)*2048+sidx)*2+sh; \
          ph[0]=(unsigned short)(k0>>16); pl[0]=(unsigned short)k0; ph[4096]=(unsigned short)(k1>>16); pl[4096]=(unsigned short)k1; } }while(0)
      {
        LDB(b0,wave); LDB(b1,wave+8);
        int kt=wave;
        #pragma unroll 1
        for(;kt<nkt;kt+=24){
          LDB(b2,kt+16); SCORE(b0,kt); __builtin_amdgcn_sched_barrier(0);
          if(kt+8<nkt){ LDB(b0,kt+24); SCORE(b1,kt+8); } __builtin_amdgcn_sched_barrier(0);
          if(kt+16<nkt){ LDB(b1,kt+32); SCORE(b2,kt+16); } __builtin_amdgcn_sched_barrier(0);
        }
      }
      #undef LDB
      #undef SCORE
      int nb=b,ntb=tb; if(hu+1<16){ hu_coords(v,hu+1,nb,ntb); load_a(cur,IQ,(size_t)nb*SEQ+ntb,kl,hh); }
      asm volatile("s_waitcnt lgkmcnt(0)\n\ts_barrier":::"memory");
#ifndef IDX_REP_B
#define IDX_REP_B 1
#endif
      _Pragma("unroll 1") for(int repB=0;repB<IDX_REP_B;++repB)
      {
        const int t=tb+wave; const int ngrp=(t>>10)+1;
        const ILAS unsigned* SHq=(const ILAS unsigned*)(lds+LDS_SH)+wave*2048+lane; const ILAS unsigned* SLq=(const ILAS unsigned*)(lds+LDS_SL)+wave*2048+lane;
        unsigned kh[32],kw[32];
        #pragma unroll
        for(int gI=0;gI<4;++gI){
          if(gI<ngrp){
            #pragma unroll
            for(int i=8*gI;i<8*gI+8;++i){ kh[i]=SHq[64*i]; kw[i]=SLq[64*i]; }
          } else {
            #pragma unroll
            for(int i=8*gI;i<8*gI+8;++i){ kh[i]=0u; kw[i]=0u; }
          }
        }
        #pragma unroll
        for(int gI=0;gI<4;++gI){ if(gI==ngrp-1){
          #pragma unroll
          for(int i=8*gI;i<8*gI+8;++i){ const unsigned m=((128*i+lane<=t)?0xffffu:0u)|((128*i+64+lane<=t)?0xffff0000u:0u); kh[i]&=m; kw[i]&=m; } } }
        unsigned T=1u; int X=0;
        unsigned one2=0x00010001u; asm volatile("":"+v"(one2));
        if(t>=TOPK){
          unsigned Thi=0u; int cntHi=0, G1=0; bool done=false;
          for(int bb=14;bb>=0;bb-=2){
            const unsigned c1=Thi|(1u<<bb), c2=Thi|(2u<<bb), c3=Thi|(3u<<bb);
            const unsigned m1=(c1-1u)*0x10001u, m2=(c2-1u)*0x10001u, m3=(c3-1u)*0x10001u;
            unsigned a1[2]={0u,0u},a2[2]={0u,0u},a3[2]={0u,0u};
            #pragma unroll
            for(int gI=0;gI<4;++gI){ if(gI<ngrp){
              #pragma unroll
              for(int i=8*gI;i<8*gI+8;++i){ a1[i&1]=pk_count(a1[i&1],kh[i],m1,one2); a2[i&1]=pk_count(a2[i&1],kh[i],m2,one2); a3[i&1]=pk_count(a3[i&1],kh[i],m3,one2); } } }
            const unsigned s1=a1[0]+a1[1], s2=a2[0]+a2[1], s3=a3[0]+a3[1];
            const int n12=wave_sum((int)(((s1&0xffffu)+(s1>>16))|(((s2&0xffffu)+(s2>>16))<<16)));
            const int n3=wave_sum((int)((s3&0xffffu)+(s3>>16)));
            const int n1=n12&0xffff, n2=(int)((unsigned)n12>>16);
            int nj;
            if(n3>=TOPK){ Thi=c3; nj=n3; } else if(n2>=TOPK){ Thi=c2; nj=n2; G1=n3; } else if(n1>=TOPK){ Thi=c1; nj=n1; G1=n2; } else { nj=0; G1=n1; }
            if(nj>0){ cntHi=nj; if(nj==TOPK){ done=true; break; } }
          }
          T=Thi<<16; X=0;
          if(!done){
            { const unsigned thr=Thi*0x10001u; const u16x2_t one={1,1}, ffff={0xffff,0xffff};
              #pragma unroll
              for(int gI=0;gI<4;++gI){ if(gI<ngrp){
                #pragma unroll
                for(int i=8*gI;i<8*gI+8;++i){ u16x2_t x=__builtin_bit_cast(u16x2_t,kh[i]^thr); x=__builtin_elementwise_min(x,one); x=(one-x)*ffff; kw[i]&=__builtin_bit_cast(unsigned,x); } } } }
            unsigned Tlo=0u; int cntT=cntHi;
            for(int bit=15;bit>=0;--bit){
              const unsigned cand=Tlo|(1u<<bit), cm1r=(cand-1u)*0x10001u; unsigned ac[4]={0u,0u,0u,0u};
              #pragma unroll
              for(int gI=0;gI<4;++gI){ if(gI<ngrp){
                #pragma unroll
                for(int i=8*gI;i<8*gI+8;++i) ac[i&3]=pk_count(ac[i&3],kw[i],cm1r,one2); } }
              const unsigned acc=(ac[0]+ac[1])+(ac[2]+ac[3]);
              const int cnt=G1+wave_sum((int)((acc&0xffffu)+(acc>>16)));
              if(cnt>=TOPK){ Tlo=cand; cntT=cnt; if(cnt==TOPK) break; }
            }
            T=(Thi<<16)|Tlo; X=cntT-TOPK;
          }
        }
        unsigned long long mine=0ull;
        #pragma unroll
        for(int gI=3;gI>=0;--gI){ if(gI<ngrp){
          #pragma unroll
          for(int i=8*gI+7;i>=8*gI;--i){
            const unsigned keyA=(kh[i]<<16)|(kw[i]&0xffffu), keyB=(kh[i]&0xffff0000u)|(kw[i]>>16);
            unsigned long long balB=__ballot(keyB>=T), balA=__ballot(keyA>=T);
            if(X>0){ unsigned long long eq=__ballot(keyB==T);
              while(X>0&&eq!=0ull){ const int hb=63-__builtin_clzll(eq); balB&=~(1ull<<hb); eq&=~(1ull<<hb); --X; }
              eq=__ballot(keyA==T);
              while(X>0&&eq!=0ull){ const int hb=63-__builtin_clzll(eq); balA&=~(1ull<<hb); eq&=~(1ull<<hb); --X; } }
            if(lane==2*i) mine=balA;
            if(lane==2*i+1) mine=balB;
          } } }
        { int ln_=lane; asm volatile("":"+v"(ln_)); const unsigned off_=(unsigned)((((b*128+(t>>5))*64+ln_)*32+(t&31))*8); *(unsigned long long*)((char*)MASK+off_)=mine; }
        if(hu+1<16) load_w(cur,IW,(size_t)nb*SEQ+ntb,hh,idx_scale);
        { const int smax=wave_max(mine!=0ull?64*lane+63-__builtin_clzll(mine):-1);
          if(lane==0) __hip_atomic_fetch_max(BLK+b*16+(t>>8),(unsigned)(SEQ-1-smax),__ATOMIC_RELAXED,__HIP_MEMORY_SCOPE_AGENT); }
      }
      asm volatile("s_waitcnt lgkmcnt(0)\n\ts_barrier":::"memory");
    }
  }
}
#undef ILAS
}

struct MapIdent { __device__ __forceinline__ int operator()(int j) const { return j; } };
struct MapWin {
    __device__ __forceinline__ int operator()(int j) const {
        if (j < 1536) return j;
        if (j < 3072) return 1544 + (j - 1536);
        if (j < 3584) return 3080 + (j - 3072);
        if (j < 3648) return 3592 + (j - 3584);
        if (j < 3656) return 1536 + (j - 3648);
        if (j < 3664) return 3656 + (j - 3656);
        if (j < 3840) return -1;
        return 3664 + (j - 3840);
    }
};
struct MapF1 { __device__ __forceinline__ int operator()(int j) const { const int pn = j >> 8, i = j & 255; return i < 128 ? 128 * pn + i : DFF + 128 * pn + (i - 128); } };
template <class Map, bool F8 = false>
__device__ __forceinline__ void wt_item(const float* W, int K, int ldw, bf16_t* WT, int nblk, int item, LAS float* scr, int lane, const Map& map, float f8s = F8_WSCALE, int rowsub = 0) {
    const int kb = item / nblk, nb = item % nblk, k0 = 64 * kb, n0 = 32 * nb;
    const int src = map(n0 + (lane & 31));
#pragma unroll 8
    for (int i = 0; i < 32; ++i) { const int kk = 2 * i + (lane >> 5); scr[kk * 33 + (lane & 31)] = src >= 0 ? W[(size_t)(k0 + kk) * ldw + src] : 0.f; }
    asm volatile("s_waitcnt lgkmcnt(0)" ::: "memory");
    const int c = lane & 7;
#pragma unroll
    for (int j = 0; j < 4; ++j) { const int n = (lane >> 3) + 8 * j; const LAS float* sp = scr + (8 * c) * 33 + n;
        if constexpr (F8) { u32x2 o; o.x = pk4_fp8(sp[0 * 33] * f8s, sp[1 * 33] * f8s, sp[2 * 33] * f8s, sp[3 * 33] * f8s); o.y = pk4_fp8(sp[4 * 33] * f8s, sp[5 * 33] * f8s, sp[6 * 33] * f8s, sp[7 * 33] * f8s);
            *(u32x2*)((unsigned char*)WT + (size_t)(n0 + n - rowsub) * K + k0 + 8 * c) = o; }
        else { u32x4 o; o.x = f2bf(sp[0 * 33]) | (f2bf(sp[1 * 33]) << 16); o.y = f2bf(sp[2 * 33]) | (f2bf(sp[3 * 33]) << 16); o.z = f2bf(sp[4 * 33]) | (f2bf(sp[5 * 33]) << 16); o.w = f2bf(sp[6 * 33]) | (f2bf(sp[7 * 33]) << 16);
        *(u32x4*)(WT + (size_t)(n0 + n) * K + k0 + 8 * c) = o; } }
    asm volatile("s_waitcnt lgkmcnt(0)" ::: "memory");
}
__device__ __forceinline__ void wcvt_phase(const P& p, LAS unsigned char* lds, int wg, int nwg) {
    const int tid = ltid(), lane = tid & 63, wave = tid >> 6;
    LAS float* scr = (LAS float*)(lds + wave * 16384);
    constexpr int I_IN = 16 * 184, I_A = 8 * 32, I_OUT = 16 * 32, I_F1 = 16 * 176, I_F2 = 44 * 32, I_LAYER = I_IN + 2 * I_A + I_OUT + I_F1 + I_F2;
    for (int it = wg * 8 + wave; it < DEPTH * I_LAYER; it += nwg * 8) {
        const int l = it / I_LAYER; int r = it % I_LAYER;
        unsigned char* wt = p.ws + WS_WT + (size_t)l * WT_LAYER;
        if (r < I_IN) { if (r % 184 < 120) wt_item(p.w_in + (size_t)l * D * NIN, D, NIN, (bf16_t*)(wt + WT_IN), 184, r, scr, lane, MapWin());
                        else wt_item<MapWin, true>(p.w_in + (size_t)l * D * NIN, D, NIN, (bf16_t*)(wt + WT_G8), 184, r, scr, lane, MapWin(), F8_W64, NPROJ); continue; } r -= I_IN;
        if (r < I_A) { wt_item<MapIdent, true>(p.w_a + (size_t)l * 512 * D, 512, D, (bf16_t*)(wt + WT_A8), 32, r, scr, lane, MapIdent(), F8_W64); continue; } r -= I_A;
        if (r < I_A) { wt_item<MapIdent, true>(p.w_b + (size_t)l * 512 * D, 512, D, (bf16_t*)(wt + WT_B8), 32, r, scr, lane, MapIdent(), F8_W64); continue; } r -= I_A;
        if (r < I_OUT) { wt_item(p.w_out + (size_t)l * D * D, D, D, (bf16_t*)(wt + WT_OUT), 32, r, scr, lane, MapIdent()); continue; } r -= I_OUT;
        if (r < I_F1) { wt_item<MapF1, true>(p.w_ffn_in + (size_t)l * D * 2 * DFF, D, 2 * DFF, (bf16_t*)(wt + WT_F1), 176, r, scr, lane, MapF1()); continue; } r -= I_F1;
        wt_item<MapIdent, true>(p.w_ffn_out + (size_t)l * DFF * D, DFF, D, (bf16_t*)(wt + WT_F2), 32, r, scr, lane, MapIdent());
    }
}

enum { PH_CVT = 0, PH_PROJ, PH_CUM, PH_IDX, PH_ATTN, PH_GATES, PH_BRA, PH_BRB, PH_OUT, PH_LN1, PH_FFN1, PH_FFN2, PH_LN2, PH_WCVT };

template <class Epi>
__device__ __forceinline__ void fast_gemm(LAS unsigned char* lds, const bf16_t* A, const bf16_t* Bt, int N, int K, const Epi& E) {
    pg8::Gemm g{A, Bt, M, N, K}; pg8::StaticOrder S; S.init(M, N, (int)gridDim.x, (int)blockIdx.x);
    pg8::gemm_phase<Epi, pg8::StaticOrder, true, true>(lds, g, S, E);
}
template <class Epi, bool ALIGN = true>
__device__ __forceinline__ void fast_gemm8(LAS unsigned char* lds, const unsigned char* A, const unsigned char* Bt, int N, int K, const Epi& E) {
    asm volatile("" : "+s"(K));
    pg8::Gemm g{(const bf16_t*)A, (const bf16_t*)Bt, M, N, K}; pg8::StaticOrder S; S.init(M, N, (int)gridDim.x, (int)blockIdx.x);
    pg8::gemm_phase<Epi, pg8::StaticOrder, ALIGN, true, true>(lds, g, S, E);
}

#ifndef NAIVE_MASK
#define NAIVE_MASK 0
#endif
template <int PH>
__device__ __forceinline__ void run_phase(const P& p_in, int l, LAS unsigned char* lds, int wg, int nwg) {
    P p = p_in; { size_t z = 0; asm volatile("" : "+s"(z)); p.ws = p_in.ws + z; }
    bf16_t* XB = WSP(bf16_t, WS_XB);
    const unsigned char* wt = p.ws + WS_WT + (size_t)l * WT_LAYER;
    if constexpr (PH == PH_CVT) cvt_phase(p, wg, nwg);
    if constexpr (PH == PH_WCVT) wcvt_phase(p, lds, wg, nwg);
    if constexpr (PH == PH_PROJ && (NAIVE_MASK & 1)) {
        GemmArgs g{XB, D, p.w_in + (size_t)l * D * NIN, NIN, C_GA, D, 0};
        EpiProj E{WSP(bf16_t, WS_FQ), WSP(bf16_t, WS_FK), WSP(bf16_t, WS_FV), WSP(bf16_t, WS_DQ), WSP(bf16_t, WS_DK), WSP(bf16_t, WS_DV), WSP(bf16_t, WS_IQ), WSP(bf16_t, WS_IK),
                  WSP(float, WS_FL), WSP(float, WS_IW), p.b_forget + l * NH};
        naive_gemm_phase<EpiProj, false>(lds, g, E, wg, nwg);
    } else
    if constexpr (PH == PH_PROJ) {
        pg8::EpiProjF E{WSP(bf16_t, WS_FQ), (size_t)M * 512, WSP(bf16_t, WS_IK), WSP(float, WS_FL), WSP(float, WS_IW), p.b_forget + l * NH, QSCALE};
        fast_gemm(lds, XB, (const bf16_t*)(wt + WT_IN), NPROJ, D, E);
    }
    if constexpr (PH == PH_CUM) { cum_phase(p, lds, wg, nwg); norm_phase(p, WSP(unsigned, WS_CTL) + CW_KMAX + 128 * l, (float*)(WSP(unsigned, WS_CTL) + CW_QMAX + 2048 * l), wg, nwg); }
    if constexpr (PH == PH_IDX && (NAIVE_MASK & 128)) idx_phase(p, lds, wg, nwg); else
    if constexpr (PH == PH_IDX) {
        const int G = (int)gridDim.x, bx = (int)blockIdx.x, vcu = (G % 8 == 0) ? (bx % 8) * (G / 8) + bx / 8 : bx;
        idx_body::idx_phase_fast(lds, WSP(const bf16_t, WS_IQ), WSP(const bf16_t, WS_IK), WSP(const float, WS_IW), WSP(unsigned, WS_MASK), WSP(unsigned, WS_CTL) + CW_BLK + 128 * l, IDX_SCALE, vcu, G);
    }
    if constexpr (PH == PH_ATTN && (NAIVE_MASK & 64)) attn_phase_naive(p, wg, nwg); else
    if constexpr (PH == PH_ATTN) {
        typedef attn_body::bf16 abf;
        auto mk = [l](unsigned char* ws) { unsigned* ctl = (unsigned*)(ws + WS_CTL);
            return attn_body::AttnTensors{(const abf*)(ws + WS_FQ), (const abf*)(ws + WS_FK), (const abf*)(ws + WS_FV), (const abf*)(ws + WS_DQ), (const abf*)(ws + WS_DK), (const abf*)(ws + WS_DV),
                                          (abf*)(ws + WS_OA), (abf*)(ws + WS_OB), (const float*)(ws + WS_CUM), (const unsigned*)(ws + WS_MASK),
                                          ctl + CW_QHEAD + 64 * l, ctl + CW_KMAX + 128 * l, (const float*)(ctl + CW_QMAX + 2048 * l), ctl + CW_BLK + 128 * l}; };
        attn_body::attn_phase<8>((char*)lds, p.ws, mk, (volatile LAS unsigned*)(lds + LDS_MISC_OFF + 16));
    }
    if constexpr (PH == PH_GATES && (NAIVE_MASK & 2)) {
        GemmArgs g{XB, D, p.w_in + (size_t)l * D * NIN + C_GA, NIN, 2048, D, 0};
        EpiGates E{WSP(bf16_t, WS_SGA), WSP(bf16_t, WS_SGB)};
        naive_gemm_phase<EpiGates, false>(lds, g, E, wg, nwg);
    } else
    if constexpr (PH == PH_GATES) {
        pg8::EpiGatesF E{WSP(bf16_t, WS_SGA), (size_t)M * 1024, 1.f / F8_W64};
        fast_gemm8(lds, WSP(const unsigned char, WS_XF8), wt + WT_G8, NGATE, D, E);
    }
    if constexpr (PH == PH_BRA && (NAIVE_MASK & 4)) {
        GemmArgs g{WSP(bf16_t, WS_OA), 512, p.w_a + (size_t)l * 512 * D, D, D, 512, 0};
        EpiBranchA E{WSP(bf16_t, WS_SGA)};
        naive_gemm_phase<EpiBranchA, false>(lds, g, E, wg, nwg);
    } else
    if constexpr (PH == PH_BRA) {
        pg8::EpiBranchF<0> E{WSP(bf16_t, WS_SGA), nullptr, nullptr, 1.f / (F8_OSCALE * F8_W64), 0.f};
        fast_gemm8(lds, WSP(const unsigned char, WS_OA), wt + WT_A8, D, 512, E);
    }
    if constexpr (PH == PH_BRB && (NAIVE_MASK & 4)) {
        GemmArgs g{WSP(bf16_t, WS_OB), 512, p.w_b + (size_t)l * 512 * D, D, D, 512, 0};
        EpiBranchB E{WSP(bf16_t, WS_SGA), WSP(bf16_t, WS_SGB)};
        naive_gemm_phase<EpiBranchB, false>(lds, g, E, wg, nwg);
    } else
    if constexpr (PH == PH_BRB) {
        pg8::EpiBranchF<1> E{WSP(bf16_t, WS_SGB), WSP(bf16_t, WS_SGA), WSP(unsigned char, WS_MG8), 1.f / (F8_OSCALE * F8_W64), F8_MSCALE};
        fast_gemm8(lds, WSP(const unsigned char, WS_OB), wt + WT_B8, D, 512, E);
    }
    if constexpr (PH == PH_OUT && (NAIVE_MASK & 8)) {
        GemmArgs g{WSP(bf16_t, WS_SGB), D, p.w_out + (size_t)l * D * D, D, D, D, 0};
        EpiResF32 E{l == 0 ? p.x : nullptr, XB, p.out};
        naive_gemm_phase<EpiResF32, false>(lds, g, E, wg, nwg);
    } else
    if constexpr (PH == PH_OUT) {
        pg8::EpiResF E{l == 0 ? p.x : nullptr, XB, WSP(bf16_t, WS_Y1), ALPHA, 1.f};
        fast_gemm(lds, WSP(bf16_t, WS_SGB), (const bf16_t*)(wt + WT_OUT), D, D, E);
    }
    if constexpr (PH == PH_LN1) ln_phase(WSP(const bf16_t, WS_Y1), p.ln1_g + l * D, p.ln1_b + l * D, WSP(bf16_t, WS_X1B), nullptr, wg, nwg, WSP(unsigned char, WS_X1F8));
    if constexpr (PH == PH_FFN1 && (NAIVE_MASK & 16)) {
        GemmArgs g{WSP(bf16_t, WS_X1B), D, p.w_ffn_in + (size_t)l * D * 2 * DFF, 2 * DFF, DFF, D, DFF};
        EpiSwiglu E{WSP(bf16_t, WS_H)};
        naive_gemm_phase<EpiSwiglu, true>(lds, g, E, wg, nwg);
    } else
    if constexpr (PH == PH_FFN1) {
        pg8::EpiSwigluF8 E{WSP(unsigned char, WS_H8), DFF, 1.f / F8_WSCALE, F8_HSCALE};
        fast_gemm8(lds, WSP(const unsigned char, WS_X1F8), wt + WT_F1, 2 * DFF, D, E);
    }
    if constexpr (PH == PH_FFN2 && (NAIVE_MASK & 32)) {
        GemmArgs g{WSP(bf16_t, WS_H), DFF, p.w_ffn_out + (size_t)l * DFF * D, D, D, DFF, 0};
        EpiResF32 E{nullptr, WSP(bf16_t, WS_X1B), p.out};
        naive_gemm_phase<EpiResF32, false>(lds, g, E, wg, nwg);
    } else
    if constexpr (PH == PH_FFN2) {
        pg8::EpiResF E{nullptr, WSP(bf16_t, WS_X1B), XB, ALPHA, 1.f / (F8_WSCALE * F8_HSCALE)};
        fast_gemm8(lds, WSP(const unsigned char, WS_H8), wt + WT_F2, D, DFF, E);
    }
    if constexpr (PH == PH_LN2) {
        if (l + 1 < DEPTH) ln_phase(XB, p.ln2_g + l * D, p.ln2_b + l * D, XB, nullptr, wg, nwg, WSP(unsigned char, WS_XF8));
        else ln_phase(XB, p.ln2_g + l * D, p.ln2_b + l * D, nullptr, p.out, wg, nwg);
    }
}

#define XB_TMO      128
#define XB_XCNT(j)  (256  + 64 * (j))
#define XB_XSUB(j)  (1280 + 64 * (j))
#define XB_XGEN(j)  (2304 + 64 * (j))
#define XB_TOP      3328
#define XB_TOPGEN   3392
#define XCD_BAR_WORDS 3456
#define XB_SPIN_CAP (1u << 18)

__device__ __forceinline__ unsigned xb_ld(unsigned* p)              { return __hip_atomic_load(p, __ATOMIC_RELAXED, __HIP_MEMORY_SCOPE_AGENT); }
__device__ __forceinline__ unsigned xb_add(unsigned* p, unsigned v) { return __hip_atomic_fetch_add(p, v, __ATOMIC_RELAXED, __HIP_MEMORY_SCOPE_AGENT); }
__device__ __forceinline__ unsigned xb_xcc_id() { return (unsigned)__builtin_amdgcn_s_getreg((3 << 11) | 20) & 0xFu; }
#define XB_SPIN(cond, bar) do { unsigned _sp = 0; while (cond) { __builtin_amdgcn_s_sleep(1); \
    if ((++_sp & 255u) == 0u) { if (xb_ld(&(bar)[XB_TMO])) break; if (_sp > XB_SPIN_CAP) { atomicAdd(&(bar)[XB_TMO], 1u); break; } } } } while (0)

struct XcdBarrier {
    unsigned* bar; unsigned x;
    volatile LAS unsigned* st;
};

__device__ __forceinline__ XcdBarrier xcd_barrier_post(unsigned* bar, volatile LAS unsigned* st) {
    XcdBarrier b; b.bar = bar; b.x = xb_xcc_id(); b.st = st;
    if (ltid() == 0) (void)xb_add(&bar[XB_XCNT(b.x)], 1u);
    return b;
}
__device__ __forceinline__ void xcd_barrier_complete(unsigned* bar, unsigned x, unsigned& nloc, unsigned& nx) {
    const unsigned G = gridDim.x * gridDim.y * gridDim.z;
    unsigned sum, cnt, mine, sp = 0u;
    for (;;) {
        sum = 0u; cnt = 0u; mine = 0u;
#pragma unroll
        for (unsigned j = 0; j < 16; ++j) { const unsigned c = xb_ld(&bar[XB_XCNT(j)]); sum += c; cnt += (c > 0u) ? 1u : 0u; mine = (j == x) ? c : mine; }
        if (sum == G) break;
        __builtin_amdgcn_s_sleep(1);
        if ((++sp & 255u) == 0u) { if (xb_ld(&bar[XB_TMO])) break; if (sp > XB_SPIN_CAP) { atomicAdd(&bar[XB_TMO], 1u); break; } }
    }
    nloc = mine > 0u ? mine : 1u; nx = cnt > 0u ? cnt : 1u;
}

__device__ __forceinline__ void xcd_barrier(const XcdBarrier& b) {
    asm volatile("s_waitcnt vmcnt(0)" ::: "memory");
    __syncthreads();
    if (ltid() == 0) {
        unsigned* bar = b.bar;
        __builtin_amdgcn_s_waitcnt(0);
        unsigned nloc = b.st[0], nx = b.st[1];
        if (nloc == 0u) { xcd_barrier_complete(bar, b.x, nloc, nx); b.st[0] = nloc; b.st[1] = nx; }
        const unsigned old = xb_add(&bar[XB_XSUB(b.x)], 1u);
        const unsigned gen = old / nloc;
        if (old + 1u == (gen + 1u) * nloc) {
            __builtin_amdgcn_fence(__ATOMIC_RELEASE, "agent");
            asm volatile("s_waitcnt vmcnt(0)" ::: "memory");
            const unsigned og = xb_add(&bar[XB_TOP], 1u);
            const unsigned tg = og / nx;
            if (og + 1u == (tg + 1u) * nx) xb_add(&bar[XB_TOPGEN], 1u);
            else XB_SPIN(xb_ld(&bar[XB_TOPGEN]) == tg, bar);
            __builtin_amdgcn_fence(__ATOMIC_ACQUIRE, "agent");
            xb_add(&bar[XB_XGEN(b.x)], 1u);
            asm volatile("s_waitcnt vmcnt(0)" ::: "memory");
        } else {
            XB_SPIN(xb_ld(&bar[XB_XGEN(b.x)]) == gen, bar);
            __builtin_amdgcn_fence(__ATOMIC_ACQUIRE, "agent");
            asm volatile("s_waitcnt vmcnt(0)" ::: "memory");
        }
    }
    __syncthreads();
}

constexpr int LDS_BYTES = 147456;
constexpr int LDS_MISC = LDS_MISC_OFF;
constexpr int CW_BAR = 4096;
constexpr size_t CTL_ZERO_BYTES = 1u << 20;

#ifndef DUP_MASK
#define DUP_MASK 0
#endif
#define RUNPH(PH, bit) do { run_phase<PH>(p, l, lds, wg, nwg); if (DUP_MASK & (bit)) { xcd_barrier(bar); run_phase<PH>(p, l, lds, wg, nwg); } } while (0)
template <int LYR>
__device__ __forceinline__ void layer_body(const P& p, LAS unsigned char* lds, int wg, int nwg, const XcdBarrier& bar) {
    constexpr int l = LYR;
    RUNPH(PH_PROJ, 1); xcd_barrier(bar);
    run_phase<PH_CUM>(p, l, lds, wg, nwg); __syncthreads();
    RUNPH(PH_IDX, 2); xcd_barrier(bar);
    RUNPH(PH_ATTN, 4); xcd_barrier(bar);
    RUNPH(PH_GATES, 8); xcd_barrier(bar);
    run_phase<PH_BRA>(p, l, lds, wg, nwg); xcd_barrier(bar);
    run_phase<PH_BRB>(p, l, lds, wg, nwg); xcd_barrier(bar);
    RUNPH(PH_OUT, 16); xcd_barrier(bar);
    RUNPH(PH_LN1, 32); xcd_barrier(bar);
    RUNPH(PH_FFN1, 64); xcd_barrier(bar);
    RUNPH(PH_FFN2, 128); xcd_barrier(bar);
    run_phase<PH_LN2>(p, l, lds, wg, nwg);
}

__global__ void __launch_bounds__(NT, 2) mega_fwd(P p) {
    extern __shared__ __attribute__((aligned(16))) unsigned char lds_raw[];
    LAS unsigned char* lds = (LAS unsigned char*)lds_raw;
    volatile LAS unsigned* MISC = (volatile LAS unsigned*)(lds + LDS_MISC);
    if (threadIdx.x < 8) MISC[threadIdx.x] = 0u;
    ((volatile LAS int*)(uintptr_t)LDS_WTAB_OFF)[hw_wave_slot()] = (int)(threadIdx.x >> 6);
    __syncthreads();
    XcdBarrier bar = xcd_barrier_post((unsigned*)(p.ws + WS_CTL) + CW_BAR, MISC);
    const int wg = (int)blockIdx.x, nwg = (int)gridDim.x;
    run_phase<PH_CVT>(p, 0, lds, wg, nwg);
    run_phase<PH_WCVT>(p, 0, lds, wg, nwg); xcd_barrier(bar);
    layer_body<0>(p, lds, wg, nwg, bar); xcd_barrier(bar);
    layer_body<1>(p, lds, wg, nwg, bar);
}

extern "C" void kernel_launch(void* const* d_in, const int* in_sizes, int n_in, void* d_out, int out_size, void* d_ws, size_t ws_size, hipStream_t stream) {
    static int grid = 0;
    if (grid == 0) {
        if (n_in != 12 || ws_size < WS_END) { fprintf(stderr, "kernel_launch: unexpected inputs (n_in %d, ws %zu)\n", n_in, ws_size); grid = -1; return; }
        int dev = 0, cus = 0, per_cu = 0;
        if (hipGetDevice(&dev) != hipSuccess || hipDeviceGetAttribute(&cus, hipDeviceAttributeMultiprocessorCount, dev) != hipSuccess) { grid = -1; return; }
        if (hipFuncSetAttribute((const void*)mega_fwd, hipFuncAttributeMaxDynamicSharedMemorySize, LDS_BYTES) != hipSuccess) { fprintf(stderr, "kernel_launch: hipFuncSetAttribute failed\n"); grid = -1; return; }
        if (hipOccupancyMaxActiveBlocksPerMultiprocessor(&per_cu, (const void*)mega_fwd, NT, LDS_BYTES) != hipSuccess || per_cu < 1) { fprintf(stderr, "kernel_launch: occupancy query says %d\n", per_cu); }
        (void)hipGetLastError();
        grid = cus;
    }
    if (grid < 0) return;
    P p{};
    p.x = (const float*)d_in[0]; p.w_in = (const float*)d_in[1]; p.b_forget = (const float*)d_in[2]; p.w_a = (const float*)d_in[3]; p.w_b = (const float*)d_in[4];
    p.w_out = (const float*)d_in[5]; p.ln1_g = (const float*)d_in[6]; p.ln1_b = (const float*)d_in[7]; p.w_ffn_in = (const float*)d_in[8]; p.w_ffn_out = (const float*)d_in[9];
    p.ln2_g = (const float*)d_in[10]; p.ln2_b = (const float*)d_in[11]; p.out = (float*)d_out; p.ws = (unsigned char*)d_ws;
    if (hipMemsetAsync((char*)d_ws + WS_CTL, 0, CTL_ZERO_BYTES, stream) != hipSuccess) { fprintf(stderr, "kernel_launch: memset failed\n"); return; }
    hipLaunchKernelGGL(mega_fwd, dim3(grid), dim3(NT), LDS_BYTES, stream, p);
}
```

```cpp
#include <hip/hip_runtime.h>
#include <stdint.h>
#include <stdio.h>

#define LAS __attribute__((address_space(3)))
typedef unsigned short bf16_t;
typedef float f32x4 __attribute__((ext_vector_type(4)));
typedef unsigned u32x4 __attribute__((ext_vector_type(4)));
typedef unsigned u32x2 __attribute__((ext_vector_type(2)));

namespace cfg {
constexpr int NB = 8, L = 4096, D = 1024, M = NB * L, DEPTH = 2;
constexpr int NH = 8, HD = 64, HW = 512;
constexpr int DFF = 2816;
constexpr int NIN = 5712;
constexpr int C_GA = 3664;
constexpr float ALPHA = 1.4142135623730951f;
constexpr float LN_EPS = 1e-5f;
constexpr float LOG2E = 1.4426950408889634f;
constexpr float QSCALE = 0.125f * LOG2E;
constexpr float IDX_SCALE = 0.04419417382415922f;
constexpr int TOPK = 256;
constexpr int NT = 512;
constexpr int LDS_MISC_OFF = 135168;
constexpr size_t MiB = 1u << 20;
constexpr size_t WS_CTL = 0;
constexpr size_t WS_WT = 1 * MiB, WT_LAYER = 32 * MiB;
constexpr size_t WT_G8 = 12058624 + 4 * 1048576 + 5767168, WT_A8 = WT_G8 + 2 * 1048576, WT_B8 = WT_A8 + 524288, WT_OUT8 = WT_B8 + 524288;
constexpr size_t WT_IN = 0, WT_A = 12058624, WT_B = WT_A + 1048576, WT_OUT = WT_B + 1048576, WT_F1 = WT_OUT + 2097152, WT_F2 = WT_F1 + 11534336;
constexpr int NPROJ = 3840, NGATE = 2048;
constexpr size_t WS_XB = 65 * MiB;
constexpr size_t WS_FQ = 129 * MiB, WS_FK = 161 * MiB, WS_FV = 193 * MiB, WS_DQ = 225 * MiB, WS_DK = 257 * MiB, WS_DV = 289 * MiB, WS_IQ = 321 * MiB;
constexpr size_t WS_IK = 353 * MiB;
constexpr size_t WS_FL = 357 * MiB, WS_IW = 358 * MiB, WS_CUM = 359 * MiB;
constexpr size_t WS_OA = 360 * MiB, WS_OB = 392 * MiB;
constexpr size_t WS_X1B = 360 * MiB;
constexpr size_t WS_MASK = 424 * MiB;
constexpr size_t WS_SGA = 129 * MiB, WS_SGB = 193 * MiB;
constexpr size_t WS_Y1 = 129 * MiB;
constexpr size_t WS_H8 = 129 * MiB;
constexpr size_t WS_X1F8 = 217 * MiB;
constexpr size_t WS_H = 129 * MiB;
constexpr size_t WS_XF8 = 440 * MiB;
constexpr size_t WS_MG8 = 472 * MiB;
constexpr size_t WS_END = 504 * MiB;
constexpr int CW_QHEAD = 8192;
constexpr int CW_KMAX = 8448;
constexpr int CW_BLK = 8704;
constexpr int CW_QMAX = 9216;
}
using namespace cfg;

__device__ __forceinline__ float bf2f(unsigned v) { return __uint_as_float(v << 16); }
__device__ __forceinline__ unsigned f2bf(float f) { unsigned u = __float_as_uint(f); return (u + 0x7fffu + ((u >> 16) & 1u)) >> 16; }

constexpr int LDS_WTAB_OFF = 135168 + 64;
__device__ __forceinline__ unsigned hw_wave_slot() { return ((unsigned)__builtin_amdgcn_s_getreg((3 << 11) | (0 << 6) | 4) & 15u) | (((unsigned)__builtin_amdgcn_s_getreg((1 << 11) | (4 << 6) | 4) & 3u) << 4); }
__device__ __forceinline__ int ltid() {
    const int w = ((volatile LAS int*)(uintptr_t)LDS_WTAB_OFF)[hw_wave_slot()];
    int lane; asm volatile("v_mbcnt_lo_u32_b32 %0, -1, 0\n\tv_mbcnt_hi_u32_b32 %0, -1, %0" : "=v"(lane));
    int t = w * 64 + lane;
    asm volatile("" : "+v"(t)); return t;
}

__device__ __forceinline__ unsigned pk4_fp8(float a, float b, float c, float d) { unsigned w = 0u; w = (unsigned)__builtin_amdgcn_cvt_pk_fp8_f32(a, b, (int)w, false); w = (unsigned)__builtin_amdgcn_cvt_pk_fp8_f32(c, d, (int)w, true); return w; }
constexpr float F8_WSCALE = 256.f, F8_HSCALE = 16.f, F8_W64 = 64.f, F8_OSCALE = 16.f, F8_MSCALE = 16.f;

struct P {
    const float *x, *w_in, *b_forget, *w_a, *w_b, *w_out, *ln1_g, *ln1_b, *w_ffn_in, *w_ffn_out, *ln2_g, *ln2_b;
    float* out; unsigned char* ws;
};
#define WSP(T, off) ((T*)(p.ws + (off)))

struct GemmArgs { const bf16_t* A; int lda; const float* W; int ldw; int N; int K; int dual_off; };

template <class Epi, bool DUAL>
__device__ __forceinline__ void naive_gemm_phase(LAS unsigned char* lds, const GemmArgs g, const Epi& E, int wg, int nwg) {
    LAS float* As = (LAS float*)lds;
    LAS float* Bs = As + 16 * 132;
    LAS float* Bs2 = Bs + 16 * 128;
    const int tid = ltid(), ty = tid >> 5, tx = tid & 31;
    const int ntn = (g.N + 127) / 128, ntm = M / 128, nitems = ntn * ntm;
    for (int it = wg; it < nitems; it += nwg) {
        const int tm = it / ntn, tn = it % ntn;
        const int m0 = tm * 128, n0 = tn * 128;
        float acc[8][4], acc2[8][4];
#pragma unroll
        for (int i = 0; i < 8; ++i)
#pragma unroll
            for (int j = 0; j < 4; ++j) { acc[i][j] = 0.f; acc2[i][j] = 0.f; }
        for (int k0 = 0; k0 < g.K; k0 += 16) {
            {
                const int r = tid >> 2, kq = (tid & 3) * 4;
                const u32x2 v = *(const u32x2*)(g.A + (size_t)(m0 + r) * g.lda + k0 + kq);
                As[(kq + 0) * 132 + r] = bf2f(v.x & 0xffffu); As[(kq + 1) * 132 + r] = bf2f(v.x >> 16);
                As[(kq + 2) * 132 + r] = bf2f(v.y & 0xffffu); As[(kq + 3) * 132 + r] = bf2f(v.y >> 16);
            }
            {
                const int k = tid >> 5, n4 = (tid & 31) * 4, n = n0 + n4;
                f32x4 w = (f32x4){0.f, 0.f, 0.f, 0.f}, w2 = w;
                if (n < g.N) { w = *(const f32x4*)(g.W + (size_t)(k0 + k) * g.ldw + n); if (DUAL) w2 = *(const f32x4*)(g.W + (size_t)(k0 + k) * g.ldw + n + g.dual_off); }
                *(LAS f32x4*)(Bs + k * 128 + n4) = w;
                if (DUAL) *(LAS f32x4*)(Bs2 + k * 128 + n4) = w2;
            }
            __syncthreads();
#pragma unroll 2
            for (int kk = 0; kk < 16; ++kk) {
                const f32x4 a0 = *(const LAS f32x4*)(As + kk * 132 + ty * 8), a1 = *(const LAS f32x4*)(As + kk * 132 + ty * 8 + 4);
                const f32x4 b = *(const LAS f32x4*)(Bs + kk * 128 + tx * 4);
                const float a[8] = {a0.x, a0.y, a0.z, a0.w, a1.x, a1.y, a1.z, a1.w};
                const float bb[4] = {b.x, b.y, b.z, b.w};
#pragma unroll
                for (int i = 0; i < 8; ++i)
#pragma unroll
                    for (int j = 0; j < 4; ++j) acc[i][j] = fmaf(a[i], bb[j], acc[i][j]);
                if (DUAL) {
                    const f32x4 b2 = *(const LAS f32x4*)(Bs2 + kk * 128 + tx * 4);
                    const float b2b[4] = {b2.x, b2.y, b2.z, b2.w};
#pragma unroll
                    for (int i = 0; i < 8; ++i)
#pragma unroll
                        for (int j = 0; j < 4; ++j) acc2[i][j] = fmaf(a[i], b2b[j], acc2[i][j]);
                }
            }
            __syncthreads();
        }
#pragma unroll
        for (int i = 0; i < 8; ++i)
#pragma unroll
            for (int j = 0; j < 4; ++j) { const int n = n0 + tx * 4 + j; if (n < g.N) E(m0 + ty * 8 + i, n, acc[i][j], acc2[i][j]); }
    }
}

struct EpiProj {
    bf16_t *FQ, *FK, *FV, *DQ, *DK, *DV, *IQ, *IK; float *FL, *IW; const float* bforget;
    __device__ __forceinline__ void operator()(int m, int n, float v, float) const {
        const size_t r = (size_t)m;
        if (n < 512) FQ[r * 512 + n] = (bf16_t)f2bf(v * QSCALE);
        else if (n < 1024) FK[r * 512 + (n - 512)] = (bf16_t)f2bf(v);
        else if (n < 1536) FV[r * 512 + (n - 1024)] = (bf16_t)f2bf(v);
        else if (n < 1544) FL[r * 8 + (n - 1536)] = v + bforget[n - 1536];
        else if (n < 2056) DQ[r * 512 + (n - 1544)] = (bf16_t)f2bf(v * QSCALE);
        else if (n < 2568) DK[r * 512 + (n - 2056)] = (bf16_t)f2bf(v);
        else if (n < 3080) DV[r * 512 + (n - 2568)] = (bf16_t)f2bf(v);
        else if (n < 3592) IQ[r * 512 + (n - 3080)] = (bf16_t)f2bf(v);
        else if (n < 3656) IK[r * 64 + (n - 3592)] = (bf16_t)f2bf(v);
        else IW[r * 8 + (n - 3656)] = v;
    }
};
struct EpiGates {
    bf16_t *SGA, *SGB;
    __device__ __forceinline__ void operator()(int m, int n, float v, float) const {
        const float s = 1.f / (1.f + __expf(-v));
        if (n < 1024) SGA[(size_t)m * 1024 + n] = (bf16_t)f2bf(s); else SGB[(size_t)m * 1024 + (n - 1024)] = (bf16_t)f2bf(s);
    }
};
struct EpiBranchA { bf16_t* SGA;
    __device__ __forceinline__ void operator()(int m, int n, float v, float) const { bf16_t* q = SGA + (size_t)m * 1024 + n; *q = (bf16_t)f2bf(bf2f(*q) * v); } };
struct EpiBranchB { const bf16_t* MA; bf16_t* SGB;
    __device__ __forceinline__ void operator()(int m, int n, float v, float) const { const size_t o = (size_t)m * 1024 + n; SGB[o] = (bf16_t)f2bf(bf2f(MA[o]) + bf2f(SGB[o]) * v); } };
struct EpiResF32 { const float* xf; const bf16_t* xb; float* Y;
    __device__ __forceinline__ void operator()(int m, int n, float v, float) const { const size_t o = (size_t)m * 1024 + n; const float xv = xf ? xf[o] : bf2f(xb[o]); Y[o] = ALPHA * xv + v; } };
struct EpiSwiglu { bf16_t* H;
    __device__ __forceinline__ void operator()(int m, int n, float g, float u) const { const float s = g / (1.f + __expf(-g)); H[(size_t)m * DFF + n] = (bf16_t)f2bf(s * u); } };

namespace pg8 {
#define PG8_LAS __attribute__((address_space(3)))
typedef unsigned short bf16_t;
typedef short bf16x8 __attribute__((ext_vector_type(8)));
typedef float f32x4 __attribute__((ext_vector_type(4)));
typedef unsigned u32x4 __attribute__((ext_vector_type(4)));
constexpr int BM = 256, BK = 64, HALF = 128, HTB = HALF * BK * 2  , STAGE_BYTES = 8 * HTB, NXCD = 8, WGM = 8;

__host__ __device__ __forceinline__ int lds_byte(int r, int c) { const int st = (r >> 4) * 2 + (c >> 5), rr = r & 15, cc = c & 31, ob = rr * 64 + cc * 2; return st * 1024 + (ob ^ (((ob >> 9) & 1) << 5)); }
__host__ __device__ __forceinline__ void stage_rc(int b, int& R, int& C) { const int st = b / 1024, sb = b % 1024, swz = sb ^ (((sb >> 9) & 1) << 5); R = (st >> 1) * 16 + swz / 64; C = (st & 1) * 32 + (swz % 64) / 2; }
__host__ __device__ __forceinline__ int perm32(int rho) { const int n = rho >> 4, i = rho & 15; return 8 * (i >> 2) + 4 * n + (i & 3); }

struct Unit { int pm, pn; };
struct Gemm { const bf16_t* A; const bf16_t* Bt; int M, N, K; };

struct StaticOrder {
    int nM, nN, nwg, G, c;
    __host__ __device__ void init(int M, int N, int G_, int c_) { nM = M / BM; nN = N / BM; nwg = nM * nN; G = G_; c = c_; }
    __host__ __device__ bool next(int i, Unit& u) const { return at((long)i * G + c, u); }
    __host__ __device__ bool at(long L, Unit& u) const {
        if (L >= nwg) return false;
        int wgid = (int)L; { const int q = nwg / NXCD, r = nwg % NXCD, xcd = wgid % NXCD, off = wgid / NXCD; wgid = (xcd < r ? xcd * (q + 1) : r * (q + 1) + (xcd - r) * q) + off; }
        const int nig = WGM * nN, gid = wgid / nig, fm = gid * WGM, gsz = (nM - fm) < WGM ? (nM - fm) : WGM;
        u.pm = fm + ((wgid % nig) % gsz); u.pn = (wgid % nig) / gsz; return true;
    }
    __device__ __forceinline__ void a_ready(const Unit&) const {}
    __device__ __forceinline__ void done(const Unit&) const {}
};
struct SplitOrder : StaticOrder {
    __host__ __device__ bool next(int i, Unit& u) const {
        if (i < 5 || nwg != 6 * G || (G & 1)) return at((long)i * G + c, u);
        if (c < G / 2 || i >= 7) return false;
        return at(5L * G + (long)(i - 5) * (G / 2) + (c - G / 2), u);
    }
};


typedef float f32x2_t __attribute__((ext_vector_type(2))); typedef __bf16 bf16x2_t __attribute__((ext_vector_type(2)));
__device__ __forceinline__ unsigned cvt_pk_bf16(float lo, float hi) { f32x2_t v = {lo, hi}; bf16x2_t b = __builtin_convertvector(v, bf16x2_t); return __builtin_bit_cast(unsigned, b); }
__device__ __forceinline__ float bflo(unsigned w) { return __uint_as_float(w << 16); }
__device__ __forceinline__ float bfhi(unsigned w) { return __uint_as_float(w & 0xffff0000u); }
__device__ __forceinline__ u32x4 pack8(const f32x4 v0, const f32x4 v1) { u32x4 w; w.x = cvt_pk_bf16(v0[0], v0[1]); w.y = cvt_pk_bf16(v0[2], v0[3]); w.z = cvt_pk_bf16(v1[0], v1[1]); w.w = cvt_pk_bf16(v1[2], v1[3]); return w; }
__device__ __forceinline__ float sigmoid_f(float v) { return __builtin_amdgcn_rcpf(1.0f + __builtin_amdgcn_exp2f(-1.4426950408889634f * v)); }

struct EpiProjF {
    static constexpr bool PERM = true, AFTER_DRAIN = false;
    bf16_t* QKV; size_t tstride; bf16_t* IK; float* FL; float* IW; const float* bforget; float qs; int pn_off;
    __device__ __forceinline__ void operator()(const f32x4 (&acc)[2][2][4][2], const Unit& u, int wr, int wc, int fr, int fq) const {
        const int row0 = u.pm * BM + wr * 64 + fr; const int pn = u.pn + pn_off;
        if (pn < 14) {
            const int t = pn >> 1; const float sc = (t == 0 || t == 3) ? qs : 1.f;
            bf16_t* base = QKV + (size_t)t * tstride + (pn & 1) * 256 + wc * 32 + 8 * fq;
#pragma unroll
            for (int ai = 0; ai < 2; ++ai)
#pragma unroll
                for (int m = 0; m < 4; ++m) { bf16_t* rowp = base + (size_t)(row0 + ai * HALF + m * 16) * 512;
#pragma unroll
                    for (int bj = 0; bj < 2; ++bj) *(u32x4*)(rowp + bj * HALF) = pack8(acc[ai][bj][m][0] * sc, acc[ai][bj][m][1] * sc); }
        } else {
#pragma unroll
            for (int ai = 0; ai < 2; ++ai)
#pragma unroll
                for (int m = 0; m < 4; ++m) { const size_t row = (size_t)(row0 + ai * HALF + m * 16);
                    const f32x4 v0 = acc[ai][0][m][0], v1 = acc[ai][0][m][1];
                    if (wc < 2) *(u32x4*)(IK + row * 64 + wc * 32 + 8 * fq) = pack8(v0, v1);
                    else if (wc == 2 && fq == 0) { *(f32x4*)(FL + row * 8) = v0 + *(const f32x4*)bforget; *(f32x4*)(FL + row * 8 + 4) = v1 + *(const f32x4*)(bforget + 4); }
                    else if (wc == 2 && fq == 1) { *(f32x4*)(IW + row * 8) = v0; *(f32x4*)(IW + row * 8 + 4) = v1; } }
        }
    }
};
struct EpiQkvF {
    static constexpr bool PERM = true, AFTER_DRAIN = false;
    bf16_t* QKV; size_t tstride; float qs, accs;
    __device__ __forceinline__ void operator()(const f32x4 (&acc)[2][2][4][2], const Unit& u, int wr, int wc, int fr, int fq) const {
        asm volatile("" : "+v"(fr), "+v"(fq));
        const int row0 = u.pm * BM + wr * 64 + fr; const int t = u.pn >> 1; const float sc = ((t == 0 || t == 3) ? qs : 1.f) * accs;
        bf16_t* base = QKV + (size_t)t * tstride + (u.pn & 1) * 256 + wc * 32 + 8 * fq;
#pragma unroll
        for (int ai = 0; ai < 2; ++ai)
#pragma unroll
            for (int m = 0; m < 4; ++m) { bf16_t* rowp = base + (size_t)(row0 + ai * HALF + m * 16) * 512;
#pragma unroll
                for (int bj = 0; bj < 2; ++bj) *(u32x4*)(rowp + bj * HALF) = pack8(acc[ai][bj][m][0] * sc, acc[ai][bj][m][1] * sc); }
    }
};
struct EpiGatesF {
    static constexpr bool PERM = true, AFTER_DRAIN = false;
    bf16_t* SG; size_t tstride; float accs;
    __device__ __forceinline__ void operator()(const f32x4 (&acc)[2][2][4][2], const Unit& u, int wr, int wc, int fr, int fq) const {
        asm volatile("" : "+v"(fr), "+v"(fq));
        const int row0 = u.pm * BM + wr * 64 + fr;
        bf16_t* base = SG + (size_t)(u.pn >> 2) * tstride + (u.pn & 3) * 256 + wc * 32 + 8 * fq;
#pragma unroll
        for (int ai = 0; ai < 2; ++ai)
#pragma unroll
            for (int m = 0; m < 4; ++m) { bf16_t* rowp = base + (size_t)(row0 + ai * HALF + m * 16) * 1024;
#pragma unroll
                for (int bj = 0; bj < 2; ++bj) { f32x4 v0 = acc[ai][bj][m][0], v1 = acc[ai][bj][m][1];
#pragma unroll
                    for (int e = 0; e < 4; ++e) { v0[e] = sigmoid_f(v0[e] * accs); v1[e] = sigmoid_f(v1[e] * accs); }
                    *(u32x4*)(rowp + bj * HALF) = pack8(v0, v1); } }
    }
};
template <int MODE> struct EpiBranchF {
    static constexpr bool PERM = true, AFTER_DRAIN = false;
    bf16_t* G; const bf16_t* MA; unsigned char* M8; float accs; float ms;
    __device__ __forceinline__ void operator()(const f32x4 (&acc)[2][2][4][2], const Unit& u, int wr, int wc, int fr, int fq) const {
        asm volatile("" : "+v"(fr), "+v"(fq));
        const int row0 = u.pm * BM + wr * 64 + fr; const int col0 = u.pn * BM + wc * 32 + 8 * fq;
        float accs = this->accs, ms = this->ms; asm volatile("" : "+s"(accs), "+s"(ms));
#pragma unroll
        for (int ai = 0; ai < 2; ++ai)
#pragma unroll
            for (int m = 0; m < 4; ++m) { const size_t off = (size_t)(row0 + ai * HALF + m * 16) * 1024 + col0;
#pragma unroll
                for (int bj = 0; bj < 2; ++bj) { const f32x4 a0 = acc[ai][bj][m][0], a1 = acc[ai][bj][m][1];
                    const u32x4 g = *(const u32x4*)(G + off + bj * HALF);
                    f32x4 v0 = (f32x4){bflo(g.x) * a0[0], bfhi(g.x) * a0[1], bflo(g.y) * a0[2], bfhi(g.y) * a0[3]} * accs;
                    f32x4 v1 = (f32x4){bflo(g.z) * a1[0], bfhi(g.z) * a1[1], bflo(g.w) * a1[2], bfhi(g.w) * a1[3]} * accs;
                    if (MODE == 1) { const u32x4 q = *(const u32x4*)(MA + off + bj * HALF);
                        v0 = v0 + (f32x4){bflo(q.x), bfhi(q.x), bflo(q.y), bfhi(q.y)}; v1 = v1 + (f32x4){bflo(q.z), bfhi(q.z), bflo(q.w), bfhi(q.w)}; }
                    *(u32x4*)(G + off + bj * HALF) = pack8(v0, v1); }
                asm volatile("" ::: "memory"); }
    }
};
struct EpiResF {
    static constexpr bool PERM = true, AFTER_DRAIN = false;
    const float* xf; const bf16_t* xb; bf16_t* Y; float alpha; float accs;
    __device__ __forceinline__ void operator()(const f32x4 (&acc)[2][2][4][2], const Unit& u, int wr, int wc, int fr, int fq) const {
        asm volatile("" : "+v"(fr), "+v"(fq));
        const int row0 = u.pm * BM + wr * 64 + fr; const int col0 = u.pn * BM + wc * 32 + 8 * fq;
#pragma unroll
        for (int ai = 0; ai < 2; ++ai)
#pragma unroll
            for (int m = 0; m < 4; ++m) { const size_t off = (size_t)(row0 + ai * HALF + m * 16) * 1024 + col0;
#pragma unroll
                for (int bj = 0; bj < 2; ++bj) { const size_t o = off + bj * HALF; f32x4 x0, x1;
                    if (xf) { x0 = *(const f32x4*)(xf + o); x1 = *(const f32x4*)(xf + o + 4); }
                    else { const u32x4 w = *(const u32x4*)(xb + o); x0 = (f32x4){bflo(w.x), bfhi(w.x), bflo(w.y), bfhi(w.y)}; x1 = (f32x4){bflo(w.z), bfhi(w.z), bflo(w.w), bfhi(w.w)}; }
                    *(u32x4*)(Y + o) = pack8(x0 * alpha + acc[ai][bj][m][0] * accs, x1 * alpha + acc[ai][bj][m][1] * accs); } }
    }
};
struct EpiSwigluF {
    static constexpr bool PERM = true, AFTER_DRAIN = false;
    bf16_t* H; int ldh;
    __device__ __forceinline__ void operator()(const f32x4 (&acc)[2][2][4][2], const Unit& u, int wr, int wc, int fr, int fq) const {
        const int row0 = u.pm * BM + wr * 64 + fr; const int col0 = u.pn * HALF + wc * 32 + 8 * fq;
#pragma unroll
        for (int ai = 0; ai < 2; ++ai)
#pragma unroll
            for (int m = 0; m < 4; ++m) { f32x4 v0, v1;
#pragma unroll
                for (int e = 0; e < 4; ++e) { const float g0 = acc[ai][0][m][0][e], g1 = acc[ai][0][m][1][e];
                    v0[e] = g0 * sigmoid_f(g0) * acc[ai][1][m][0][e]; v1[e] = g1 * sigmoid_f(g1) * acc[ai][1][m][1][e]; }
                *(u32x4*)(H + (size_t)(row0 + ai * HALF + m * 16) * ldh + col0) = pack8(v0, v1); }
    }
};

struct EpiSwigluF8 {
    static constexpr bool PERM = true, AFTER_DRAIN = false;
    unsigned char* H8; int ldh; float accs, hs;
    __device__ __forceinline__ void operator()(const f32x4 (&acc)[2][2][4][2], const Unit& u, int wr, int wc, int fr, int fq) const {
        asm volatile("" : "+v"(fr), "+v"(fq));
        typedef unsigned u32x2v __attribute__((ext_vector_type(2)));
        const int row0 = u.pm * BM + wr * 64 + fr; const int col0 = u.pn * HALF + wc * 32 + 8 * fq;
#pragma unroll
        for (int ai = 0; ai < 2; ++ai)
#pragma unroll
            for (int m = 0; m < 4; ++m) { float v[8];
#pragma unroll
                for (int e = 0; e < 4; ++e) { const float g0 = acc[ai][0][m][0][e] * accs, g1 = acc[ai][0][m][1][e] * accs;
                    v[e] = __builtin_amdgcn_fmed3f(g0 * sigmoid_f(g0) * (acc[ai][1][m][0][e] * accs) * hs, -448.f, 448.f); v[4 + e] = __builtin_amdgcn_fmed3f(g1 * sigmoid_f(g1) * (acc[ai][1][m][1][e] * accs) * hs, -448.f, 448.f); }
                u32x2v w; w.x = pk4_fp8(v[0], v[1], v[2], v[3]); w.y = pk4_fp8(v[4], v[5], v[6], v[7]);
                *(u32x2v*)(H8 + (size_t)(row0 + ai * HALF + m * 16) * ldh + col0) = w; }
    }
};

template <class Epi, class Sched, bool ALIGN_EPI = false, bool SP2 = false, bool FP8 = false>
__device__ __forceinline__ void gemm_phase(PG8_LAS unsigned char* lds, const Gemm g, const Sched& S, const Epi& E) {
    const int tid = ltid(), wid = __builtin_amdgcn_readfirstlane(tid >> 6), lane = tid & 63, wr = wid >> 2, wc = wid & 3, fr = lane & 15, fq = lane >> 4;
    const int K = g.K, rowb = FP8 ? K : 2 * K, nt = rowb / (2 * BK);
    unsigned voffA[2], voffB[2];
#define PG8_VOFF() do { int t_ = tid; if constexpr (FP8) asm volatile("" : "+v"(t_));     \
    _Pragma("unroll") for (int i = 0; i < 2; ++i) { int R, C; stage_rc(t_ * 16 + i * 8192, R, C); const int Rb = Epi::PERM ? ((R & ~31) + perm32(R & 31)) : R; \
        voffA[i] = (unsigned)(R * rowb + C * 2); voffB[i] = (unsigned)(Rb * rowb + C * 2); } } while (0)
    PG8_VOFF();
    const size_t kstep = (size_t)(BK * 2);
    const size_t hstep = (size_t)HALF * rowb;
    const size_t tstep = 2 * hstep;
    const unsigned ldsw = (unsigned)wid * 1024u;
    const int aoff = lds_byte(wr * 64 + fr, fq * 8), boff = lds_byte(wc * 32 + fr, fq * 8);
#define PG8_SA(b, h) (((b) * 2 + (h)) * HTB)
#define PG8_SB(b, h) ((4 + (b) * 2 + (h)) * HTB)
#define PG8_STAGE(bufoff, gbase, voff) do { _Pragma("unroll") for (int _i = 0; _i < 2; ++_i) { unsigned vo_ = (voff)[_i]; if constexpr (FP8) asm volatile("" : "+v"(vo_));     \
        __builtin_amdgcn_global_load_lds((const unsigned*)((const char*)(gbase) + vo_), (PG8_LAS unsigned*)(lds + (bufoff) + ldsw + _i * 8192), 16, 0, 0); } } while (0)
#define PG8_LDF(f, base) do { if constexpr (FP8) { const i32x4_t l0_ = *(const PG8_LAS i32x4_t*)(base), l1_ = *(const PG8_LAS i32x4_t*)((base) + 1024); f.w = __builtin_shufflevector(l0_, l1_, 0, 1, 2, 3, 4, 5, 6, 7); } \
        else { f.h[0] = *(const PG8_LAS bf16x8*)(base); f.h[1] = *(const PG8_LAS bf16x8*)((base) + 1024); } } while (0)
#define PG8_LDA(dst, b, h) do { _Pragma("unroll") for (int m = 0; m < 4; ++m) PG8_LDF(dst[m], lds + PG8_SA(b, h) + aoff + m * 2048); } while (0)
#define PG8_LDB(dst, b, h) do { _Pragma("unroll") for (int n = 0; n < 2; ++n) PG8_LDF(dst[n], lds + PG8_SB(b, h) + boff + n * 2048); } while (0)
#define PG8_MMA(ai, bj, At, Bt) do { __builtin_amdgcn_s_setprio(1); _Pragma("unroll") for (int m = 0; m < 4; ++m) _Pragma("unroll") for (int n = 0; n < 2; ++n) { \
        if constexpr (FP8) acc[ai][bj][m][n] = __builtin_amdgcn_mfma_scale_f32_16x16x128_f8f6f4(Bt[n].w, At[m].w, acc[ai][bj][m][n], 0, 0, 0, 0, 0, 0);     \
        else { _Pragma("unroll") for (int k = 0; k < 2; ++k) acc[ai][bj][m][n] = __builtin_amdgcn_mfma_f32_16x16x32_bf16(Bt[n].h[k], At[m].h[k], acc[ai][bj][m][n], 0, 0, 0); } } \
        __builtin_amdgcn_s_setprio(0); } while (0)
#define PG8_WAIT_V(n) asm volatile("s_waitcnt vmcnt(" #n ")" ::: "memory")
#define PG8_WAIT_L(n) asm volatile("s_waitcnt lgkmcnt(" #n ")" ::: "memory")
#define PG8_BAR __builtin_amdgcn_s_barrier()
#define PG8_SCHED __builtin_amdgcn_sched_barrier(0)
    Unit cur, nxt; int ui = 0;
    if (!S.next(0, cur)) return;
    f32x4 acc[2][2][4][2];
#pragma unroll
    for (int a = 0; a < 2; ++a)
#pragma unroll
        for (int b = 0; b < 2; ++b)
#pragma unroll
            for (int m = 0; m < 4; ++m)
#pragma unroll
                for (int n = 0; n < 2; ++n) acc[a][b][m][n] = (f32x4){0.f, 0.f, 0.f, 0.f};
    typedef int i32x8_t __attribute__((ext_vector_type(8))); typedef int i32x4_t __attribute__((ext_vector_type(4)));
    struct Frag { bf16x8 h[2]; i32x8_t w; };
    Frag At[4], B0[2], B1[2];
    const char* cA = (const char*)g.A + (size_t)cur.pm * tstep; const char* cB = (const char*)g.Bt + (size_t)cur.pn * tstep;
    S.a_ready(cur);
    if constexpr (SP2) {
        PG8_STAGE(PG8_SB(0, 0), cB, voffB); PG8_STAGE(PG8_SB(0, 1), cB + hstep, voffB); PG8_STAGE(PG8_SA(0, 0), cA, voffA); PG8_STAGE(PG8_SA(0, 1), cA + hstep, voffA);
        if (wr == 1) PG8_BAR;
        PG8_WAIT_V(2); PG8_BAR;
        PG8_STAGE(PG8_SB(1, 0), cB + kstep, voffB); PG8_STAGE(PG8_SA(1, 0), cA + kstep, voffA); PG8_STAGE(PG8_SB(1, 1), cB + hstep + kstep, voffB);
        PG8_WAIT_V(6); PG8_BAR;
    } else {
        PG8_STAGE(PG8_SB(0, 0), cB, voffB); PG8_STAGE(PG8_SA(0, 0), cA, voffA); PG8_STAGE(PG8_SB(0, 1), cB + hstep, voffB); PG8_STAGE(PG8_SA(0, 1), cA + hstep, voffA);
        if (wr == 1) PG8_BAR;
        PG8_WAIT_V(4); PG8_BAR;
        PG8_STAGE(PG8_SB(1, 0), cB + kstep, voffB); PG8_STAGE(PG8_SA(1, 0), cA + kstep, voffA); PG8_STAGE(PG8_SB(1, 1), cB + hstep + kstep, voffB);
        PG8_WAIT_V(6); PG8_BAR;
    }
    for (;;) {
        const bool has_next = S.next(ui + 1, nxt);
        const char* nA = has_next ? (const char*)g.A + (size_t)nxt.pm * tstep : cA; const char* nB = has_next ? (const char*)g.Bt + (size_t)nxt.pn * tstep : cB;
        for (int t = 0; t < nt; t += 2) {
            const bool last = (t == nt - 2);
            const char* a1 = cA + (size_t)(t + 1) * kstep;
            const char* a2 = last ? nA : cA + (size_t)(t + 2) * kstep; const char* b2 = last ? nB : cB + (size_t)(t + 2) * kstep;
            const char* a3 = a2 + kstep; const char* b3 = b2 + kstep;
            if (last && has_next) S.a_ready(nxt);
            if constexpr (SP2) {
            PG8_LDB(B0, 0, 0); PG8_LDB(B1, 0, 1); PG8_SCHED; PG8_LDA(At, 0, 0); PG8_STAGE(PG8_SA(1, 1), a1 + hstep, voffA);
            PG8_WAIT_V(8); PG8_WAIT_L(0); PG8_BAR; PG8_MMA(0, 0, At, B0); PG8_MMA(0, 1, At, B1); PG8_BAR; PG8_SCHED;
            PG8_LDA(At, 0, 1); PG8_STAGE(PG8_SB(0, 0), b2, voffB); PG8_STAGE(PG8_SB(0, 1), b2 + hstep, voffB); PG8_STAGE(PG8_SA(0, 0), a2, voffA);
            PG8_WAIT_V(8); PG8_WAIT_L(0); PG8_BAR; PG8_MMA(1, 0, At, B0); PG8_MMA(1, 1, At, B1); PG8_BAR; PG8_SCHED;
            PG8_LDB(B0, 1, 0); PG8_LDB(B1, 1, 1); PG8_SCHED; PG8_LDA(At, 1, 0); PG8_STAGE(PG8_SA(0, 1), a2 + hstep, voffA);
            PG8_WAIT_V(8); PG8_WAIT_L(0); PG8_BAR; PG8_MMA(0, 0, At, B0); PG8_MMA(0, 1, At, B1); PG8_BAR; PG8_SCHED;
            PG8_LDA(At, 1, 1); PG8_STAGE(PG8_SB(1, 0), b3, voffB); PG8_STAGE(PG8_SB(1, 1), b3 + hstep, voffB); PG8_STAGE(PG8_SA(1, 0), a3, voffA);
            PG8_WAIT_V(8); PG8_WAIT_L(0); PG8_BAR; PG8_MMA(1, 0, At, B0); PG8_MMA(1, 1, At, B1); PG8_BAR; PG8_SCHED;
            } else {
            PG8_LDB(B0, 0, 0); PG8_SCHED; PG8_LDA(At, 0, 0); PG8_STAGE(PG8_SA(1, 1), a1 + hstep, voffA);
            PG8_WAIT_L(8); PG8_BAR; PG8_WAIT_L(0); PG8_MMA(0, 0, At, B0); PG8_BAR; PG8_SCHED;
            PG8_LDB(B1, 0, 1); PG8_STAGE(PG8_SB(0, 0), b2, voffB);
            PG8_BAR; PG8_WAIT_L(0); PG8_MMA(0, 1, At, B1); PG8_BAR;
            PG8_LDA(At, 0, 1); PG8_STAGE(PG8_SA(0, 0), a2, voffA);
            PG8_BAR; PG8_WAIT_L(0); PG8_MMA(1, 0, At, B0); PG8_BAR; PG8_SCHED;
            PG8_STAGE(PG8_SB(0, 1), b2 + hstep, voffB);
            PG8_WAIT_V(6); PG8_BAR; PG8_MMA(1, 1, At, B1); PG8_BAR;
            PG8_LDB(B0, 1, 0); PG8_SCHED; PG8_LDA(At, 1, 0); PG8_STAGE(PG8_SA(0, 1), a2 + hstep, voffA);
            PG8_WAIT_L(8); PG8_BAR; PG8_WAIT_L(0); PG8_MMA(0, 0, At, B0); PG8_BAR; PG8_SCHED;
            PG8_LDB(B1, 1, 1); PG8_STAGE(PG8_SB(1, 0), b3, voffB);
            PG8_BAR; PG8_WAIT_L(0); PG8_MMA(0, 1, At, B1); PG8_BAR;
            PG8_LDA(At, 1, 1); PG8_STAGE(PG8_SA(1, 0), a3, voffA);
            PG8_BAR; PG8_WAIT_L(0); PG8_MMA(1, 0, At, B0); PG8_BAR; PG8_SCHED;
            PG8_STAGE(PG8_SB(1, 1), b3 + hstep, voffB);
            PG8_WAIT_V(6); PG8_BAR; PG8_MMA(1, 1, At, B1); PG8_BAR;
            }
        }
        if constexpr (ALIGN_EPI) { if (wr == 0) PG8_BAR; }
        if constexpr (!Epi::AFTER_DRAIN) { E(acc, cur, wr, wc, fr, fq); S.done(cur); }
        if (!has_next) break;
#pragma unroll
        for (int a = 0; a < 2; ++a)
#pragma unroll
            for (int b = 0; b < 2; ++b)
#pragma unroll
                for (int m = 0; m < 4; ++m)
#pragma unroll
                    for (int n = 0; n < 2; ++n) acc[a][b][m][n] = (f32x4){0.f, 0.f, 0.f, 0.f};
        cur = nxt; cA = nA; cB = nB; ++ui;
        if constexpr (ALIGN_EPI) { if (wr == 1) PG8_BAR; }
    }
    PG8_WAIT_V(0);
    if constexpr (!ALIGN_EPI) { if (wr == 0) PG8_BAR; }
    PG8_BAR;
    if constexpr (Epi::AFTER_DRAIN) { E.fused(acc, cur, wr, wc, fr, fq, lds, wid, lane); S.done(cur); }
#undef PG8_SA
#undef PG8_SB
#undef PG8_STAGE
#undef PG8_LDA
#undef PG8_LDB
#undef PG8_LDF
#undef PG8_VOFF
#undef PG8_MMA
#undef PG8_WAIT_V
#undef PG8_WAIT_L
#undef PG8_BAR
#undef PG8_SCHED
}
}

__device__ __forceinline__ void cvt_phase(const P& p, int wg, int nwg) {
    bf16_t* XB = WSP(bf16_t, WS_XB);
    const size_t n4 = (size_t)M * D / 4;
    const int tid = ltid();
    for (size_t i = (size_t)wg * NT + tid; i < n4; i += (size_t)nwg * NT) {
        const f32x4 v = ((const f32x4*)p.x)[i];
        u32x2 o; o.x = f2bf(v.x) | (f2bf(v.y) << 16); o.y = f2bf(v.z) | (f2bf(v.w) << 16);
        ((u32x2*)XB)[i] = o;
        ((unsigned*)WSP(unsigned char, WS_XF8))[i] = pk4_fp8(v.x, v.y, v.z, v.w);
    }
}

__device__ __forceinline__ void cum_phase(const P& p, LAS unsigned char* lds, int wg, int nwg) {
    const float* FL = WSP(const float, WS_FL); float* CUM = WSP(float, WS_CUM);
    LAS float* wsum = (LAS float*)lds;
    const int tid = ltid(), lane = tid & 63, wv = tid >> 6;
    for (int it = wg; it < NB * NH; it += nwg) {
        const int b = it / NH, h = it % NH;
        float v[8]; float s = 0.f;
#pragma unroll
        for (int j = 0; j < 8; ++j) { const int t = tid * 8 + j; const float z = FL[((size_t)b * L + t) * 8 + h];
            const float ls = fminf(z, 0.f) - log1pf(__expf(-fabsf(z))); s += ls; v[j] = s; }
        float incl = s;
#pragma unroll
        for (int o = 1; o < 64; o <<= 1) { const float u = __shfl_up(incl, o); if (lane >= o) incl += u; }
        if (lane == 63) wsum[wv] = incl;
        __syncthreads();
        float base = incl - s;
        for (int w = 0; w < wv; ++w) base += wsum[w];
#pragma unroll
        for (int j = 0; j < 8; ++j) CUM[((size_t)b * NH + h) * L + tid * 8 + j] = base + v[j];
        __syncthreads();
    }
}

__device__ __forceinline__ void norm_phase(const P& p, unsigned* kmax2, float* qmax2, int wg, int nwg) {
    const int tid = ltid(), lane = tid & 63;
    for (int it = wg; it < 512; it += nwg) {
        const int mixer = it >> 8, bh = (it >> 2) & 63, qt = it & 3, b = bh >> 3, h = bh & 7;
        const bf16_t* Q = mixer ? WSP(const bf16_t, WS_DQ) : WSP(const bf16_t, WS_FQ); const bf16_t* K = mixer ? WSP(const bf16_t, WS_DK) : WSP(const bf16_t, WS_FK);
        float qm = 0.f, km = 0.f;
#pragma unroll
        for (int j = 0; j < 2; ++j) {
            const size_t row = (size_t)b * L + qt * 1024 + tid * 2 + j;
            const u32x4* qr = (const u32x4*)(Q + row * 512 + h * 64); const u32x4* kr = (const u32x4*)(K + row * 512 + h * 64);
            float qs = 0.f, ks = 0.f;
#pragma unroll
            for (int c = 0; c < 8; ++c) { const u32x4 a = qr[c], d = kr[c];
                const float q0 = bf2f(a.x & 0xffffu), q1 = __uint_as_float(a.x & 0xffff0000u), q2 = bf2f(a.y & 0xffffu), q3 = __uint_as_float(a.y & 0xffff0000u), q4 = bf2f(a.z & 0xffffu), q5 = __uint_as_float(a.z & 0xffff0000u), q6 = bf2f(a.w & 0xffffu), q7 = __uint_as_float(a.w & 0xffff0000u);
                const float k0 = bf2f(d.x & 0xffffu), k1 = __uint_as_float(d.x & 0xffff0000u), k2 = bf2f(d.y & 0xffffu), k3 = __uint_as_float(d.y & 0xffff0000u), k4 = bf2f(d.z & 0xffffu), k5 = __uint_as_float(d.z & 0xffff0000u), k6 = bf2f(d.w & 0xffffu), k7 = __uint_as_float(d.w & 0xffff0000u);
                qs += (q0 * q0 + q1 * q1) + (q2 * q2 + q3 * q3) + (q4 * q4 + q5 * q5) + (q6 * q6 + q7 * q7);
                ks += (k0 * k0 + k1 * k1) + (k2 * k2 + k3 * k3) + (k4 * k4 + k5 * k5) + (k6 * k6 + k7 * k7); }
            qm = fmaxf(qm, qs); km = fmaxf(km, ks);
        }
#pragma unroll
        for (int o = 1; o < 64; o <<= 1) { qm = fmaxf(qm, __shfl_xor(qm, o)); km = fmaxf(km, __shfl_xor(km, o)); }
        if (lane == 0) {
            __hip_atomic_fetch_max((unsigned*)qmax2 + (mixer * 64 + bh) * 16 + qt * 4 + (tid >> 7), __float_as_uint(qm * 1.01f), __ATOMIC_RELAXED, __HIP_MEMORY_SCOPE_AGENT);
            __hip_atomic_fetch_max(kmax2 + mixer * 64 + bh, __float_as_uint(km * 1.01f), __ATOMIC_RELAXED, __HIP_MEMORY_SCOPE_AGENT);
        }
    }
}

__device__ __forceinline__ void ln_phase(const bf16_t* Y, const float* g, const float* bta, bf16_t* XO, float* FO, int wg, int nwg, unsigned char* X8 = nullptr) {
    const int tid = ltid(), lane = tid & 63, wv = tid >> 6;
    for (int m = wg * 8 + wv; m < M; m += nwg * 8) {
        const u32x4* yr = (const u32x4*)(Y + (size_t)m * D) + 2 * lane;
        const u32x4 a = yr[0], b = yr[1];
        float v[16] = {bf2f(a.x & 0xffffu), __uint_as_float(a.x & 0xffff0000u), bf2f(a.y & 0xffffu), __uint_as_float(a.y & 0xffff0000u), bf2f(a.z & 0xffffu), __uint_as_float(a.z & 0xffff0000u), bf2f(a.w & 0xffffu), __uint_as_float(a.w & 0xffff0000u),
                       bf2f(b.x & 0xffffu), __uint_as_float(b.x & 0xffff0000u), bf2f(b.y & 0xffffu), __uint_as_float(b.y & 0xffff0000u), bf2f(b.z & 0xffffu), __uint_as_float(b.z & 0xffff0000u), bf2f(b.w & 0xffffu), __uint_as_float(b.w & 0xffff0000u)};
        float s = 0.f;
#pragma unroll
        for (int j = 0; j < 16; ++j) s += v[j];
#pragma unroll
        for (int o = 1; o < 64; o <<= 1) s += __shfl_xor(s, o);
        const float mean = s * (1.f / D); float s2 = 0.f;
#pragma unroll
        for (int j = 0; j < 16; ++j) { v[j] -= mean; s2 += v[j] * v[j]; }
#pragma unroll
        for (int o = 1; o < 64; o <<= 1) s2 += __shfl_xor(s2, o);
        const float rstd = 1.f / sqrtf(s2 * (1.f / D) + LN_EPS);
        const f32x4* gp = (const f32x4*)g + 4 * lane; const f32x4* bp = (const f32x4*)bta + 4 * lane;
        f32x4 o4[4];
#pragma unroll
        for (int j = 0; j < 4; ++j) { const f32x4 gg = gp[j], bb = bp[j]; o4[j] = (f32x4){v[4 * j], v[4 * j + 1], v[4 * j + 2], v[4 * j + 3]} * rstd * gg + bb; }
        if (XO) { u32x4 w0, w1;
            w0.x = f2bf(o4[0].x) | (f2bf(o4[0].y) << 16); w0.y = f2bf(o4[0].z) | (f2bf(o4[0].w) << 16); w0.z = f2bf(o4[1].x) | (f2bf(o4[1].y) << 16); w0.w = f2bf(o4[1].z) | (f2bf(o4[1].w) << 16);
            w1.x = f2bf(o4[2].x) | (f2bf(o4[2].y) << 16); w1.y = f2bf(o4[2].z) | (f2bf(o4[2].w) << 16); w1.z = f2bf(o4[3].x) | (f2bf(o4[3].y) << 16); w1.w = f2bf(o4[3].z) | (f2bf(o4[3].w) << 16);
            u32x4* xo = (u32x4*)(XO + (size_t)m * D) + 2 * lane; xo[0] = w0; xo[1] = w1;
            if (X8) { u32x4 q; q.x = pk4_fp8(o4[0].x, o4[0].y, o4[0].z, o4[0].w); q.y = pk4_fp8(o4[1].x, o4[1].y, o4[1].z, o4[1].w); q.z = pk4_fp8(o4[2].x, o4[2].y, o4[2].z, o4[2].w); q.w = pk4_fp8(o4[3].x, o4[3].y, o4[3].z, o4[3].w);
                *((u32x4*)(X8 + (size_t)m * D) + lane) = q; } }
        else { f32x4* fo = (f32x4*)(FO + (size_t)m * D) + 4 * lane;
#pragma unroll
            for (int j = 0; j < 4; ++j) fo[j] = o4[j]; }
    }
}

__device__ __forceinline__ unsigned sortable(float f) { const unsigned u = __float_as_uint(f); return (u & 0x80000000u) ? ~u : (u | 0x80000000u); }
__device__ __forceinline__ unsigned wg_sum(unsigned c, LAS unsigned* buf, int par, int tid) {
#pragma unroll
    for (int o = 1; o < 64; o <<= 1) c += __shfl_xor(c, o);
    if ((tid & 63) == 0) buf[par * 8 + (tid >> 6)] = c;
    __syncthreads();
    unsigned s = 0;
#pragma unroll
    for (int w = 0; w < 8; ++w) s += buf[par * 8 + w];
    return s;
}
__device__ __forceinline__ void idx_phase(const P& p, LAS unsigned char* lds, int wg, int nwg) {
    const bf16_t* IQ = WSP(const bf16_t, WS_IQ); const bf16_t* IK = WSP(const bf16_t, WS_IK); const float* IW = WSP(const float, WS_IW);
    unsigned* MASK = WSP(unsigned, WS_MASK);
    LAS float* iqs = (LAS float*)lds;
    LAS float* wv = iqs + 512;
    LAS unsigned* cbuf = (LAS unsigned*)(wv + 8);
    LAS unsigned* wtot = cbuf + 16;
    LAS unsigned char* bytes = (LAS unsigned char*)(wtot + 8);
    LAS unsigned* sc = (LAS unsigned*)(bytes + 512);
    const int tid = ltid(), lane = tid & 63, wave = tid >> 6;
    for (int row = wg; row < M; row += nwg) {
        const int b = row / L, t = row % L, n = t + 1;
        iqs[tid] = bf2f(IQ[(size_t)row * 512 + tid]);
        if (tid < 8) wv[tid] = IW[(size_t)row * 8 + tid] * IDX_SCALE;
        __syncthreads();
        for (int s = tid; s < L; s += NT) {
            unsigned key = 0u;
            if (s < n) {
                float kf[64];
                const u32x4* kr = (const u32x4*)(IK + ((size_t)b * L + s) * 64);
#pragma unroll
                for (int c = 0; c < 8; ++c) { const u32x4 v = kr[c];
                    kf[c * 8 + 0] = bf2f(v.x & 0xffffu); kf[c * 8 + 1] = bf2f(v.x >> 16); kf[c * 8 + 2] = bf2f(v.y & 0xffffu); kf[c * 8 + 3] = bf2f(v.y >> 16);
                    kf[c * 8 + 4] = bf2f(v.z & 0xffffu); kf[c * 8 + 5] = bf2f(v.z >> 16); kf[c * 8 + 6] = bf2f(v.w & 0xffffu); kf[c * 8 + 7] = bf2f(v.w >> 16); }
                float score = 0.f;
#pragma unroll 1
                for (int h = 0; h < 8; ++h) {
                    float d0 = 0.f, d1 = 0.f;
#pragma unroll
                    for (int d = 0; d < 64; d += 4) { const f32x4 q = *(const LAS f32x4*)(iqs + h * 64 + d);
                        d0 = fmaf(q.x, kf[d], d0); d1 = fmaf(q.y, kf[d + 1], d1); d0 = fmaf(q.z, kf[d + 2], d0); d1 = fmaf(q.w, kf[d + 3], d1); }
                    score = fmaf(wv[h], fmaxf(d0 + d1, 0.f), score);
                }
                key = sortable(score + 0.f);
                if (key == 0u) key = 1u;
            }
            sc[s] = key;
        }
        __syncthreads();
        unsigned k8[8];
#pragma unroll
        for (int j = 0; j < 8; ++j) k8[j] = sc[tid * 8 + j];
        unsigned bits = 0u;
        if (n <= TOPK) {
#pragma unroll
            for (int j = 0; j < 8; ++j) if (tid * 8 + j < n) bits |= 1u << j;
        } else {
            unsigned T = 0u; int par = 0;
            for (int bit = 31; bit >= 0; --bit) {
                const unsigned cand = T | (1u << bit); unsigned c = 0;
#pragma unroll
                for (int j = 0; j < 8; ++j) c += (k8[j] >= cand) ? 1u : 0u;
                if (wg_sum(c, cbuf, par, tid) >= (unsigned)TOPK) T = cand;
                par ^= 1;
            }
            unsigned cg = 0, ce = 0;
#pragma unroll
            for (int j = 0; j < 8; ++j) { cg += (k8[j] > T) ? 1u : 0u; ce += (k8[j] == T) ? 1u : 0u; }
            const unsigned G = wg_sum(cg, cbuf, par, tid); par ^= 1;
            const unsigned E = (unsigned)TOPK - G;
            unsigned incl = ce;
#pragma unroll
            for (int o = 1; o < 64; o <<= 1) { const unsigned u = __shfl_up(incl, o); if (lane >= o) incl += u; }
            if (lane == 63) wtot[wave] = incl;
            __syncthreads();
            unsigned rank = incl - ce;
            for (int w = 0; w < wave; ++w) rank += wtot[w];
#pragma unroll
            for (int j = 0; j < 8; ++j) {
                if (k8[j] > T) bits |= 1u << j;
                else if (k8[j] == T) { if (rank < E) bits |= 1u << j; ++rank; }
            }
        }
        bytes[tid] = (unsigned char)bits;
        __syncthreads();
        if (tid < 128) MASK[(size_t)row * 128 + tid] = ((const LAS unsigned*)bytes)[tid];
        __syncthreads();
    }
}

template <bool DSA>
__device__ __forceinline__ void attn_item(const P& p, int item) {
    const int qc = item & 7, h = (item >> 3) & 7, b = item >> 6;
    const int t = qc * 512 + ltid();
    const size_t row = (size_t)b * L + t;
    const bf16_t* Q = DSA ? WSP(const bf16_t, WS_DQ) : WSP(const bf16_t, WS_FQ);
    const bf16_t* K = DSA ? WSP(const bf16_t, WS_DK) : WSP(const bf16_t, WS_FK);
    const bf16_t* V = DSA ? WSP(const bf16_t, WS_DV) : WSP(const bf16_t, WS_FV);
    bf16_t* O = DSA ? WSP(bf16_t, WS_OB) : WSP(bf16_t, WS_OA);
    const float* cum = WSP(const float, WS_CUM) + ((size_t)b * NH + h) * L;
    const unsigned* mrow = WSP(const unsigned, WS_MASK) + row * 128;
    float q[64], o[64];
    {
        const u32x4* qr = (const u32x4*)(Q + row * 512 + h * 64);
#pragma unroll
        for (int c = 0; c < 8; ++c) { const u32x4 v = qr[c];
            q[c * 8 + 0] = bf2f(v.x & 0xffffu); q[c * 8 + 1] = bf2f(v.x >> 16); q[c * 8 + 2] = bf2f(v.y & 0xffffu); q[c * 8 + 3] = bf2f(v.y >> 16);
            q[c * 8 + 4] = bf2f(v.z & 0xffffu); q[c * 8 + 5] = bf2f(v.z >> 16); q[c * 8 + 6] = bf2f(v.w & 0xffffu); q[c * 8 + 7] = bf2f(v.w >> 16); }
    }
#pragma unroll
    for (int d = 0; d < 64; ++d) o[d] = 0.f;
    float mx = -1e30f, l = 0.f;
    const float ct = DSA ? 0.f : cum[t] * LOG2E;
    const float slope2 = exp2f(-(float)(h + 1)) * LOG2E;
    const int tmax = __builtin_amdgcn_readfirstlane(t | 63);
    const bf16_t* Kh = K + (size_t)b * L * 512 + h * 64;
    const bf16_t* Vh = V + (size_t)b * L * 512 + h * 64;
    for (int s0 = 0; s0 <= tmax; s0 += 2) {
        float xv[2]; bool ok[2];
        const unsigned mb = DSA ? (mrow[s0 >> 5] >> (s0 & 31)) : 0x3u;
#pragma unroll
        for (int j = 0; j < 2; ++j) {
            const int s = s0 + j;
            const u32x4* kr = (const u32x4*)(Kh + (size_t)s * 512);
            float d0 = 0.f, d1 = 0.f;
#pragma unroll
            for (int c = 0; c < 8; ++c) { const u32x4 v = kr[c];
                d0 = fmaf(q[c * 8 + 0], bf2f(v.x & 0xffffu), d0); d1 = fmaf(q[c * 8 + 1], bf2f(v.x >> 16), d1);
                d0 = fmaf(q[c * 8 + 2], bf2f(v.y & 0xffffu), d0); d1 = fmaf(q[c * 8 + 3], bf2f(v.y >> 16), d1);
                d0 = fmaf(q[c * 8 + 4], bf2f(v.z & 0xffffu), d0); d1 = fmaf(q[c * 8 + 5], bf2f(v.z >> 16), d1);
                d0 = fmaf(q[c * 8 + 6], bf2f(v.w & 0xffffu), d0); d1 = fmaf(q[c * 8 + 7], bf2f(v.w >> 16), d1); }
            const float dot = d0 + d1;
            ok[j] = (s <= t) && ((mb >> j) & 1u);
            const float xx = DSA ? (dot - slope2 * (float)(t - s)) : (dot + (ct - cum[s] * LOG2E));
            xv[j] = ok[j] ? xx : -1e30f;
        }
        const float mnew = fmaxf(fmaxf(xv[0], xv[1]), mx);
        const float alpha = exp2f(mx - mnew);
        mx = mnew; l *= alpha;
#pragma unroll
        for (int d = 0; d < 64; ++d) o[d] *= alpha;
#pragma unroll
        for (int j = 0; j < 2; ++j) {
            const int s = s0 + j;
            const float pj = ok[j] ? exp2f(xv[j] - mnew) : 0.f;
            l += pj;
            const u32x4* vr = (const u32x4*)(Vh + (size_t)s * 512);
#pragma unroll
            for (int c = 0; c < 8; ++c) { const u32x4 v = vr[c];
                o[c * 8 + 0] = fmaf(pj, bf2f(v.x & 0xffffu), o[c * 8 + 0]); o[c * 8 + 1] = fmaf(pj, bf2f(v.x >> 16), o[c * 8 + 1]);
                o[c * 8 + 2] = fmaf(pj, bf2f(v.y & 0xffffu), o[c * 8 + 2]); o[c * 8 + 3] = fmaf(pj, bf2f(v.y >> 16), o[c * 8 + 3]);
                o[c * 8 + 4] = fmaf(pj, bf2f(v.z & 0xffffu), o[c * 8 + 4]); o[c * 8 + 5] = fmaf(pj, bf2f(v.z >> 16), o[c * 8 + 5]);
                o[c * 8 + 6] = fmaf(pj, bf2f(v.w & 0xffffu), o[c * 8 + 6]); o[c * 8 + 7] = fmaf(pj, bf2f(v.w >> 16), o[c * 8 + 7]); }
        }
    }
    const float rl = 1.f / l;
    u32x4* orow = (u32x4*)(O + row * 512 + h * 64);
#pragma unroll
    for (int c = 0; c < 8; ++c) { u32x4 w;
        w.x = f2bf(o[c * 8 + 0] * rl) | (f2bf(o[c * 8 + 1] * rl) << 16); w.y = f2bf(o[c * 8 + 2] * rl) | (f2bf(o[c * 8 + 3] * rl) << 16);
        w.z = f2bf(o[c * 8 + 4] * rl) | (f2bf(o[c * 8 + 5] * rl) << 16); w.w = f2bf(o[c * 8 + 6] * rl) | (f2bf(o[c * 8 + 7] * rl) << 16);
        orow[c] = w; }
}
__device__ __forceinline__ void attn_phase_naive(const P& p, int wg, int nwg) {
    for (int it = wg; it < 1024; it += nwg) {
        const int r = it >> 1; const int item = (r & ~7) | (7 - (r & 7));
        if (it & 1) attn_item<true>(p, item); else attn_item<false>(p, item);
    }
}

#include <hip/hip_bf16.h>
#include <cmath>
namespace attn_body {
using bf16=__hip_bfloat16;
using bf16x8=__attribute__((ext_vector_type(8)))short;
using s16x4=__attribute__((ext_vector_type(4)))short;
using f32x16=__attribute__((ext_vector_type(16)))float;
using u32x4=__attribute__((ext_vector_type(4)))unsigned;
typedef float f32x4_t __attribute__((ext_vector_type(4)));
constexpr int BATCH=8,NHEAD=8,SEQ=4096,D=64,DM=NHEAD*D;
constexpr int NW=8,QBLK=32,QB=QBLK*NW,KVBLK=64,NQB=SEQ/QB;
constexpr int ATTN_PITCH=DM, ATTN_UNIT_ROWS=QB;
__device__ __forceinline__ int crow(int r,int hi){return (r&3)+8*(r>>2)+4*hi;}
#define SBAR() __builtin_amdgcn_sched_barrier(0)
__device__ __forceinline__ void cmask(f32x16&p0,f32x16&p1,int jb,int qrel,int hi){
  const float NEG=-INFINITY; int kb=64*jb+4*hi;
  #pragma unroll
  for(int r=0;r<16;++r){int kv=kb+(r&3)+8*(r>>2); if(kv>qrel)p0[r]=NEG; if(kv+32>qrel)p1[r]=NEG;}
}

constexpr int NSLOT=3, SLOTB=8192;
constexpr int LDS_K=0, LDS_V=NSLOT*SLOTB, LDS_WS=2*NSLOT*SLOTB, LDS_OST=LDS_WS+NW*64*4, LDS_TAB=LDS_OST+NW*4096, LDS_BYTES=LDS_TAB+SEQ*4;
constexpr float C2=0.125f*1.4426950408889634f;
__device__ __forceinline__ void glds16(const void*gsrc,unsigned lds_dst){unsigned keep;
  asm volatile("s_mov_b32 %0, m0\n\ts_mov_b32 m0, %2\n\ts_nop 0\n\tglobal_load_lds_dwordx4 %1, off\n\ts_mov_b32 m0, %0":"=&s"(keep):"v"(gsrc),"s"(lds_dst):"memory");}
__device__ __forceinline__ float max3f(float a,float b,float c){float r;asm("v_max3_f32 %0, %1, %2, %3":"=v"(r):"v"(a),"v"(b),"v"(c));return r;}
__device__ __forceinline__ float max2f(float a,float b){float r;asm("v_max_f32_e32 %0, %1, %2":"=v"(r):"v"(a),"v"(b));return r;}
__device__ __forceinline__ float fadd_s(float a,float b){float r;asm("v_add_f32_e32 %0, %1, %2":"=v"(r):"v"(a),"v"(b));return r;}
__device__ __forceinline__ float fsub_s(float a,float b){float r;asm("v_sub_f32_e32 %0, %1, %2":"=v"(r):"v"(a),"v"(b));return r;}
typedef float f32x2_t __attribute__((ext_vector_type(2))); typedef __bf16 bf16x2_t __attribute__((ext_vector_type(2)));
__device__ __forceinline__ unsigned cvtpk_s(float lo,float hi){f32x2_t v={lo,hi};bf16x2_t b=__builtin_convertvector(v,bf16x2_t);return __builtin_bit_cast(unsigned,b);}
#define WAIT_BAR(N) asm volatile("s_waitcnt vmcnt(" #N ") lgkmcnt(0)\n\ts_barrier":::"memory")

__device__ __forceinline__ void qkt(f32x16&p0,f32x16&p1,const char*Kslot,const bf16x8*qr,const f32x16&negm,int r32,int hi){
  const char*kb=Kslot+hi*1024+r32*16;
  #pragma unroll
  for(int d0=0;d0<4;++d0){
    const bf16x8 b0=*reinterpret_cast<const bf16x8*>(kb+d0*2048);
    const bf16x8 b1=*reinterpret_cast<const bf16x8*>(kb+d0*2048+512);
    if(d0==0){p0=__builtin_amdgcn_mfma_f32_32x32x16_bf16(b0,qr[0],negm,0,0,0);p1=__builtin_amdgcn_mfma_f32_32x32x16_bf16(b1,qr[0],negm,0,0,0);}
    else{p0=__builtin_amdgcn_mfma_f32_32x32x16_bf16(b0,qr[d0],p0,0,0,0);p1=__builtin_amdgcn_mfma_f32_32x32x16_bf16(b1,qr[d0],p1,0,0,0);}}
}
typedef __attribute__((address_space(3))) const char* lds_cptr;
typedef short v4i16_t __attribute__((ext_vector_type(4)));
__device__ __forceinline__ void kload8(bf16x8*kf,lds_cptr kp){
  kf[0]=*(const __attribute__((address_space(3))) bf16x8*)(kp);      kf[1]=*(const __attribute__((address_space(3))) bf16x8*)(kp+512);
  kf[2]=*(const __attribute__((address_space(3))) bf16x8*)(kp+2048); kf[3]=*(const __attribute__((address_space(3))) bf16x8*)(kp+2560);
  kf[4]=*(const __attribute__((address_space(3))) bf16x8*)(kp+4096); kf[5]=*(const __attribute__((address_space(3))) bf16x8*)(kp+4608);
  kf[6]=*(const __attribute__((address_space(3))) bf16x8*)(kp+6144); kf[7]=*(const __attribute__((address_space(3))) bf16x8*)(kp+6656);
}
__device__ __forceinline__ void kload2(bf16x8*kf,lds_cptr kp,int j){ kf[2*j]=*(const __attribute__((address_space(3))) bf16x8*)(kp+j*2048); kf[2*j+1]=*(const __attribute__((address_space(3))) bf16x8*)(kp+j*2048+512); }
__device__ __forceinline__ s16x4 vtr(lds_cptr p){ return __builtin_bit_cast(s16x4,__builtin_amdgcn_ds_read_tr16_b64_v4i16((__attribute__((address_space(3))) v4i16_t*)p)); }
__device__ __forceinline__ float rowmax(const f32x16&p0,const f32x16&p1){
  float a=max3f(p0[0],p0[1],p1[0]),b=max3f(p0[2],p0[3],p1[1]);a=max3f(a,p1[2],p1[3]);
  #pragma unroll
  for(int r=4;r<16;r+=4){a=max3f(a,p0[r],p0[r+1]);b=max3f(b,p0[r+2],p0[r+3]);a=max3f(a,p1[r],p1[r+1]);b=max3f(b,p1[r+2],p1[r+3]);}
  const float m=max2f(a,b);
  auto rr=__builtin_amdgcn_permlane32_swap(__float_as_uint(m),__float_as_uint(m),false,false);
  return max2f(__uint_as_float(rr[0]),__uint_as_float(rr[1]));
}
__device__ __forceinline__ void pv(f32x16*o,int vb,bf16x8 pa0,bf16x8 pa1,bf16x8 pa2,bf16x8 pa3){
  #pragma unroll
  for(int d0=0;d0<2;++d0){s16x4 lo[4],hi[4];
    #pragma unroll
    for(int ks=0;ks<4;++ks){
      asm volatile("ds_read_b64_tr_b16 %0,%1 offset:%c2":"=&v"(lo[ks]):"v"(vb),"i"(d0*4096+ks*1024):"memory");
      asm volatile("ds_read_b64_tr_b16 %0,%1 offset:%c2":"=&v"(hi[ks]):"v"(vb),"i"(d0*4096+ks*1024+512):"memory");}
    asm volatile("s_waitcnt lgkmcnt(0)":::"memory");SBAR();
    #define PK(k) (bf16x8){lo[k][0],lo[k][1],lo[k][2],lo[k][3],hi[k][0],hi[k][1],hi[k][2],hi[k][3]}
    o[d0]=__builtin_amdgcn_mfma_f32_32x32x16_bf16(pa0,PK(0),o[d0],0,0,0);
    o[d0]=__builtin_amdgcn_mfma_f32_32x32x16_bf16(pa1,PK(1),o[d0],0,0,0);
    o[d0]=__builtin_amdgcn_mfma_f32_32x32x16_bf16(pa2,PK(2),o[d0],0,0,0);
    o[d0]=__builtin_amdgcn_mfma_f32_32x32x16_bf16(pa3,PK(3),o[d0],0,0,0);
    #undef PK
  }
}

#ifndef ATTN_STORE16
#define ATTN_STORE16(p,v) (*(u32x4*)(p)=(v))
#endif
template<int THRL,bool DSA> __device__ __forceinline__ void attn_unit(int b,int h,int qb,int jstart,const bf16*Q,const bf16*__restrict__ K,const bf16*__restrict__ V,bf16*O,const unsigned*__restrict__ MASK,char*shm){
  const int tid=ltid(),lane=tid&63,r32=lane&31,hi=lane>>5; const int wid=__builtin_amdgcn_readfirstlane(tid>>6);
  const long rowbase=(long)b*SEQ; const int q0=qb*QB;
  const bf16*Qw=Q+(rowbase+q0+wid*QBLK)*DM+h*D;
  const bf16*Kh=K+(rowbase+(long)jstart*KVBLK)*DM+h*D,*Vh=V+(rowbase+(long)jstart*KVBLK)*DM+h*D;
  const unsigned lds0=(unsigned)(uintptr_t)shm;
  float*wsf=(float*)(shm+LDS_WS)+wid*64;
  const bf16*ksrc=Kh+(long)lane*DM+wid*8;
  const bf16*vsrc=Vh+(long)(16*(wid&3)+(lane>>2))*DM+(wid>>2)*32+(lane&3)*8;
  const unsigned kdst=lds0+LDS_K+wid*1024, vdst=lds0+LDS_V+wid*1024;
  #define DMA_K(t,slot) glds16(ksrc+(long)(t)*KVBLK*DM,(unsigned)__builtin_amdgcn_readfirstlane(kdst+(slot)))
  #define DMA_V(t,slot) glds16(vsrc+(long)(t)*KVBLK*DM,(unsigned)__builtin_amdgcn_readfirstlane(vdst+(slot)))
  const int vb0=(int)(lds0+LDS_V)+((lane>>4)&1)*32+(lane&3)*8+(4*hi+((lane&15)>>2))*64;
  const char*Kbase=shm+LDS_K; bf16x8 kf[8];
  const lds_cptr shm3=(lds_cptr)shm; const lds_cptr kp0=shm3+LDS_K+hi*1024+r32*16; const lds_cptr vp0=shm3+LDS_V+((lane>>4)&1)*32+(lane&3)*8+(4*hi+((lane&15)>>2))*64;
  const int NT=(q0+QB)/KVBLK-jstart;
  DMA_K(0,0);DMA_V(0,0);DMA_K(1,SLOTB);
  bf16x8 qr[4];
  #pragma unroll
  for(int d0=0;d0<4;++d0)qr[d0]=*reinterpret_cast<const bf16x8*>(&Qw[(long)r32*DM+d0*16+hi*8]);
  float mhat=0.f,l_reg=0.f;f32x16 o[2];o[0]=f32x16{};o[1]=f32x16{};f32x16 negm=f32x16{};
  const int qrel=wid*QBLK+r32;
  const __attribute__((address_space(3))) float* tabp0=(const __attribute__((address_space(3))) float*)((lds_cptr)shm+LDS_TAB); const __attribute__((address_space(3))) float* tabp=tabp0+jstart*KVBLK;
  const unsigned moff=(unsigned)((((b*(SEQ/32)+((q0+qrel)>>5))*64+jstart)*32+((q0+qrel)&31))*8);
  unsigned long long mw=0ull;
  #define CMASK(P0,P1,t) do{ if(!DSA){int jb_=(t)-(NT-4); if(jb_>=0)cmask(P0,P1,jb_,qrel,hi);} }while(0)
  #define BIAS(P0,P1,t) do{ const __attribute__((address_space(3))) float* tb_=tabp+(t)*64+4*hi; \
    _Pragma("unroll") for(int g_=0;g_<4;++g_){ const f32x4_t a_=*(const __attribute__((address_space(3))) f32x4_t*)(tb_+8*g_), b_=*(const __attribute__((address_space(3))) f32x4_t*)(tb_+32+8*g_); \
      _Pragma("unroll") for(int e_=0;e_<4;++e_){ P0[4*g_+e_]-=a_[e_]; P1[4*g_+e_]-=b_[e_]; } } }while(0)
  #define MLOAD(t) do{ if(DSA) mw=*(const unsigned long long*)((const char*)MASK+(moff+(unsigned)(t)*256u)); }while(0)
  #define DMASK(P0,P1) do{ if(DSA){ const unsigned w0_=~((unsigned)mw>>(4*hi)), w1_=~((unsigned)(mw>>32)>>(4*hi)); \
    _Pragma("unroll") for(int r=0;r<16;++r){ const unsigned c_=(r&3)+8*(r>>2); \
      const float t0_=__uint_as_float(((unsigned)__builtin_amdgcn_sbfe((int)w0_,c_,1u)&0x80000000u)|0x7f800000u), t1_=__uint_as_float(((unsigned)__builtin_amdgcn_sbfe((int)w1_,c_,1u)&0x80000000u)|0x7f800000u); \
      P0[r]=__builtin_fminf(P0[r],t0_); P1[r]=__builtin_fminf(P1[r],t1_); } } }while(0)
  bool resc=false;
  #define START(P0,P1) do{ const float rm=__builtin_fmaxf(rowmax(P0,P1),-4000.f); resc=false; \
    { const float dl=rm; mhat=fadd_s(mhat,dl); \
      _Pragma("unroll") for(int r=0;r<16;++r){P0[r]=fsub_s(P0[r],dl);P1[r]=fsub_s(P1[r],dl);} \
      _Pragma("unroll") for(int r=0;r<16;++r)negm[r]=-mhat; asm volatile("":"+v"(negm)); } \
    _Pragma("unroll") for(int r=0;r<16;++r)P0[r]=__builtin_amdgcn_exp2f(P0[r]); }while(0)
  #define RESC() do{ if(resc){ asm volatile("s_waitcnt lgkmcnt(0)":::"memory"); \
      _Pragma("unroll") for(int d_=0;d_<2;++d_) _Pragma("unroll") for(int r=0;r<16;++r)o[d_][r]*=wsf[crow(r,hi)]; } }while(0)
  f32x16 pA0,pA1,pB0,pB1;
  int sl_prev=0,sl_cur=0,sl_next=SLOTB;
  #define ROT() do{sl_prev=sl_cur;sl_cur=sl_next;sl_next=(sl_next==(NSLOT-1)*SLOTB)?0:sl_next+SLOTB;}while(0)
  DMA_K(2,2*SLOTB);
  MLOAD(0);
  WAIT_BAR(3);
  { const float tq=tabp0[q0+qrel]; mhat=-tq; _Pragma("unroll") for(int r=0;r<16;++r)negm[r]=tq; asm volatile("":"+v"(negm)); }
  qkt(pA0,pA1,Kbase,qr,negm,r32,hi);asm volatile("s_nop 15\n\ts_nop 7":"+v"(pA0),"+v"(pA1));BIAS(pA0,pA1,0);DMASK(pA0,pA1);CMASK(pA0,pA1,0);
  START(pA0,pA1);
  _Pragma("unroll") for(int r=0;r<16;++r)pA1[r]=__builtin_amdgcn_exp2f(pA1[r]);
  WAIT_BAR(0);
  DMA_K(3,0);DMA_V(1,SLOTB);
  MLOAD(1);
  ROT();
  kload8(kf,kp0+sl_cur);
  #define WB2() do{ if(DSA){WAIT_BAR(3);} else {WAIT_BAR(2);} }while(0)
  WB2();
  s16x4 vlo[8],vhi[8]; u32x4 pw0,pw1,pw2,pw3;
  #define PKW(P,B) cvtpk_s(P[B],P[B+1])
  #define PAF(k) __builtin_bit_cast(bf16x8,pw##k)
  #define VFR(i) (bf16x8){vlo[i][0],vlo[i][1],vlo[i][2],vlo[i][3],vhi[i][0],vhi[i][1],vhi[i][2],vhi[i][3]}
  #define PIN(x) asm volatile("":"+v"(x))
  #define MX3(a,b,c) __builtin_fmaxf(__builtin_fmaxf((a),(b)),(c))
  #define GAPA(MF,A0,A1,A2,A3,W0,W1,PW) do{ MF; sacc+=A0; sacc+=A1; sacc+=A2; sacc+=A3; PIN(sacc); W0; W1; PIN(PW); SBAR(); }while(0)
  #define EX(v) __builtin_amdgcn_exp2f(v)
  #define GAPB(MF,X,B) do{ MF; X[B]=EX(X[B]); X[B+1]=EX(X[B+1]); X[B+2]=EX(X[B+2]); X[B+3]=EX(X[B+3]); PIN(X); SBAR(); }while(0)
  #define VRD(i) do{ vlo[i]=vtr(vp_+(((i)>>2)*4096+((i)&3)*1024)); vhi[i]=vtr(vp_+(((i)>>2)*4096+((i)&3)*1024+512)); }while(0)
  #define KRD(G,j) do{ if(G){ kload2(kf,kp0+sl_next,j); SBAR(); } }while(0)
  #define STEP(C0,C1,P0,P1,t,GK,GV,GL) do{ SBAR(); \
    const lds_cptr vp_=vp0+sl_prev; \
    VRD(0); SBAR(); float sacc=(P0[0]+P0[1]); \
    GAPA(C0=__builtin_amdgcn_mfma_f32_32x32x16_bf16(kf[0],qr[0],negm,0,0,0), P0[2],P0[3],P0[4],P0[5],     pw0[0]=PKW(P0,0), pw0[1]=PKW(P0,2), pw0); \
    VRD(4); SBAR(); GAPA(C1=__builtin_amdgcn_mfma_f32_32x32x16_bf16(kf[1],qr[0],negm,0,0,0), P0[6],P0[7],P0[8],P0[9],     pw0[2]=PKW(P0,4), pw0[3]=PKW(P0,6), pw0); \
    VRD(1); SBAR(); GAPA(C0=__builtin_amdgcn_mfma_f32_32x32x16_bf16(kf[2],qr[1],C0,0,0,0),   P0[10],P0[11],P0[12],P0[13], pw1[0]=PKW(P0,8), pw1[1]=PKW(P0,10), pw1); \
    VRD(5); SBAR(); GAPA(C1=__builtin_amdgcn_mfma_f32_32x32x16_bf16(kf[3],qr[1],C1,0,0,0),   P0[14],P0[15],P1[0],P1[1],   pw1[2]=PKW(P0,12),pw1[3]=PKW(P0,14), pw1); \
    VRD(2); SBAR(); GAPA(C0=__builtin_amdgcn_mfma_f32_32x32x16_bf16(kf[4],qr[2],C0,0,0,0),   P1[2],P1[3],P1[4],P1[5],     pw2[0]=PKW(P1,0), pw2[1]=PKW(P1,2), pw2); \
    VRD(6); SBAR(); GAPA(C1=__builtin_amdgcn_mfma_f32_32x32x16_bf16(kf[5],qr[2],C1,0,0,0),   P1[6],P1[7],P1[8],P1[9],     pw2[2]=PKW(P1,4), pw2[3]=PKW(P1,6), pw2); \
    VRD(3); SBAR(); GAPA(C0=__builtin_amdgcn_mfma_f32_32x32x16_bf16(kf[6],qr[3],C0,0,0,0),   P1[10],P1[11],P1[12],P1[13], pw3[0]=PKW(P1,8), pw3[1]=PKW(P1,10), pw3); \
    VRD(7); SBAR(); GAPA(C1=__builtin_amdgcn_mfma_f32_32x32x16_bf16(kf[7],qr[3],C1,0,0,0),   P1[14],P1[15],0.f,0.f,       pw3[2]=PKW(P1,12),pw3[3]=PKW(P1,14), pw3); \
    l_reg+=sacc; \
    BIAS(C0,C1,t); DMASK(C0,C1); \
    if(GK){DMA_K((t)+3,sl_cur);} if(GV){DMA_V((t)+1,sl_next); MLOAD((t)+1);} \
    CMASK(C0,C1,t); \
    { float a=MX3(C0[0],C0[1],C1[0]),b=MX3(C0[2],C0[3],C1[1]); a=MX3(a,C1[2],C1[3]); \
      _Pragma("unroll") for(int r=4;r<16;r+=4){a=MX3(a,C0[r],C0[r+1]);b=MX3(b,C0[r+2],C0[r+3]);a=MX3(a,C1[r],C1[r+1]);b=MX3(b,C1[r+2],C1[r+3]);} \
      float rm=__builtin_fmaxf(a,b); { auto rr=__builtin_amdgcn_permlane32_swap(__float_as_uint(rm),__float_as_uint(rm),false,false); rm=__builtin_fmaxf(__uint_as_float(rr[0]),__uint_as_float(rr[1])); } \
      resc=false; \
      if(__builtin_expect(__any(rm>(float)THRL),0)){ const float dl=__builtin_fmaxf(rm,0.f); mhat+=dl; \
        _Pragma("unroll") for(int r=0;r<16;++r){C0[r]-=dl;C1[r]-=dl;} \
        _Pragma("unroll") for(int r=0;r<16;++r)negm[r]=-mhat; asm volatile("":"+v"(negm)); \
        const float f=__builtin_amdgcn_exp2f(-dl); l_reg*=f; if(hi==0)wsf[r32]=f; resc=true; } } \
    SBAR(); \
    GAPB(o[0]=__builtin_amdgcn_mfma_f32_32x32x16_bf16(PAF(0),VFR(0),o[0],0,0,0), C0,0); \
    GAPB(o[1]=__builtin_amdgcn_mfma_f32_32x32x16_bf16(PAF(0),VFR(4),o[1],0,0,0), C0,4); \
    KRD(GL,0); GAPB(o[0]=__builtin_amdgcn_mfma_f32_32x32x16_bf16(PAF(1),VFR(1),o[0],0,0,0), C0,8); \
    KRD(GL,1); GAPB(o[1]=__builtin_amdgcn_mfma_f32_32x32x16_bf16(PAF(1),VFR(5),o[1],0,0,0), C0,12); \
    KRD(GL,2); GAPB(o[0]=__builtin_amdgcn_mfma_f32_32x32x16_bf16(PAF(2),VFR(2),o[0],0,0,0), C1,0); \
    KRD(GL,3); GAPB(o[1]=__builtin_amdgcn_mfma_f32_32x32x16_bf16(PAF(2),VFR(6),o[1],0,0,0), C1,4); \
    GAPB(o[0]=__builtin_amdgcn_mfma_f32_32x32x16_bf16(PAF(3),VFR(3),o[0],0,0,0), C1,8); \
    GAPB(o[1]=__builtin_amdgcn_mfma_f32_32x32x16_bf16(PAF(3),VFR(7),o[1],0,0,0), C1,12); \
    }while(0)
  int t=1;
  #undef CMASK
  #define CMASK(P0,P1,t) do{}while(0)
  for(;t+5<NT;t+=2){
    STEP(pB0,pB1,pA0,pA1,t,true,true,true);     WB2(); RESC(); ROT();
    STEP(pA0,pA1,pB0,pB1,t+1,true,true,true);   WB2(); RESC(); ROT();
  }
  #undef CMASK
  #define CMASK(P0,P1,t) do{ if(!DSA){int jb_=(t)-(NT-4); if(jb_>=0)cmask(P0,P1,jb_,qrel,hi);} }while(0)
  #define ENDW(tt) do{ if((tt)+3<NT){WB2();} else if((tt)+2<NT){ if(DSA){WAIT_BAR(2);} else {WAIT_BAR(1);} } else { if(DSA){WAIT_BAR(1);} else {WAIT_BAR(0);} } }while(0)
  for(;t+1<NT;t+=2){
    STEP(pB0,pB1,pA0,pA1,t,(t+3<NT),(t+1<NT),(t+1<NT));       ENDW(t);   RESC(); ROT();
    STEP(pA0,pA1,pB0,pB1,t+1,(t+4<NT),(t+2<NT),(t+2<NT));     ENDW(t+1); RESC(); ROT();
  }
  STEP(pB0,pB1,pA0,pA1,NT-1,false,false,false); RESC();
  { float sacc=pB0[0]+pB0[1]; _Pragma("unroll") for(int r=2;r<16;++r)sacc+=pB0[r]; _Pragma("unroll") for(int r=0;r<16;++r)sacc+=pB1[r]; l_reg+=sacc;
    pw0=(u32x4){PKW(pB0,0),PKW(pB0,2),PKW(pB0,4),PKW(pB0,6)};pw1=(u32x4){PKW(pB0,8),PKW(pB0,10),PKW(pB0,12),PKW(pB0,14)};pw2=(u32x4){PKW(pB1,0),PKW(pB1,2),PKW(pB1,4),PKW(pB1,6)};pw3=(u32x4){PKW(pB1,8),PKW(pB1,10),PKW(pB1,12),PKW(pB1,14)};
    SBAR(); pv(o,vb0+sl_cur,PAF(0),PAF(1),PAF(2),PAF(3)); }
  #undef PKW
  #undef PAF
  #undef VFR
  #undef PIN
  #undef MX3
  #undef GAPA
  #undef GAPB
  #undef EX
  #undef VRD
  #undef KRD
  #undef STEP
  #undef ENDW
  #undef WB2
  {auto rr=__builtin_amdgcn_permlane32_swap(__float_as_uint(l_reg),__float_as_uint(l_reg),false,false);l_reg=__uint_as_float(rr[0])+__uint_as_float(rr[1]);}
  if(hi==0)wsf[32+r32]=l_reg;asm volatile("s_waitcnt lgkmcnt(0)":::"memory");
  float rli[16];
  #pragma unroll
  for(int r=0;r<16;++r)rli[r]=__builtin_amdgcn_rcpf(wsf[32+crow(r,hi)]);
  bf16*Ow=O+(rowbase+q0+wid*QBLK)*DM+h*D;
  { bf16*stg=(bf16*)(shm+LDS_OST)+wid*2048;
    #pragma unroll
    for(int r=0;r<16;++r){const int orow=crow(r,hi);
      #pragma unroll
      for(int d0=0;d0<2;++d0)stg[orow*64+d0*32+r32]=__float2bfloat16(o[d0][r]*rli[r]);}
    asm volatile("s_waitcnt lgkmcnt(0)":::"memory");
    #pragma unroll
    for(int i=0;i<4;++i){const int row=i*8+(lane>>3),ch=lane&7; const u32x4 v=*(const u32x4*)(stg+row*64+ch*8);
      const float SC=16.f; typedef unsigned u32x2v __attribute__((ext_vector_type(2))); u32x2v w;
      w.x=pk4_fp8(__uint_as_float(v.x<<16)*SC,__uint_as_float(v.x&0xffff0000u)*SC,__uint_as_float(v.y<<16)*SC,__uint_as_float(v.y&0xffff0000u)*SC);
      w.y=pk4_fp8(__uint_as_float(v.z<<16)*SC,__uint_as_float(v.z&0xffff0000u)*SC,__uint_as_float(v.w<<16)*SC,__uint_as_float(v.w&0xffff0000u)*SC);
      *(u32x2v*)((unsigned char*)O+((rowbase+q0+wid*QBLK+row)*DM+h*D+ch*8))=w;} }
  asm volatile("s_waitcnt lgkmcnt(0)\n\ts_barrier":::"memory");
  #undef DMA_K
  #undef DMA_V
  #undef CMASK
  #undef BIAS
  #undef MLOAD
  #undef DMASK
  #undef START
  #undef RESC
  #undef ROT
}
constexpr int ATTN_LDS_BYTES=LDS_BYTES;
struct AttnTensors { const bf16 *FQ,*FK,*FV,*DQ,*DK,*DV; bf16 *OA,*OB; const float* CUM; const unsigned* MASK;
  unsigned* qhead; const unsigned* kmax2; const float* qmax2; const unsigned* blk; };
template<bool DSA> __device__ __forceinline__ void fill_tab(int b,int h,const float*CUM,char*shm){
  __attribute__((address_space(3))) float* tab=(__attribute__((address_space(3))) float*)((lds_cptr)shm+LDS_TAB);
  const int tid=ltid(); const float L2E=1.4426950408889634f;
  if(DSA){ const float sl=__builtin_amdgcn_exp2f(-(float)(h+1))*L2E;
    #pragma unroll
    for(int j=0;j<8;++j){ const int s_=tid*8+j; tab[s_]=-sl*(float)s_; } }
  else { const f32x4_t* c=(const f32x4_t*)(CUM+((size_t)b*NHEAD+h)*SEQ)+tid*2; const f32x4_t a=c[0],d=c[1];
    *(__attribute__((address_space(3))) f32x4_t*)(tab+tid*8)=a*L2E; *(__attribute__((address_space(3))) f32x4_t*)(tab+tid*8+4)=d*L2E; }
  asm volatile("s_waitcnt vmcnt(0) lgkmcnt(0)\n\ts_barrier":::"memory");
}
template<int THRL=8,class MK> __device__ __forceinline__ void attn_phase(char*lds,unsigned char*ws_,const MK&mk,volatile __attribute__((address_space(3))) unsigned* slot){
  const float CUT=64.f;
  for(;;){
    unsigned char* wsl; { size_t z=0; asm volatile("":"+s"(z)); wsl=ws_+z; }
    const AttnTensors T=mk(wsl);
    if(ltid()==0) slot[0]=__hip_atomic_fetch_add(T.qhead,1u,__ATOMIC_RELAXED,__HIP_MEMORY_SCOPE_AGENT);
    asm volatile("s_waitcnt vmcnt(0) lgkmcnt(0)\n\ts_barrier":::"memory");
    const unsigned u=slot[0];
    if(u>=2u*BATCH*NHEAD*NQB) break;
    const int qb=NQB-1-(int)(u>>7), r=(int)(u&127u), mixer=r>>6, bh=r&63, b=bh>>3, h=bh&7, q0=qb*QB, NTfull=(q0+QB)/KVBLK;
    const float qk=__builtin_sqrtf(T.qmax2[(mixer*64+bh)*NQB+qb]*__uint_as_float(T.kmax2[mixer*64+bh]));
    const float bound=2.f*qk+1.f+CUT;
    const __attribute__((address_space(3))) float* tab=(const __attribute__((address_space(3))) float*)((lds_cptr)lds+LDS_TAB);
    int jstart=0;
    if(mixer==0){
      fill_tab<false>(b,h,T.CUM,lds);
      const int lane=ltid()&63; const int sk=64*lane+63;
      const bool skip=(lane<NTfull)&&(tab[q0]-tab[sk<SEQ?sk:SEQ-1]+bound<0.f)&&(bound==bound);
      const unsigned long long m=__ballot(skip);
      jstart=(~m==0ull)?64:__builtin_ctzll(~m);
    } else {
      fill_tab<true>(b,h,T.CUM,lds);
      const float sl=__builtin_amdgcn_exp2f(-(float)(h+1))*1.4426950408889634f;
      const int smin=SEQ-1-(int)T.blk[b*NQB+qb];
      const float f=((float)smin-bound/sl)*(1.f/64.f);
      jstart=(f>0.f&&bound==bound)?(int)f:0;
    }
    jstart=__builtin_amdgcn_readfirstlane(jstart)&~1; if(jstart>NTfull-4) jstart=NTfull-4; if(jstart<0) jstart=0;
    if(mixer==0) attn_unit<THRL,false>(b,h,qb,jstart,T.FQ,T.FK,T.FV,T.OA,T.MASK,lds);
    else         attn_unit<THRL,true >(b,h,qb,jstart,T.DQ,T.DK,T.DV,T.OB,T.MASK,lds);
  }
}
#undef SBAR
#undef WAIT_BAR
}

namespace idx_body {
using bf16x8=__attribute__((ext_vector_type(8)))short;
using f32x16=__attribute__((ext_vector_type(16)))float;
typedef float f32x4_t __attribute__((ext_vector_type(4)));
typedef unsigned u32x4_t __attribute__((ext_vector_type(4)));
typedef unsigned short u16x2_t __attribute__((ext_vector_type(2)));
#define ILAS __attribute__((address_space(3)))
constexpr int SEQ=4096, TOPK=256;
constexpr int LDS_SH=0, LDS_SL=65536, LDS_BYTES=131072;
__device__ __forceinline__ float relu_f(float x){ const int b=__builtin_bit_cast(int,x); return __builtin_bit_cast(float,b>0?b:0); }
__device__ __forceinline__ unsigned skey(float f){ const unsigned u=__float_as_uint(f+0.f); return (u&0x80000000u)?~u:(u|0x80000000u); }
__device__ __forceinline__ int wave_sum(int v){
  v+=__builtin_amdgcn_update_dpp(0,v,0xB1,0xF,0xF,true);
  v+=__builtin_amdgcn_update_dpp(0,v,0x4E,0xF,0xF,true);
  v+=__builtin_amdgcn_update_dpp(0,v,0x141,0xF,0xF,true);
  v+=__builtin_amdgcn_update_dpp(0,v,0x140,0xF,0xF,true);
  v+=__builtin_amdgcn_update_dpp(0,v,0x142,0xA,0xF,false);
  v+=__builtin_amdgcn_update_dpp(0,v,0x143,0xC,0xF,false);
  return __builtin_amdgcn_readlane(v,63);
}
__device__ __forceinline__ int wave_max(int v){
  v=max(v,__builtin_amdgcn_update_dpp(v,v,0xB1,0xF,0xF,false)); v=max(v,__builtin_amdgcn_update_dpp(v,v,0x4E,0xF,0xF,false));
  v=max(v,__builtin_amdgcn_update_dpp(v,v,0x141,0xF,0xF,false)); v=max(v,__builtin_amdgcn_update_dpp(v,v,0x140,0xF,0xF,false));
  v=max(v,__builtin_amdgcn_update_dpp(v,v,0x142,0xA,0xF,false)); v=max(v,__builtin_amdgcn_update_dpp(v,v,0x143,0xC,0xF,false));
  return __builtin_amdgcn_readlane(v,63);
}
__device__ __forceinline__ unsigned pk_count(unsigned acc,unsigned x,unsigned cm1r,unsigned one2){
  unsigned tmp;
  asm("v_pk_sub_u16 %1, %2, %3 clamp\n\tv_pk_min_u16 %1, %1, %4\n\tv_pk_add_u16 %0, %0, %1":"+v"(acc),"=&v"(tmp):"v"(x),"v"(cm1r),"v"(one2));
  return acc;
}
struct AW { bf16x8 a[2][4]; f32x4_t w[2][4]; };
__device__ __forceinline__ void load_a(AW&x,const unsigned short*__restrict__ IQ,size_t rowb,int kl,int hh){
  asm volatile("":"+v"(kl),"+v"(hh));
  const int g=kl>>3, hr=(kl>>2)&1, e=kl&3, aq=2*hr+(g>>1), ahead=4*(g&1)+e;
  #pragma unroll
  for(int at=0;at<2;++at){
    const unsigned short* ap=IQ+(rowb+4*at+aq)*512+ahead*64+8*hh;
    #pragma unroll
    for(int ks=0;ks<4;++ks) x.a[at][ks]=__builtin_bit_cast(bf16x8,*(const u32x4_t*)(ap+16*ks));
  }
}
__device__ __forceinline__ void load_w(AW&x,const float*__restrict__ IW,size_t rowb,int hh,float idx_scale){
  asm volatile("":"+v"(hh));
  #pragma unroll
  for(int at=0;at<2;++at){
    const f32x4_t* wp=(const f32x4_t*)(IW+(rowb+4*at+2*hh)*8);
    #pragma unroll
    for(int k=0;k<4;++k) x.w[at][k]=wp[k]*idx_scale;
  }
}
__device__ __forceinline__ void hu_coords(int v,int hu,int&b,int&tb){ b=v>>5; const int r=v&31, i=hu>>1, p=r+32*(i>>1), qi=(i&1)?255-p:p; tb=qi*16+8*(hu&1); }
__device__ __forceinline__ void idx_phase_fast(ILAS unsigned char*lds,const unsigned short*__restrict__ IQ,const unsigned short*__restrict__ IK,const float*__restrict__ IW,unsigned*__restrict__ MASK,unsigned*__restrict__ BLK,float idx_scale,int vcu,int ncu){
  const int tid=ltid(),lane=tid&63,kl=lane&31,hh=lane>>5; const int wave=__builtin_amdgcn_readfirstlane(tid>>6);
  for(int v=vcu;v<256;v+=ncu){
    int b,tb; hu_coords(v,0,b,tb);
    AW cur; load_a(cur,IQ,(size_t)b*SEQ+tb,kl,hh); load_w(cur,IW,(size_t)b*SEQ+tb,hh,idx_scale);
    bf16x8 b0[4],b1[4],b2[4];
    #define LDBX(dst,kt_,nkt_,bb_) do{ const int ktc_=(kt_)<(nkt_)?(kt_):(nkt_)-1; int kl_=kl,hh_=hh; asm volatile("":"+v"(kl_),"+v"(hh_)); const u32x4_t* kp_=(const u32x4_t*)(IK+((size_t)(bb_)*SEQ+kl_)*64+8*hh_+(size_t)ktc_*2048); \
      _Pragma("unroll") for(int ks=0;ks<4;++ks) dst[ks]=__builtin_bit_cast(bf16x8,kp_[2*ks]); }while(0)
    #pragma unroll 1
    for(int hu=0;hu<16;++hu){
      hu_coords(v,hu,b,tb);
      const size_t rowb=(size_t)b*SEQ+tb;
      const int nkt=(tb+8+31)>>5;
      const int tqb=tb+2*hh;
      #define LDB(dst,kt_) LDBX(dst,kt_,nkt,b)
      #define SCORE(bb,kt_) do{ const int s=32*(kt_)+kl; const int sidx=((s>>7)<<6)+(s&63), sh=(s>>6)&1; \
        _Pragma("unroll") for(int at=0;at<2;++at){ \
          f32x16 c=f32x16{}; \
          _Pragma("unroll") for(int ks=0;ks<4;++ks) c=__builtin_amdgcn_mfma_f32_32x32x16_bf16(cur.a[at][ks],bb[ks],c,0,0,0); \
          float s0=0.f,s1=0.f; \
          _Pragma("unroll") for(int q=0;q<4;++q){ s0=__builtin_fmaf(cur.w[at][0][q],relu_f(c[q]),s0); s0=__builtin_fmaf(cur.w[at][1][q],relu_f(c[4+q]),s0); \
                                s1=__builtin_fmaf(cur.w[at][2][q],relu_f(c[8+q]),s1); s1=__builtin_fmaf(cur.w[at][3][q],relu_f(c[12+q]),s1); } \
          const int tq=tqb+4*at; \
          const unsigned k0=(s<=tq)?skey(s0):0u, k1=(s<=tq+1)?skey(s1):0u; \
          ILAS unsigned short* ph=(ILAS unsigned short*)(lds+LDS_SH)+((4*at+2*hh)*2048+sidx)*2+sh; \
          ILAS unsigned short* pl=(ILAS unsigned short*)(lds+LDS_SL)+((4*at+2*hh)*2048+sidx)*2+sh; \
          ph[0]=(unsigned short)(k0>>16); pl[0]=(unsigned short)k0; ph[4096]=(unsigned short)(k1>>16); pl[4096]=(unsigned short)k1; } }while(0)
      {
        LDB(b0,wave); LDB(b1,wave+8);
        int kt=wave;
        #pragma unroll 1
        for(;kt<nkt;kt+=24){
          LDB(b2,kt+16); SCORE(b0,kt); __builtin_amdgcn_sched_barrier(0);
          if(kt+8<nkt){ LDB(b0,kt+24); SCORE(b1,kt+8); } __builtin_amdgcn_sched_barrier(0);
          if(kt+16<nkt){ LDB(b1,kt+32); SCORE(b2,kt+16); } __builtin_amdgcn_sched_barrier(0);
        }
      }
      #undef LDB
      #undef SCORE
      int nb=b,ntb=tb; if(hu+1<16){ hu_coords(v,hu+1,nb,ntb); load_a(cur,IQ,(size_t)nb*SEQ+ntb,kl,hh); }
      asm volatile("s_waitcnt lgkmcnt(0)\n\ts_barrier":::"memory");
#ifndef IDX_REP_B
#define IDX_REP_B 1
#endif
      _Pragma("unroll 1") for(int repB=0;repB<IDX_REP_B;++repB)
      {
        const int t=tb+wave; const int ngrp=(t>>10)+1;
        const ILAS unsigned* SHq=(const ILAS unsigned*)(lds+LDS_SH)+wave*2048+lane; const ILAS unsigned* SLq=(const ILAS unsigned*)(lds+LDS_SL)+wave*2048+lane;
        unsigned kh[32],kw[32];
        #pragma unroll
        for(int gI=0;gI<4;++gI){
          if(gI<ngrp){
            #pragma unroll
            for(int i=8*gI;i<8*gI+8;++i){ kh[i]=SHq[64*i]; kw[i]=SLq[64*i]; }
          } else {
            #pragma unroll
            for(int i=8*gI;i<8*gI+8;++i){ kh[i]=0u; kw[i]=0u; }
          }
        }
        #pragma unroll
        for(int gI=0;gI<4;++gI){ if(gI==ngrp-1){
          #pragma unroll
          for(int i=8*gI;i<8*gI+8;++i){ const unsigned m=((128*i+lane<=t)?0xffffu:0u)|((128*i+64+lane<=t)?0xffff0000u:0u); kh[i]&=m; kw[i]&=m; } } }
        unsigned T=1u; int X=0;
        unsigned one2=0x00010001u; asm volatile("":"+v"(one2));
        if(t>=TOPK){
          unsigned Thi=0u; int cntHi=0, G1=0; bool done=false;
          for(int bb=14;bb>=0;bb-=2){
            const unsigned c1=Thi|(1u<<bb), c2=Thi|(2u<<bb), c3=Thi|(3u<<bb);
            const unsigned m1=(c1-1u)*0x10001u, m2=(c2-1u)*0x10001u, m3=(c3-1u)*0x10001u;
            unsigned a1[2]={0u,0u},a2[2]={0u,0u},a3[2]={0u,0u};
            #pragma unroll
            for(int gI=0;gI<4;++gI){ if(gI<ngrp){
              #pragma unroll
              for(int i=8*gI;i<8*gI+8;++i){ a1[i&1]=pk_count(a1[i&1],kh[i],m1,one2); a2[i&1]=pk_count(a2[i&1],kh[i],m2,one2); a3[i&1]=pk_count(a3[i&1],kh[i],m3,one2); } } }
            const unsigned s1=a1[0]+a1[1], s2=a2[0]+a2[1], s3=a3[0]+a3[1];
            const int n12=wave_sum((int)(((s1&0xffffu)+(s1>>16))|(((s2&0xffffu)+(s2>>16))<<16)));
            const int n3=wave_sum((int)((s3&0xffffu)+(s3>>16)));
            const int n1=n12&0xffff, n2=(int)((unsigned)n12>>16);
            int nj;
            if(n3>=TOPK){ Thi=c3; nj=n3; } else if(n2>=TOPK){ Thi=c2; nj=n2; G1=n3; } else if(n1>=TOPK){ Thi=c1; nj=n1; G1=n2; } else { nj=0; G1=n1; }
            if(nj>0){ cntHi=nj; if(nj==TOPK){ done=true; break; } }
          }
          T=Thi<<16; X=0;
          if(!done){
            { const unsigned thr=Thi*0x10001u; const u16x2_t one={1,1}, ffff={0xffff,0xffff};
              #pragma unroll
              for(int gI=0;gI<4;++gI){ if(gI<ngrp){
                #pragma unroll
                for(int i=8*gI;i<8*gI+8;++i){ u16x2_t x=__builtin_bit_cast(u16x2_t,kh[i]^thr); x=__builtin_elementwise_min(x,one); x=(one-x)*ffff; kw[i]&=__builtin_bit_cast(unsigned,x); } } } }
            unsigned Tlo=0u; int cntT=cntHi;
            for(int bit=15;bit>=0;--bit){
              const unsigned cand=Tlo|(1u<<bit), cm1r=(cand-1u)*0x10001u; unsigned ac[4]={0u,0u,0u,0u};
              #pragma unroll
              for(int gI=0;gI<4;++gI){ if(gI<ngrp){
                #pragma unroll
                for(int i=8*gI;i<8*gI+8;++i) ac[i&3]=pk_count(ac[i&3],kw[i],cm1r,one2); } }
              const unsigned acc=(ac[0]+ac[1])+(ac[2]+ac[3]);
              const int cnt=G1+wave_sum((int)((acc&0xffffu)+(acc>>16)));
              if(cnt>=TOPK){ Tlo=cand; cntT=cnt; if(cnt==TOPK) break; }
            }
            T=(Thi<<16)|Tlo; X=cntT-TOPK;
          }
        }
        unsigned long long mine=0ull;
        #pragma unroll
        for(int gI=3;gI>=0;--gI){ if(gI<ngrp){
          #pragma unroll
          for(int i=8*gI+7;i>=8*gI;--i){
            const unsigned keyA=(kh[i]<<16)|(kw[i]&0xffffu), keyB=(kh[i]&0xffff0000u)|(kw[i]>>16);
            unsigned long long balB=__ballot(keyB>=T), balA=__ballot(keyA>=T);
            if(X>0){ unsigned long long eq=__ballot(keyB==T);
              while(X>0&&eq!=0ull){ const int hb=63-__builtin_clzll(eq); balB&=~(1ull<<hb); eq&=~(1ull<<hb); --X; }
              eq=__ballot(keyA==T);
              while(X>0&&eq!=0ull){ const int hb=63-__builtin_clzll(eq); balA&=~(1ull<<hb); eq&=~(1ull<<hb); --X; } }
            if(lane==2*i) mine=balA;
            if(lane==2*i+1) mine=balB;
          } } }
        { int ln_=lane; asm volatile("":"+v"(ln_)); const unsigned off_=(unsigned)((((b*128+(t>>5))*64+ln_)*32+(t&31))*8); *(unsigned long long*)((char*)MASK+off_)=mine; }
        if(hu+1<16) load_w(cur,IW,(size_t)nb*SEQ+ntb,hh,idx_scale);
        { const int smax=wave_max(mine!=0ull?64*lane+63-__builtin_clzll(mine):-1);
          if(lane==0) __hip_atomic_fetch_max(BLK+b*16+(t>>8),(unsigned)(SEQ-1-smax),__ATOMIC_RELAXED,__HIP_MEMORY_SCOPE_AGENT); }
      }
      asm volatile("s_waitcnt lgkmcnt(0)\n\ts_barrier":::"memory");
    }
  }
}
#undef ILAS
}

struct MapIdent { __device__ __forceinline__ int operator()(int j) const { return j; } };
struct MapWin {
    __device__ __forceinline__ int operator()(int j) const {
        if (j < 1536) return j;
        if (j < 3072) return 1544 + (j - 1536);
        if (j < 3584) return 3080 + (j - 3072);
        if (j < 3648) return 3592 + (j - 3584);
        if (j < 3656) return 1536 + (j - 3648);
        if (j < 3664) return 3656 + (j - 3656);
        if (j < 3840) return -1;
        return 3664 + (j - 3840);
    }
};
struct MapF1 { __device__ __forceinline__ int operator()(int j) const { const int pn = j >> 8, i = j & 255; return i < 128 ? 128 * pn + i : DFF + 128 * pn + (i - 128); } };
template <class Map, bool F8 = false>
__device__ __forceinline__ void wt_item(const float* W, int K, int ldw, bf16_t* WT, int nblk, int item, LAS float* scr, int lane, const Map& map, float f8s = F8_WSCALE, int rowsub = 0) {
    const int kb = item / nblk, nb = item % nblk, k0 = 64 * kb, n0 = 32 * nb;
    const int src = map(n0 + (lane & 31));
#pragma unroll 8
    for (int i = 0; i < 32; ++i) { const int kk = 2 * i + (lane >> 5); scr[kk * 33 + (lane & 31)] = src >= 0 ? W[(size_t)(k0 + kk) * ldw + src] : 0.f; }
    asm volatile("s_waitcnt lgkmcnt(0)" ::: "memory");
    const int c = lane & 7;
#pragma unroll
    for (int j = 0; j < 4; ++j) { const int n = (lane >> 3) + 8 * j; const LAS float* sp = scr + (8 * c) * 33 + n;
        if constexpr (F8) { u32x2 o; o.x = pk4_fp8(sp[0 * 33] * f8s, sp[1 * 33] * f8s, sp[2 * 33] * f8s, sp[3 * 33] * f8s); o.y = pk4_fp8(sp[4 * 33] * f8s, sp[5 * 33] * f8s, sp[6 * 33] * f8s, sp[7 * 33] * f8s);
            *(u32x2*)((unsigned char*)WT + (size_t)(n0 + n - rowsub) * K + k0 + 8 * c) = o; }
        else { u32x4 o; o.x = f2bf(sp[0 * 33]) | (f2bf(sp[1 * 33]) << 16); o.y = f2bf(sp[2 * 33]) | (f2bf(sp[3 * 33]) << 16); o.z = f2bf(sp[4 * 33]) | (f2bf(sp[5 * 33]) << 16); o.w = f2bf(sp[6 * 33]) | (f2bf(sp[7 * 33]) << 16);
        *(u32x4*)(WT + (size_t)(n0 + n) * K + k0 + 8 * c) = o; } }
    asm volatile("s_waitcnt lgkmcnt(0)" ::: "memory");
}
__device__ __forceinline__ void wcvt_phase(const P& p, LAS unsigned char* lds, int wg, int nwg) {
    const int tid = ltid(), lane = tid & 63, wave = tid >> 6;
    LAS float* scr = (LAS float*)(lds + wave * 16384);
    constexpr int I_IN = 16 * 184, I_A = 8 * 32, I_OUT = 16 * 32, I_F1 = 16 * 176, I_F2 = 44 * 32, I_LAYER = I_IN + 2 * I_A + I_OUT + I_F1 + I_F2;
    for (int it = wg * 8 + wave; it < DEPTH * I_LAYER; it += nwg * 8) {
        const int l = it / I_LAYER; int r = it % I_LAYER;
        unsigned char* wt = p.ws + WS_WT + (size_t)l * WT_LAYER;
        if (r < I_IN) { if (r % 184 < 96) wt_item<MapWin, true>(p.w_in + (size_t)l * D * NIN, D, NIN, (bf16_t*)(wt + WT_IN), 184, r, scr, lane, MapWin(), F8_W64);
                        else if (r % 184 < 120) wt_item(p.w_in + (size_t)l * D * NIN, D, NIN, (bf16_t*)(wt + WT_IN), 184, r, scr, lane, MapWin());
                        else wt_item<MapWin, true>(p.w_in + (size_t)l * D * NIN, D, NIN, (bf16_t*)(wt + WT_G8), 184, r, scr, lane, MapWin(), F8_W64, NPROJ); continue; } r -= I_IN;
        if (r < I_A) { wt_item<MapIdent, true>(p.w_a + (size_t)l * 512 * D, 512, D, (bf16_t*)(wt + WT_A8), 32, r, scr, lane, MapIdent(), F8_W64); continue; } r -= I_A;
        if (r < I_A) { wt_item<MapIdent, true>(p.w_b + (size_t)l * 512 * D, 512, D, (bf16_t*)(wt + WT_B8), 32, r, scr, lane, MapIdent(), F8_W64); continue; } r -= I_A;
        if (r < I_OUT) { wt_item(p.w_out + (size_t)l * D * D, D, D, (bf16_t*)(wt + WT_OUT), 32, r, scr, lane, MapIdent()); continue; } r -= I_OUT;
        if (r < I_F1) { wt_item<MapF1, true>(p.w_ffn_in + (size_t)l * D * 2 * DFF, D, 2 * DFF, (bf16_t*)(wt + WT_F1), 176, r, scr, lane, MapF1()); continue; } r -= I_F1;
        wt_item<MapIdent, true>(p.w_ffn_out + (size_t)l * DFF * D, DFF, D, (bf16_t*)(wt + WT_F2), 32, r, scr, lane, MapIdent());
    }
}

enum { PH_CVT = 0, PH_PROJ, PH_CUM, PH_IDX, PH_ATTN, PH_GATES, PH_BRA, PH_BRB, PH_OUT, PH_LN1, PH_FFN1, PH_FFN2, PH_LN2, PH_WCVT };

template <class Epi>
__device__ __forceinline__ void fast_gemm(LAS unsigned char* lds, const bf16_t* A, const bf16_t* Bt, int N, int K, const Epi& E) {
    pg8::Gemm g{A, Bt, M, N, K}; pg8::StaticOrder S; S.init(M, N, (int)gridDim.x, (int)blockIdx.x);
    pg8::gemm_phase<Epi, pg8::StaticOrder, true, true>(lds, g, S, E);
}
template <class Epi, bool ALIGN = true>
__device__ __forceinline__ void fast_gemm8(LAS unsigned char* lds, const unsigned char* A, const unsigned char* Bt, int N, int K, const Epi& E) {
    asm volatile("" : "+s"(K));
    pg8::Gemm g{(const bf16_t*)A, (const bf16_t*)Bt, M, N, K}; pg8::StaticOrder S; S.init(M, N, (int)gridDim.x, (int)blockIdx.x);
    pg8::gemm_phase<Epi, pg8::StaticOrder, ALIGN, true, true>(lds, g, S, E);
}

#ifndef NAIVE_MASK
#define NAIVE_MASK 0
#endif
template <int PH>
__device__ __forceinline__ void run_phase(const P& p_in, int l, LAS unsigned char* lds, int wg, int nwg) {
    P p = p_in; { size_t z = 0; asm volatile("" : "+s"(z)); p.ws = p_in.ws + z; }
    bf16_t* XB = WSP(bf16_t, WS_XB);
    const unsigned char* wt = p.ws + WS_WT + (size_t)l * WT_LAYER;
    if constexpr (PH == PH_CVT) cvt_phase(p, wg, nwg);
    if constexpr (PH == PH_WCVT) wcvt_phase(p, lds, wg, nwg);
    if constexpr (PH == PH_PROJ && (NAIVE_MASK & 1)) {
        GemmArgs g{XB, D, p.w_in + (size_t)l * D * NIN, NIN, C_GA, D, 0};
        EpiProj E{WSP(bf16_t, WS_FQ), WSP(bf16_t, WS_FK), WSP(bf16_t, WS_FV), WSP(bf16_t, WS_DQ), WSP(bf16_t, WS_DK), WSP(bf16_t, WS_DV), WSP(bf16_t, WS_IQ), WSP(bf16_t, WS_IK),
                  WSP(float, WS_FL), WSP(float, WS_IW), p.b_forget + l * NH};
        naive_gemm_phase<EpiProj, false>(lds, g, E, wg, nwg);
    } else
    if constexpr (PH == PH_PROJ) {
        { pg8::EpiProjF E{WSP(bf16_t, WS_FQ), (size_t)M * 512, WSP(bf16_t, WS_IK), WSP(float, WS_FL), WSP(float, WS_IW), p.b_forget + l * NH, QSCALE, 12};
          fast_gemm(lds, XB, (const bf16_t*)(wt + WT_IN) + (size_t)3072 * D, 768, D, E); }
        { pg8::EpiQkvF E{WSP(bf16_t, WS_FQ), (size_t)M * 512, QSCALE, 1.f / F8_W64};
          int K8 = D; asm volatile("" : "+s"(K8));
          pg8::Gemm g{(const bf16_t*)WSP(const unsigned char, WS_XF8), (const bf16_t*)(wt + WT_IN), M, 3072, K8}; pg8::SplitOrder S; S.init(M, 3072, (int)gridDim.x, (int)blockIdx.x);
          pg8::gemm_phase<pg8::EpiQkvF, pg8::SplitOrder, true, true, true>(lds, g, S, E); }
    }
    if constexpr (PH == PH_CUM) { cum_phase(p, lds, wg, nwg); norm_phase(p, WSP(unsigned, WS_CTL) + CW_KMAX + 128 * l, (float*)(WSP(unsigned, WS_CTL) + CW_QMAX + 2048 * l), wg, nwg); }
    if constexpr (PH == PH_IDX && (NAIVE_MASK & 128)) idx_phase(p, lds, wg, nwg); else
    if constexpr (PH == PH_IDX) {
        const int G = (int)gridDim.x, bx = (int)blockIdx.x, vcu = (G % 8 == 0) ? (bx % 8) * (G / 8) + bx / 8 : bx;
        idx_body::idx_phase_fast(lds, WSP(const bf16_t, WS_IQ), WSP(const bf16_t, WS_IK), WSP(const float, WS_IW), WSP(unsigned, WS_MASK), WSP(unsigned, WS_CTL) + CW_BLK + 128 * l, IDX_SCALE, vcu, G);
    }
    if constexpr (PH == PH_ATTN && (NAIVE_MASK & 64)) attn_phase_naive(p, wg, nwg); else
    if constexpr (PH == PH_ATTN) {
        typedef attn_body::bf16 abf;
        auto mk = [l](unsigned char* ws) { unsigned* ctl = (unsigned*)(ws + WS_CTL);
            return attn_body::AttnTensors{(const abf*)(ws + WS_FQ), (const abf*)(ws + WS_FK), (const abf*)(ws + WS_FV), (const abf*)(ws + WS_DQ), (const abf*)(ws + WS_DK), (const abf*)(ws + WS_DV),
                                          (abf*)(ws + WS_OA), (abf*)(ws + WS_OB), (const float*)(ws + WS_CUM), (const unsigned*)(ws + WS_MASK),
                                          ctl + CW_QHEAD + 64 * l, ctl + CW_KMAX + 128 * l, (const float*)(ctl + CW_QMAX + 2048 * l), ctl + CW_BLK + 128 * l}; };
        attn_body::attn_phase<8>((char*)lds, p.ws, mk, (volatile LAS unsigned*)(lds + LDS_MISC_OFF + 16));
    }
    if constexpr (PH == PH_GATES && (NAIVE_MASK & 2)) {
        GemmArgs g{XB, D, p.w_in + (size_t)l * D * NIN + C_GA, NIN, 2048, D, 0};
        EpiGates E{WSP(bf16_t, WS_SGA), WSP(bf16_t, WS_SGB)};
        naive_gemm_phase<EpiGates, false>(lds, g, E, wg, nwg);
    } else
    if constexpr (PH == PH_GATES) {
        pg8::EpiGatesF E{WSP(bf16_t, WS_SGA), (size_t)M * 1024, 1.f / F8_W64};
        fast_gemm8(lds, WSP(const unsigned char, WS_XF8), wt + WT_G8, NGATE, D, E);
    }
    if constexpr (PH == PH_BRA && (NAIVE_MASK & 4)) {
        GemmArgs g{WSP(bf16_t, WS_OA), 512, p.w_a + (size_t)l * 512 * D, D, D, 512, 0};
        EpiBranchA E{WSP(bf16_t, WS_SGA)};
        naive_gemm_phase<EpiBranchA, false>(lds, g, E, wg, nwg);
    } else
    if constexpr (PH == PH_BRA) {
        pg8::EpiBranchF<0> E{WSP(bf16_t, WS_SGA), nullptr, nullptr, 1.f / (F8_OSCALE * F8_W64), 0.f};
        fast_gemm8(lds, WSP(const unsigned char, WS_OA), wt + WT_A8, D, 512, E);
    }
    if constexpr (PH == PH_BRB && (NAIVE_MASK & 4)) {
        GemmArgs g{WSP(bf16_t, WS_OB), 512, p.w_b + (size_t)l * 512 * D, D, D, 512, 0};
        EpiBranchB E{WSP(bf16_t, WS_SGA), WSP(bf16_t, WS_SGB)};
        naive_gemm_phase<EpiBranchB, false>(lds, g, E, wg, nwg);
    } else
    if constexpr (PH == PH_BRB) {
        pg8::EpiBranchF<1> E{WSP(bf16_t, WS_SGB), WSP(bf16_t, WS_SGA), WSP(unsigned char, WS_MG8), 1.f / (F8_OSCALE * F8_W64), F8_MSCALE};
        fast_gemm8(lds, WSP(const unsigned char, WS_OB), wt + WT_B8, D, 512, E);
    }
    if constexpr (PH == PH_OUT && (NAIVE_MASK & 8)) {
        GemmArgs g{WSP(bf16_t, WS_SGB), D, p.w_out + (size_t)l * D * D, D, D, D, 0};
        EpiResF32 E{l == 0 ? p.x : nullptr, XB, p.out};
        naive_gemm_phase<EpiResF32, false>(lds, g, E, wg, nwg);
    } else
    if constexpr (PH == PH_OUT) {
        pg8::EpiResF E{l == 0 ? p.x : nullptr, XB, WSP(bf16_t, WS_Y1), ALPHA, 1.f};
        fast_gemm(lds, WSP(bf16_t, WS_SGB), (const bf16_t*)(wt + WT_OUT), D, D, E);
    }
    if constexpr (PH == PH_LN1) ln_phase(WSP(const bf16_t, WS_Y1), p.ln1_g + l * D, p.ln1_b + l * D, WSP(bf16_t, WS_X1B), nullptr, wg, nwg, WSP(unsigned char, WS_X1F8));
    if constexpr (PH == PH_FFN1 && (NAIVE_MASK & 16)) {
        GemmArgs g{WSP(bf16_t, WS_X1B), D, p.w_ffn_in + (size_t)l * D * 2 * DFF, 2 * DFF, DFF, D, DFF};
        EpiSwiglu E{WSP(bf16_t, WS_H)};
        naive_gemm_phase<EpiSwiglu, true>(lds, g, E, wg, nwg);
    } else
    if constexpr (PH == PH_FFN1) {
        pg8::EpiSwigluF8 E{WSP(unsigned char, WS_H8), DFF, 1.f / F8_WSCALE, F8_HSCALE};
        fast_gemm8(lds, WSP(const unsigned char, WS_X1F8), wt + WT_F1, 2 * DFF, D, E);
    }
    if constexpr (PH == PH_FFN2 && (NAIVE_MASK & 32)) {
        GemmArgs g{WSP(bf16_t, WS_H), DFF, p.w_ffn_out + (size_t)l * DFF * D, D, D, DFF, 0};
        EpiResF32 E{nullptr, WSP(bf16_t, WS_X1B), p.out};
        naive_gemm_phase<EpiResF32, false>(lds, g, E, wg, nwg);
    } else
    if constexpr (PH == PH_FFN2) {
        pg8::EpiResF E{nullptr, WSP(bf16_t, WS_X1B), XB, ALPHA, 1.f / (F8_WSCALE * F8_HSCALE)};
        fast_gemm8(lds, WSP(const unsigned char, WS_H8), wt + WT_F2, D, DFF, E);
    }
    if constexpr (PH == PH_LN2) {
        if (l + 1 < DEPTH) ln_phase(XB, p.ln2_g + l * D, p.ln2_b + l * D, XB, nullptr, wg, nwg, WSP(unsigned char, WS_XF8));
        else ln_phase(XB, p.ln2_g + l * D, p.ln2_b + l * D, nullptr, p.out, wg, nwg);
    }
}

#define XB_TMO      128
#define XB_XCNT(j)  (256  + 64 * (j))
#define XB_XSUB(j)  (1280 + 64 * (j))
#define XB_XGEN(j)  (2304 + 64 * (j))
#define XB_TOP      3328
#define XB_TOPGEN   3392
#define XCD_BAR_WORDS 3456
#define XB_SPIN_CAP (1u << 18)

__device__ __forceinline__ unsigned xb_ld(unsigned* p)              { return __hip_atomic_load(p, __ATOMIC_RELAXED, __HIP_MEMORY_SCOPE_AGENT); }
__device__ __forceinline__ unsigned xb_add(unsigned* p, unsigned v) { return __hip_atomic_fetch_add(p, v, __ATOMIC_RELAXED, __HIP_MEMORY_SCOPE_AGENT); }
__device__ __forceinline__ unsigned xb_xcc_id() { return (unsigned)__builtin_amdgcn_s_getreg((3 << 11) | 20) & 0xFu; }
#define XB_SPIN(cond, bar) do { unsigned _sp = 0; while (cond) { __builtin_amdgcn_s_sleep(1); \
    if ((++_sp & 255u) == 0u) { if (xb_ld(&(bar)[XB_TMO])) break; if (_sp > XB_SPIN_CAP) { atomicAdd(&(bar)[XB_TMO], 1u); break; } } } } while (0)

struct XcdBarrier {
    unsigned* bar; unsigned x;
    volatile LAS unsigned* st;
};

__device__ __forceinline__ XcdBarrier xcd_barrier_post(unsigned* bar, volatile LAS unsigned* st) {
    XcdBarrier b; b.bar = bar; b.x = xb_xcc_id(); b.st = st;
    if (ltid() == 0) (void)xb_add(&bar[XB_XCNT(b.x)], 1u);
    return b;
}
__device__ __forceinline__ void xcd_barrier_complete(unsigned* bar, unsigned x, unsigned& nloc, unsigned& nx) {
    const unsigned G = gridDim.x * gridDim.y * gridDim.z;
    unsigned sum, cnt, mine, sp = 0u;
    for (;;) {
        sum = 0u; cnt = 0u; mine = 0u;
#pragma unroll
        for (unsigned j = 0; j < 16; ++j) { const unsigned c = xb_ld(&bar[XB_XCNT(j)]); sum += c; cnt += (c > 0u) ? 1u : 0u; mine = (j == x) ? c : mine; }
        if (sum == G) break;
        __builtin_amdgcn_s_sleep(1);
        if ((++sp & 255u) == 0u) { if (xb_ld(&bar[XB_TMO])) break; if (sp > XB_SPIN_CAP) { atomicAdd(&bar[XB_TMO], 1u); break; } }
    }
    nloc = mine > 0u ? mine : 1u; nx = cnt > 0u ? cnt : 1u;
}

__device__ __forceinline__ void xcd_barrier(const XcdBarrier& b) {
    asm volatile("s_waitcnt vmcnt(0)" ::: "memory");
    __syncthreads();
    if (ltid() == 0) {
        unsigned* bar = b.bar;
        __builtin_amdgcn_s_waitcnt(0);
        unsigned nloc = b.st[0], nx = b.st[1];
        if (nloc == 0u) { xcd_barrier_complete(bar, b.x, nloc, nx); b.st[0] = nloc; b.st[1] = nx; }
        const unsigned old = xb_add(&bar[XB_XSUB(b.x)], 1u);
        const unsigned gen = old / nloc;
        if (old + 1u == (gen + 1u) * nloc) {
            __builtin_amdgcn_fence(__ATOMIC_RELEASE, "agent");
            asm volatile("s_waitcnt vmcnt(0)" ::: "memory");
            const unsigned og = xb_add(&bar[XB_TOP], 1u);
            const unsigned tg = og / nx;
            if (og + 1u == (tg + 1u) * nx) xb_add(&bar[XB_TOPGEN], 1u);
            else XB_SPIN(xb_ld(&bar[XB_TOPGEN]) == tg, bar);
            __builtin_amdgcn_fence(__ATOMIC_ACQUIRE, "agent");
            xb_add(&bar[XB_XGEN(b.x)], 1u);
            asm volatile("s_waitcnt vmcnt(0)" ::: "memory");
        } else {
            XB_SPIN(xb_ld(&bar[XB_XGEN(b.x)]) == gen, bar);
            __builtin_amdgcn_fence(__ATOMIC_ACQUIRE, "agent");
            asm volatile("s_waitcnt vmcnt(0)" ::: "memory");
        }
    }
    __syncthreads();
}

constexpr int LDS_BYTES = 147456;
constexpr int LDS_MISC = LDS_MISC_OFF;
constexpr int CW_BAR = 4096;
constexpr size_t CTL_ZERO_BYTES = 1u << 20;

#ifndef DUP_MASK
#define DUP_MASK 0
#endif
#define RUNPH(PH, bit) do { run_phase<PH>(p, l, lds, wg, nwg); if (DUP_MASK & (bit)) { xcd_barrier(bar); run_phase<PH>(p, l, lds, wg, nwg); } } while (0)
template <int LYR>
__device__ __forceinline__ void layer_body(const P& p, LAS unsigned char* lds, int wg, int nwg, const XcdBarrier& bar) {
    constexpr int l = LYR;
    RUNPH(PH_PROJ, 1); xcd_barrier(bar);
    run_phase<PH_CUM>(p, l, lds, wg, nwg); __syncthreads();
    RUNPH(PH_IDX, 2); xcd_barrier(bar);
    RUNPH(PH_ATTN, 4); xcd_barrier(bar);
    RUNPH(PH_GATES, 8); xcd_barrier(bar);
    run_phase<PH_BRA>(p, l, lds, wg, nwg); xcd_barrier(bar);
    run_phase<PH_BRB>(p, l, lds, wg, nwg); xcd_barrier(bar);
    RUNPH(PH_OUT, 16); xcd_barrier(bar);
    RUNPH(PH_LN1, 32); xcd_barrier(bar);
    RUNPH(PH_FFN1, 64); xcd_barrier(bar);
    RUNPH(PH_FFN2, 128); xcd_barrier(bar);
    run_phase<PH_LN2>(p, l, lds, wg, nwg);
}

__global__ void __launch_bounds__(NT, 2) mega_fwd(P p) {
    extern __shared__ __attribute__((aligned(16))) unsigned char lds_raw[];
    LAS unsigned char* lds = (LAS unsigned char*)lds_raw;
    volatile LAS unsigned* MISC = (volatile LAS unsigned*)(lds + LDS_MISC);
    if (threadIdx.x < 8) MISC[threadIdx.x] = 0u;
    ((volatile LAS int*)(uintptr_t)LDS_WTAB_OFF)[hw_wave_slot()] = (int)(threadIdx.x >> 6);
    __syncthreads();
    XcdBarrier bar = xcd_barrier_post((unsigned*)(p.ws + WS_CTL) + CW_BAR, MISC);
    const int wg = (int)blockIdx.x, nwg = (int)gridDim.x;
    run_phase<PH_CVT>(p, 0, lds, wg, nwg);
    run_phase<PH_WCVT>(p, 0, lds, wg, nwg); xcd_barrier(bar);
    layer_body<0>(p, lds, wg, nwg, bar); xcd_barrier(bar);
    layer_body<1>(p, lds, wg, nwg, bar);
}

extern "C" void kernel_launch(void* const* d_in, const int* in_sizes, int n_in, void* d_out, int out_size, void* d_ws, size_t ws_size, hipStream_t stream) {
    static int grid = 0;
    if (grid == 0) {
        if (n_in != 12 || ws_size < WS_END) { fprintf(stderr, "kernel_launch: unexpected inputs (n_in %d, ws %zu)\n", n_in, ws_size); grid = -1; return; }
        int dev = 0, cus = 0, per_cu = 0;
        if (hipGetDevice(&dev) != hipSuccess || hipDeviceGetAttribute(&cus, hipDeviceAttributeMultiprocessorCount, dev) != hipSuccess) { grid = -1; return; }
        if (hipFuncSetAttribute((const void*)mega_fwd, hipFuncAttributeMaxDynamicSharedMemorySize, LDS_BYTES) != hipSuccess) { fprintf(stderr, "kernel_launch: hipFuncSetAttribute failed\n"); grid = -1; return; }
        if (hipOccupancyMaxActiveBlocksPerMultiprocessor(&per_cu, (const void*)mega_fwd, NT, LDS_BYTES) != hipSuccess || per_cu < 1) { fprintf(stderr, "kernel_launch: occupancy query says %d\n", per_cu); }
        (void)hipGetLastError();
        grid = cus;
    }
    if (grid < 0) return;
    P p{};
    p.x = (const float*)d_in[0]; p.w_in = (const float*)d_in[1]; p.b_forget = (const float*)d_in[2]; p.w_a = (const float*)d_in[3]; p.w_b = (const float*)d_in[4];
    p.w_out = (const float*)d_in[5]; p.ln1_g = (const float*)d_in[6]; p.ln1_b = (const float*)d_in[7]; p.w_ffn_in = (const float*)d_in[8]; p.w_ffn_out = (const float*)d_in[9];
    p.ln2_g = (const float*)d_in[10]; p.ln2_b = (const float*)d_in[11]; p.out = (float*)d_out; p.ws = (unsigned char*)d_ws;
    if (hipMemsetAsync((char*)d_ws + WS_CTL, 0, CTL_ZERO_BYTES, stream) != hipSuccess) { fprintf(stderr, "kernel_launch: memset failed\n"); return; }
    hipLaunchKernelGGL(mega_fwd, dim3(grid), dim3(NT), LDS_BYTES, stream, p);
}
```
